# Optimizing an MI355X kernel written in HIP

```python
import jax, jax.numpy as jnp
from jax import lax
import numpy as np

D_MODEL = 2048
BATCH = 2
SEQ = 4096
DEPTH = 1

MEM_LEN = 256
MLA_HEADS = 8
MLA_NOPE_DIM = 128
MLA_ROPE_DIM = 64
MLA_QK_DIM = MLA_NOPE_DIM + MLA_ROPE_DIM
MLA_V_DIM = 128
MLA_Q_RANK = 512
MLA_KV_RANK = 256
SB_HEADS = 8
SB_HEAD_DIM = 128
MLA_OUT = MLA_HEADS * MLA_V_DIM
SB_OUT = SB_HEADS * SB_HEAD_DIM
D_MIX = MLA_OUT + SB_OUT
IN_SPLITS = (MLA_Q_RANK,
             MLA_Q_RANK + MLA_KV_RANK,
             MLA_Q_RANK + MLA_KV_RANK + MLA_ROPE_DIM,
             MLA_Q_RANK + MLA_KV_RANK + MLA_ROPE_DIM + SB_OUT,
             MLA_Q_RANK + MLA_KV_RANK + MLA_ROPE_DIM + 2 * SB_OUT)
IN_COLS = MLA_Q_RANK + MLA_KV_RANK + MLA_ROPE_DIM + 3 * SB_OUT
MEM_HEADS = 4
MEM_HEAD_DIM = 128
N_GROUPS = 4
EXPERTS_PER_GROUP = 8
N_EXPERTS = N_GROUPS * EXPERTS_PER_GROUP
TOP_K = 2
D_EXPERT = 512

Q_BLOCK = 128
ROPE_THETA = 10000.0
EPS = 1e-6

kernel_name = "hymba_mla_stickbreaking_hiermoe_block"


def rms_norm(x, g):
    xf = x.astype(jnp.float32)
    y = xf * lax.rsqrt(jnp.mean(xf * xf, axis=-1, keepdims=True) + EPS)
    return (y * g.astype(jnp.float32)).astype(x.dtype)


def rotary_tables(positions):
    inv_freq = ROPE_THETA ** (-jnp.arange(0, MLA_ROPE_DIM, 2, dtype=jnp.float32) / MLA_ROPE_DIM)
    ang = positions.astype(jnp.float32)[..., None] * inv_freq
    return jnp.cos(ang), jnp.sin(ang)


def apply_rope(x, cos, sin):
    x1, x2 = jnp.split(x.astype(jnp.float32), 2, axis=-1)
    return jnp.concatenate([x1 * cos - x2 * sin, x2 * cos + x1 * sin], axis=-1).astype(x.dtype)


def to_blocks(t):
    b, s, h, d = t.shape
    return t.reshape(b, s // Q_BLOCK, Q_BLOCK, h, d).transpose(1, 0, 3, 2, 4)


def from_blocks(o):
    nb, b, h, blk, d = o.shape
    return o.transpose(1, 0, 3, 2, 4).reshape(b, nb * blk, h, d)


def mla_attention(q, k, v):
    s_len = q.shape[1]
    scale = MLA_QK_DIM ** -0.5
    k_pos = jnp.arange(s_len)

    def block(args):
        q_blk, bi = args
        s = jnp.einsum('bhqd,bkhd->bhqk', q_blk, k).astype(jnp.float32) * scale
        q_pos = bi * Q_BLOCK + jnp.arange(Q_BLOCK)
        mask = k_pos[None, :] <= q_pos[:, None]
        p = jax.nn.softmax(jnp.where(mask, s, -jnp.inf), axis=-1).astype(v.dtype)
        return jnp.einsum('bhqk,bkhd->bhqd', p, v)

    o = lax.map(block, (to_blocks(q), jnp.arange(s_len // Q_BLOCK)))
    return from_blocks(o)


def stick_breaking_attention(q, k, v):
    s_len = q.shape[1]
    scale = SB_HEAD_DIM ** -0.5
    k_pos = jnp.arange(s_len)

    def block(args):
        q_blk, bi = args
        z = jnp.einsum('bhqd,bkhd->bhqk', q_blk, k).astype(jnp.float32) * scale
        q_pos = bi * Q_BLOCK + jnp.arange(Q_BLOCK)
        mask = k_pos[None, :] < q_pos[:, None]
        log_beta = jax.nn.log_sigmoid(z)
        log_1m = jnp.where(mask, jax.nn.log_sigmoid(-z), 0.0)
        later = lax.cumsum(log_1m, axis=3, reverse=True) - log_1m
        a = jnp.where(mask, jnp.exp(log_beta + later), 0.0).astype(v.dtype)
        return jnp.einsum('bhqk,bkhd->bhqd', a, v)

    o = lax.map(block, (to_blocks(q), jnp.arange(s_len // Q_BLOCK)))
    return from_blocks(o)


def memory_cross_attention(h, mem_n, w_q, w_kv, w_o):
    b, s, _ = h.shape
    m = mem_n.shape[1]
    q = (h @ w_q).reshape(b, s, MEM_HEADS, MEM_HEAD_DIM)
    kv = (mem_n @ w_kv).reshape(b, m, 2, MEM_HEADS, MEM_HEAD_DIM)
    k, v = kv[:, :, 0], kv[:, :, 1]
    sc = jnp.einsum('bshd,bmhd->bhsm', q, k).astype(jnp.float32) * (MEM_HEAD_DIM ** -0.5)
    p = jax.nn.softmax(sc, axis=-1).astype(v.dtype)
    o = jnp.einsum('bhsm,bmhd->bshd', p, v).reshape(b, s, MEM_HEADS * MEM_HEAD_DIM)
    return o @ w_o


def hierarchical_moe(h, w_group, b_group, w_expert_router, b_expert, w_gate, w_up, w_down):
    b, s, d = h.shape
    t = h.reshape(b * s, d)
    group_prob = jax.nn.softmax((t @ w_group).astype(jnp.float32) + b_group.astype(jnp.float32), axis=-1)
    p_g, g_idx = lax.top_k(group_prob, 1)
    exp_logits = ((t @ w_expert_router).astype(jnp.float32) + b_expert.astype(jnp.float32)
                  ).reshape(-1, N_GROUPS, EXPERTS_PER_GROUP)
    sel_logits = jnp.einsum('tg,tge->te', jax.nn.one_hot(g_idx[:, 0], N_GROUPS, dtype=jnp.float32), exp_logits)
    p_e, e_idx = lax.top_k(jax.nn.softmax(sel_logits, axis=-1), TOP_K)
    p_e = p_e / jnp.sum(p_e, axis=-1, keepdims=True)
    gates = p_g * p_e
    expert_id = g_idx * EXPERTS_PER_GROUP + e_idx
    combine = jnp.einsum('tk,tke->te', gates,
                         jax.nn.one_hot(expert_id, N_EXPERTS, dtype=jnp.float32)).astype(h.dtype)
    a = jnp.einsum('td,edf->tef', t, w_gate)
    u = jnp.einsum('td,edf->tef', t, w_up)
    act = jax.nn.silu(a) * u * combine[:, :, None]
    y = jnp.einsum('tef,efd->td', act, w_down)
    return y.reshape(b, s, d)


def setup_inputs(seed: int = 0) -> dict:
    key = jax.random.key(seed)
    ks = jax.random.split(key, 26)
    f32 = jnp.float32
    L = DEPTH

    def w(k, shape, fan_in):
        return jax.random.normal(k, shape, f32) * (fan_in ** -0.5)

    def gain(k, shape):
        return 1.0 + 0.02 * jax.random.normal(k, shape, f32)

    return {
        "x": jax.random.normal(ks[0], (BATCH, SEQ, D_MODEL), f32),
        "mem": jax.random.normal(ks[1], (BATCH, MEM_LEN, D_MODEL), f32),
        "positions": jnp.broadcast_to(jnp.arange(SEQ, dtype=jnp.int32), (BATCH, SEQ)),
        "norm_mix": gain(ks[2], (L, D_MODEL)),
        "w_in": w(ks[3], (L, D_MODEL, IN_COLS), D_MODEL),
        "norm_q_lat": gain(ks[4], (L, MLA_Q_RANK)),
        "w_q_b": w(ks[5], (L, MLA_Q_RANK, MLA_HEADS * MLA_QK_DIM), MLA_Q_RANK),
        "norm_kv_lat": gain(ks[6], (L, MLA_KV_RANK)),
        "w_kv_b": w(ks[7], (L, MLA_KV_RANK, MLA_HEADS * (MLA_NOPE_DIM + MLA_V_DIM)), MLA_KV_RANK),
        "norm_mla_out": gain(ks[8], (L, MLA_OUT)),
        "norm_sb_out": gain(ks[9], (L, SB_OUT)),
        "w_out": w(ks[10], (L, D_MIX, D_MODEL), D_MIX),
        "norm_mem_x": gain(ks[11], (L, D_MODEL)),
        "norm_mem_src": gain(ks[12], (L, D_MODEL)),
        "w_mem_q": w(ks[13], (L, D_MODEL, MEM_HEADS * MEM_HEAD_DIM), D_MODEL),
        "w_mem_kv": w(ks[14], (L, D_MODEL, 2 * MEM_HEADS * MEM_HEAD_DIM), D_MODEL),
        "w_mem_o": w(ks[15], (L, MEM_HEADS * MEM_HEAD_DIM, D_MODEL), MEM_HEADS * MEM_HEAD_DIM),
        "norm_ffn": gain(ks[16], (L, D_MODEL)),
        "w_group": w(ks[17], (L, D_MODEL, N_GROUPS), D_MODEL),
        "b_group": 0.01 * jax.random.normal(ks[18], (L, N_GROUPS), f32),
        "w_expert_router": w(ks[19], (L, D_MODEL, N_EXPERTS), D_MODEL),
        "b_expert": 0.01 * jax.random.normal(ks[20], (L, N_EXPERTS), f32),
        "w_gate": w(ks[21], (L, N_EXPERTS, D_MODEL, D_EXPERT), D_MODEL),
        "w_up": w(ks[22], (L, N_EXPERTS, D_MODEL, D_EXPERT), D_MODEL),
        "w_down": w(ks[23], (L, N_EXPERTS, D_EXPERT, D_MODEL), D_EXPERT),
        "norm_final": gain(ks[24], (D_MODEL,)),
    }


def reference(x, mem, positions, norm_mix, w_in, norm_q_lat, w_q_b, norm_kv_lat, w_kv_b,
              norm_mla_out, norm_sb_out, w_out, norm_mem_x, norm_mem_src, w_mem_q, w_mem_kv,
              w_mem_o, norm_ffn, w_group, b_group, w_expert_router, b_expert, w_gate, w_up,
              w_down, norm_final):
    b, s, _ = x.shape
    cos, sin = rotary_tables(positions)
    for l in range(DEPTH):
        h = rms_norm(x, norm_mix[l])
        proj = h @ w_in[l]
        c_q, c_kv, k_pe, q_sb, k_sb, v_sb = jnp.split(proj, IN_SPLITS, axis=-1)

        q = (rms_norm(c_q, norm_q_lat[l]) @ w_q_b[l]).reshape(b, s, MLA_HEADS, MLA_QK_DIM)
        q_nope, q_pe = q[..., :MLA_NOPE_DIM], q[..., MLA_NOPE_DIM:]
        kv = (rms_norm(c_kv, norm_kv_lat[l]) @ w_kv_b[l]).reshape(b, s, MLA_HEADS, MLA_NOPE_DIM + MLA_V_DIM)
        k_nope, v_mla = kv[..., :MLA_NOPE_DIM], kv[..., MLA_NOPE_DIM:]
        q_pe = apply_rope(q_pe, cos[:, :, None, :], sin[:, :, None, :])
        k_pe = apply_rope(k_pe, cos, sin)
        q_mla = jnp.concatenate([q_nope, q_pe], axis=-1)
        k_mla = jnp.concatenate(
            [k_nope, jnp.broadcast_to(k_pe[:, :, None, :], (b, s, MLA_HEADS, MLA_ROPE_DIM))], axis=-1)
        o_mla = mla_attention(q_mla, k_mla, v_mla).reshape(b, s, MLA_OUT)

        o_sb = stick_breaking_attention(q_sb.reshape(b, s, SB_HEADS, SB_HEAD_DIM),
                                        k_sb.reshape(b, s, SB_HEADS, SB_HEAD_DIM),
                                        v_sb.reshape(b, s, SB_HEADS, SB_HEAD_DIM)).reshape(b, s, SB_OUT)

        mixed = jnp.concatenate([rms_norm(o_mla, norm_mla_out[l]), rms_norm(o_sb, norm_sb_out[l])], axis=-1)
        x = x + mixed @ w_out[l]

        mem_n = rms_norm(mem, norm_mem_src[l])
        x = x + memory_cross_attention(rms_norm(x, norm_mem_x[l]), mem_n, w_mem_q[l], w_mem_kv[l], w_mem_o[l])

        x = x + hierarchical_moe(rms_norm(x, norm_ffn[l]), w_group[l], b_group[l], w_expert_router[l],
                                 b_expert[l], w_gate[l], w_up[l], w_down[l])
    return rms_norm(x, norm_final)
```

```cpp
#include <hip/hip_runtime.h>
#include <hip/hip_cooperative_groups.h>
#include <cstdio>
#include <cstdint>
namespace cg = cooperative_groups;

typedef unsigned short bf16_t;
typedef short bf16x8 __attribute__((ext_vector_type(8)));
typedef float f32x4 __attribute__((ext_vector_type(4)));
typedef float f32x16 __attribute__((ext_vector_type(16)));
typedef unsigned u32x4 __attribute__((ext_vector_type(4)));
typedef unsigned u32x2 __attribute__((ext_vector_type(2)));
typedef unsigned long long u64;

#define DEV __device__ __forceinline__

constexpr int D = 2048, NB = 2, S = 4096, T = NB * S;
constexpr int MEML = 256, MT = NB * MEML;
constexpr int NIN = 3968;
constexpr float EPS = 1e-6f;
constexpr float LOG2E = 1.4426950408889634f;
constexpr int NTHREADS = 256;
constexpr int LDS_MAIN = 65536;
constexpr int LDS_BYTES = LDS_MAIN + 1024;

constexpr size_t MB = 1024 * 1024;
constexpr size_t WS_CTL = 0;
constexpr size_t CTL_BAR = 0;
constexpr size_t CTL_CNT = 16384;
constexpr size_t CTL_SQ = 32768;
constexpr size_t CTL_BYTES = CTL_SQ + 6 * (size_t)T * 8;
constexpr size_t WS_WIN = 1 * MB;
constexpr size_t WS_WQB = WS_WIN + (size_t)NIN * D * 2;
constexpr size_t WS_WKVB = WS_WQB + 1536 * 512 * 2;
constexpr size_t WS_WOUT = WS_WKVB + 2048 * 256 * 2;
constexpr size_t WS_WMQ = WS_WOUT + (size_t)2048 * 2048 * 2;
constexpr size_t WS_WMKV = WS_WMQ + 512 * 2048 * 2;
constexpr size_t WS_WMO = WS_WMKV + 1024 * 2048 * 2;
constexpr size_t WS_WGU = WS_WMO + 2048 * 512 * 2;
constexpr size_t WS_WD = WS_WGU + (size_t)32 * 1024 * 2048 * 2;
constexpr size_t WS_WR = WS_WD + (size_t)32 * 2048 * 512 * 2;
constexpr size_t WS_H = WS_WR + 48 * 2048 * 4;
constexpr size_t WS_MEMN = WS_H + (size_t)T * D * 2;
constexpr size_t WS_ROPE = WS_MEMN + (size_t)MT * D * 2;
constexpr size_t WS_CQ = WS_ROPE + (size_t)T * 32 * 8;
constexpr size_t WS_CKV = WS_CQ + (size_t)T * 512 * 2;
constexpr size_t WS_QSB = WS_CKV + (size_t)T * 256 * 2;
constexpr size_t WS_KSB = WS_QSB + (size_t)T * 1024 * 2;
constexpr size_t WS_VSBT = WS_KSB + (size_t)T * 1024 * 2;
constexpr size_t WS_KPE = WS_VSBT + (size_t)T * 1024 * 2;
constexpr size_t WS_KMEM = WS_KPE + (size_t)T * 64 * 2;
constexpr size_t WS_VMEMT = WS_KMEM + (size_t)MT * 512 * 2;
constexpr size_t WS_QM = WS_VMEMT + (size_t)MT * 512 * 2;
constexpr size_t WS_KN = WS_QM + (size_t)T * 1536 * 2;
constexpr size_t WS_VMT = WS_KN + (size_t)T * 1024 * 2;
constexpr size_t WS_X1 = WS_VMT + (size_t)T * 1024 * 2;
constexpr size_t WS_ROUTE = WS_X1 + (size_t)T * D * 4;
constexpr size_t RT_SLOT = 0;
constexpr size_t RT_GATE = (size_t)T * 2 * 4;
constexpr size_t RT_EXP = RT_GATE + (size_t)T * 2 * 4;
constexpr size_t RT_POS = RT_EXP + (size_t)T * 2 * 4;
constexpr size_t RT_LIST = RT_POS + (size_t)T * 2 * 4;
constexpr size_t WS_END = WS_ROUTE + RT_LIST + (size_t)32 * T * 4;
constexpr size_t WS_OMIX = WS_H, WS_X2B = WS_H, WS_X1B = WS_QSB, WS_QMEM = WS_CQ, WS_OMEM = WS_KN, WS_ACT = WS_QM, WS_Y = WS_X1;
constexpr int ACT_ROWS_MAX = 2 * T + 32 * 128;

enum { SQ_CQ = 0, SQ_CKV, SQ_OMLA, SQ_OSB, SQ_X1, SQ_X2 };

struct P {
    const float* x; const float* mem; const int* pos;
    const float *norm_mix, *w_in, *norm_q_lat, *w_q_b, *norm_kv_lat, *w_kv_b, *norm_mla_out, *norm_sb_out, *w_out;
    const float *norm_mem_x, *norm_mem_src, *w_mem_q, *w_mem_kv, *w_mem_o, *norm_ffn, *w_group, *b_group, *w_er, *b_er;
    const float *w_gate, *w_up, *w_down, *norm_final;
    float* out; unsigned char* ws;
};

DEV unsigned cvt_pk_bf16(float lo, float hi) { unsigned r; asm("v_cvt_pk_bf16_f32 %0, %1, %2" : "=v"(r) : "v"(lo), "v"(hi)); return r; }
DEV float bf16_to_f32(bf16_t v) { return __uint_as_float(((unsigned)v) << 16); }
DEV float fexp2(float x) { return __builtin_amdgcn_exp2f(x); }
DEV float flog2(float x) { return __builtin_amdgcn_logf(x); }
DEV float wave_sum(float v) {
#pragma unroll
    for (int o = 32; o >= 1; o >>= 1) v += __shfl_xor(v, o);
    return v;
}
DEV void sq_add(u64* sq, int row, float partial) { atomicAdd(sq + row, (u64)__float2ull_rn(partial * 4294967296.0f)); }
DEV float sq_rs(const u64* sq, int row, float inv_n) {
    const u64 v = __hip_atomic_load(sq + row, __ATOMIC_RELAXED, __HIP_MEMORY_SCOPE_AGENT);
    const float ms = (float)((double)v * (1.0 / 4294967296.0)) * inv_n;
    return __builtin_amdgcn_rsqf(ms + EPS);
}
DEV int vperm4(int s0) { const int g = (s0 >> 2) & 3; const int gp = ((g & 1) << 1) | (g >> 1); return (s0 & ~15) | (gp << 2); }

#define XB_TMO      128
#define XB_XCNT(j)  (256  + 64 * (j))
#define XB_XSUB(j)  (1280 + 64 * (j))
#define XB_XGEN(j)  (2304 + 64 * (j))
#define XB_TOP      3328
#define XB_TOPGEN   3392
#define XCD_BAR_WORDS 3456
#define XB_SPIN_CAP (1u << 22)
#define LAS __attribute__((address_space(3)))
DEV unsigned xb_ld(unsigned* p) { return __hip_atomic_load(p, __ATOMIC_RELAXED, __HIP_MEMORY_SCOPE_AGENT); }
DEV unsigned xb_add(unsigned* p, unsigned v) { return __hip_atomic_fetch_add(p, v, __ATOMIC_RELAXED, __HIP_MEMORY_SCOPE_AGENT); }
DEV unsigned xb_xcc_id() { return (unsigned)__builtin_amdgcn_s_getreg((3 << 11) | 20) & 0xFu; }
#define XB_SPIN(cond, bar) do { unsigned _sp = 0; while (cond) { __builtin_amdgcn_s_sleep(1); \
    if ((++_sp & 255u) == 0u) { if (xb_ld(&(bar)[XB_TMO])) break; if (_sp > XB_SPIN_CAP) { atomicAdd(&(bar)[XB_TMO], 1u); break; } } } } while (0)
struct XcdBarrier { unsigned* bar; unsigned x; volatile unsigned* st; };
DEV XcdBarrier xcd_barrier_post(unsigned* bar, volatile unsigned* st) {
    XcdBarrier b; b.bar = bar; b.x = xb_xcc_id(); b.st = st;
    if (threadIdx.x == 0) (void)xb_add(&bar[XB_XCNT(b.x)], 1u);
    return b;
}
DEV void xcd_barrier_complete(unsigned* bar, unsigned x, unsigned& nloc, unsigned& nx) {
    const unsigned G = gridDim.x;
    unsigned sum, cnt, mine, sp = 0u;
    for (;;) {
        sum = 0u; cnt = 0u; mine = 0u;
#pragma unroll
        for (unsigned j = 0; j < 16; ++j) { const unsigned c = xb_ld(&bar[XB_XCNT(j)]); sum += c; cnt += (c > 0u) ? 1u : 0u; mine = (j == x) ? c : mine; }
        if (sum == G) break;
        __builtin_amdgcn_s_sleep(1);
        if ((++sp & 255u) == 0u) { if (xb_ld(&bar[XB_TMO])) break; if (sp > XB_SPIN_CAP) { atomicAdd(&bar[XB_TMO], 1u); break; } }
    }
    nloc = mine > 0u ? mine : 1u; nx = cnt > 0u ? cnt : 1u;
}
DEV void xcd_barrier(const XcdBarrier& b) {
    asm volatile("s_waitcnt vmcnt(0)" ::: "memory");
    __syncthreads();
    if (threadIdx.x == 0) {
        unsigned* bar = b.bar;
        __builtin_amdgcn_s_waitcnt(0);
        unsigned nloc = b.st[0], nx = b.st[1];
        if (nloc == 0u) { xcd_barrier_complete(bar, b.x, nloc, nx); b.st[0] = nloc; b.st[1] = nx; }
        const unsigned old = xb_add(&bar[XB_XSUB(b.x)], 1u);
        const unsigned gen = old / nloc;
        if (old + 1u == (gen + 1u) * nloc) {
            __builtin_amdgcn_fence(__ATOMIC_RELEASE, "agent");
            asm volatile("s_waitcnt vmcnt(0)" ::: "memory");
            const unsigned og = xb_add(&bar[XB_TOP], 1u);
            const unsigned tg = og / nx;
            if (og + 1u == (tg + 1u) * nx) xb_add(&bar[XB_TOPGEN], 1u);
            else XB_SPIN(xb_ld(&bar[XB_TOPGEN]) == tg, bar);
            __builtin_amdgcn_fence(__ATOMIC_ACQUIRE, "agent");
            xb_add(&bar[XB_XGEN(b.x)], 1u);
            asm volatile("s_waitcnt vmcnt(0)" ::: "memory");
        } else {
            XB_SPIN(xb_ld(&bar[XB_XGEN(b.x)]) == gen, bar);
            __builtin_amdgcn_fence(__ATOMIC_ACQUIRE, "agent");
            asm volatile("s_waitcnt vmcnt(0)" ::: "memory");
        }
    }
    __syncthreads();
}

struct XcdIter { int x, j, per; };
DEV XcdIter xcd_iter() { XcdIter r; const int G = gridDim.x; if ((G & 7) == 0) { r.x = blockIdx.x & 7; r.j = blockIdx.x >> 3; r.per = G >> 3; } else { r.x = -1; r.j = blockIdx.x; r.per = G; } return r; }

#define GLDS16(g, l) __builtin_amdgcn_global_load_lds((const unsigned*)(g), (LAS unsigned*)(l), 16, 0, 0)
typedef short s16x4 __attribute__((ext_vector_type(4)));
DEV int stage_col(int tid) { return (((tid & 7) ^ ((tid >> 3) & 7)) << 3); }
template <bool BF32>
DEV void gemm_acc(f32x4 (&acc)[4][4], unsigned char* lds, const bf16_t* a0, const bf16_t* a1, const bf16_t* a2, const bf16_t* a3,
                  const bf16_t* b0, const bf16_t* b1, const bf16_t* b2, const bf16_t* b3, const float* bf, int ldn, int nkt, bool swap) {
    int tid = threadIdx.x; asm volatile("" : "+v"(tid));
    const int lane = tid & 63, wid = tid >> 6, wr = wid >> 1, wc = wid & 1, fr = lane & 15, fq = lane >> 4;
    const int xbase = swap ? (16384 + wc * 8192) : (wr * 8192);
    const int ybase = swap ? (wr * 8192) : (16384 + wc * 8192);
    unsigned char* ldw = lds + wid * 1024;
    const int n4 = tid & 31, kr = tid >> 5;
    const int wofs = 16384 + kr * 256 + (n4 & 3) * 8, sl0 = ((n4 >> 2) ^ (kr & 3)) << 5, sl1 = ((n4 >> 2) ^ ((kr & 3) | 4)) << 5;
    const int tq = (lane >> 2) & 3, gq = tq | ((fq & 1) << 2);
    const int wrd = 16384 + (8 * fq + tq) * 256 + 8 * (lane & 3);
    f32x4 rb[8];
    auto stage_a = [&](int buf, int ko) { GLDS16(a0 + ko, ldw + buf); GLDS16(a1 + ko, ldw + buf + 4096); GLDS16(a2 + ko, ldw + buf + 8192); GLDS16(a3 + ko, ldw + buf + 12288); };
    auto stage_b = [&](int buf, int ko) { GLDS16(b0 + ko, ldw + buf + 16384); GLDS16(b1 + ko, ldw + buf + 16384 + 4096); GLDS16(b2 + ko, ldw + buf + 16384 + 8192); GLDS16(b3 + ko, ldw + buf + 16384 + 12288); };
    auto load_bf = [&](int kt) {
#pragma unroll
        for (int i = 0; i < 8; ++i) rb[i] = *(const f32x4*)(bf + (size_t)(kt * 64 + 8 * i) * ldn);
    };
    auto write_bf = [&](int buf) {
#pragma unroll
        for (int i = 0; i < 8; ++i) {
            u32x2 w; w.x = cvt_pk_bf16(rb[i][0], rb[i][1]); w.y = cvt_pk_bf16(rb[i][2], rb[i][3]);
            *(u32x2*)(lds + buf + wofs + i * 2048 + ((i & 1) ? sl1 : sl0)) = w;
        }
    };
    stage_a(0, 0);
    if (BF32) { load_bf(0); write_bf(0); } else stage_b(0, 0);
    asm volatile("s_waitcnt vmcnt(0)" ::: "memory");
    __syncthreads();
    for (int kt = 0; kt < nkt; ++kt) {
        const int cur = (kt & 1) * 32768, nxt = 32768 - cur;
        const bool more = (kt + 1 < nkt);
        if (more) { stage_a(nxt, (kt + 1) * 64); if (BF32) load_bf(kt + 1); else stage_b(nxt, (kt + 1) * 64); }
        __builtin_amdgcn_sched_barrier(0);
#pragma unroll
        for (int ks = 0; ks < 2; ++ks) {
            bf16x8 xf[4], yf[4];
            const int coff = (((ks * 4 + fq) ^ (fr & 7)) << 4) + fr * 128;
            if (BF32) {
#pragma unroll
                for (int i = 0; i < 4; ++i) {
                    const int o = cur + wrd + ks * 8192 + (((wc * 4 + i) ^ gq) << 5);
                    const s16x4 lo = __builtin_amdgcn_ds_read_tr16_b64_v4i16((LAS s16x4*)(lds + o));
                    const s16x4 hi = __builtin_amdgcn_ds_read_tr16_b64_v4i16((LAS s16x4*)(lds + o + 1024));
                    xf[i] = __builtin_shufflevector(lo, hi, 0, 1, 2, 3, 4, 5, 6, 7);
                    yf[i] = *(const bf16x8*)(lds + cur + wr * 8192 + i * 2048 + coff);
                }
            } else {
#pragma unroll
                for (int i = 0; i < 4; ++i) { xf[i] = *(const bf16x8*)(lds + cur + xbase + i * 2048 + coff); yf[i] = *(const bf16x8*)(lds + cur + ybase + i * 2048 + coff); }
            }
#pragma unroll
            for (int i = 0; i < 4; ++i)
#pragma unroll
                for (int j = 0; j < 4; ++j) acc[i][j] = __builtin_amdgcn_mfma_f32_16x16x32_bf16(xf[i], yf[j], acc[i][j], 0, 0, 0);
        }
        if (BF32 && more) write_bf(nxt);
        asm volatile("s_waitcnt vmcnt(0)" ::: "memory");
        __syncthreads();
    }
}
DEV void acc_zero(f32x4 (&acc)[4][4]) {
#pragma unroll
    for (int i = 0; i < 4; ++i)
#pragma unroll
        for (int j = 0; j < 4; ++j) acc[i][j] = (f32x4){0.f, 0.f, 0.f, 0.f};
}
DEV void gemm_dense(f32x4 (&acc)[4][4], unsigned char* lds, const bf16_t* A, int lda, int m0, const bf16_t* Bt, int ldb, int n0, int k0, int nkt, bool swap) {
    int tid = threadIdx.x; asm volatile("" : "+v"(tid));
    const int srow = tid >> 3, sc = stage_col(tid);
    const bf16_t* a = A + (size_t)(m0 + srow) * lda + k0 + sc;
    const bf16_t* b = Bt + (size_t)(n0 + srow) * ldb + k0 + sc;
    gemm_acc<false>(acc, lds, a, a + (size_t)32 * lda, a + (size_t)64 * lda, a + (size_t)96 * lda, b, b + (size_t)32 * ldb, b + (size_t)64 * ldb, b + (size_t)96 * ldb, nullptr, 0, nkt, swap);
}
DEV void gemm_dense_bf32(f32x4 (&acc)[4][4], unsigned char* lds, const bf16_t* A, int lda, int m0, const float* Bsrc, int ldn, int nkt) {
    int tid = threadIdx.x; asm volatile("" : "+v"(tid));
    const int srow = tid >> 3, sc = stage_col(tid);
    const bf16_t* a = A + (size_t)(m0 + srow) * lda + sc;
    const float* bf = Bsrc + (size_t)(tid >> 5) * ldn + (tid & 31) * 4;
    gemm_acc<true>(acc, lds, a, a + (size_t)32 * lda, a + (size_t)64 * lda, a + (size_t)96 * lda, nullptr, nullptr, nullptr, nullptr, bf, ldn, nkt, true);
}

template <class GainF, class RowF>
DEV void transpose_item(const float* src, int N, bf16_t* dst, int ldd, int k0, int n0, int lane, GainF gain, RowF dstrow) {
    const int ln = lane & 7, lk = lane >> 3;
    const int k = k0 + lk * 8, n = n0 + ln * 4;
    f32x4 v[8];
#pragma unroll
    for (int kk = 0; kk < 8; ++kk) v[kk] = *(const f32x4*)(src + (size_t)(k + kk) * N + n);
    float g[8];
#pragma unroll
    for (int kk = 0; kk < 8; ++kk) g[kk] = gain(k + kk);
#pragma unroll
    for (int j = 0; j < 4; ++j) {
        u32x4 w;
        w.x = cvt_pk_bf16(v[0][j] * g[0], v[1][j] * g[1]); w.y = cvt_pk_bf16(v[2][j] * g[2], v[3][j] * g[3]);
        w.z = cvt_pk_bf16(v[4][j] * g[4], v[5][j] * g[5]); w.w = cvt_pk_bf16(v[6][j] * g[6], v[7][j] * g[7]);
        *(u32x4*)(dst + (size_t)dstrow(n + j) * ldd + k) = w;
    }
}
DEV int rope_perm64(int i) { return i < 32 ? 2 * i : 2 * (i - 32) + 1; }

DEV void rms_row_to_bf16(const float* src, const float* g, bf16_t* dst, int lane) {
    f32x4 v[8]; float s = 0.f;
#pragma unroll
    for (int i = 0; i < 8; ++i) { v[i] = *(const f32x4*)(src + i * 256 + lane * 4); s += v[i][0] * v[i][0] + v[i][1] * v[i][1] + v[i][2] * v[i][2] + v[i][3] * v[i][3]; }
    s = wave_sum(s);
    const float rs = __builtin_amdgcn_rsqf(s * (1.0f / 2048.0f) + EPS);
#pragma unroll
    for (int i = 0; i < 8; ++i) {
        const f32x4 gg = *(const f32x4*)(g + i * 256 + lane * 4);
        u32x2 w; w.x = cvt_pk_bf16(v[i][0] * rs * gg[0], v[i][1] * rs * gg[1]); w.y = cvt_pk_bf16(v[i][2] * rs * gg[2], v[i][3] * rs * gg[3]);
        *(u32x2*)(dst + i * 256 + lane * 4) = w;
    }
}

DEV void phase0(const P& p) {
    const int lane = threadIdx.x & 63, gw = blockIdx.x * 4 + (threadIdx.x >> 6), NGW = gridDim.x * 4;
    unsigned char* ws = p.ws;
    constexpr int I_IN = 32 * 122, I_QB = 8 * 48, I_KVB = 4 * 64, I_OUT = 32 * 64, I_MQ = 32 * 16, I_MKV = 32 * 32, I_MO = 8 * 64;
    constexpr int NITEMS = I_IN + I_QB + I_KVB + I_OUT + I_MQ + I_MKV + I_MO;
    for (int it = gw; it < NITEMS; it += NGW) {
        int r = it;
        if (r < I_IN) { const int kt = r / 122, nt = r % 122;
            transpose_item(p.w_in, 3904, (bf16_t*)(ws + WS_WIN), D, kt * 64, nt * 32, lane, [](int) { return 1.0f; },
                [](int n) { return n < 768 ? n : (n < 832 ? 3840 + rope_perm64(n - 768) : n - 64); }); continue; }
        r -= I_IN;
        if (r < I_QB) { const int kt = r / 48, nt = r % 48; const float* g = p.norm_q_lat;
            transpose_item(p.w_q_b, 1536, (bf16_t*)(ws + WS_WQB), 512, kt * 64, nt * 32, lane, [g](int k) { return g[k]; },
                [](int n) { const int h = n / 192, d = n % 192; return h * 192 + (d < 128 ? d : 128 + rope_perm64(d - 128)); }); continue; }
        r -= I_QB;
        if (r < I_KVB) { const int kt = r / 64, nt = r % 64; const float* g = p.norm_kv_lat;
            transpose_item(p.w_kv_b, 2048, (bf16_t*)(ws + WS_WKVB), 256, kt * 64, nt * 32, lane, [g](int k) { return g[k]; }, [](int n) { return n; }); continue; }
        r -= I_KVB;
        if (r < I_OUT) { const int kt = r / 64, nt = r % 64; const float* g1 = p.norm_mla_out; const float* g2 = p.norm_sb_out;
            transpose_item(p.w_out, 2048, (bf16_t*)(ws + WS_WOUT), 2048, kt * 64, nt * 32, lane, [g1, g2](int k) { return k < 1024 ? g1[k] : g2[k - 1024]; }, [](int n) { return n; }); continue; }
        r -= I_OUT;
        if (r < I_MQ) { const int kt = r / 16, nt = r % 16; const float* g = p.norm_mem_x;
            transpose_item(p.w_mem_q, 512, (bf16_t*)(ws + WS_WMQ), 2048, kt * 64, nt * 32, lane, [g](int k) { return g[k]; }, [](int n) { return n; }); continue; }
        r -= I_MQ;
        if (r < I_MKV) { const int kt = r / 32, nt = r % 32;
            transpose_item(p.w_mem_kv, 1024, (bf16_t*)(ws + WS_WMKV), 2048, kt * 64, nt * 32, lane, [](int) { return 1.0f; }, [](int n) { return n; }); continue; }
        r -= I_MKV;
        { const int kt = r / 64, nt = r % 64;
            transpose_item(p.w_mem_o, 2048, (bf16_t*)(ws + WS_WMO), 512, kt * 64, nt * 32, lane, [](int) { return 1.0f; }, [](int n) { return n; }); }
    }
    {
        float* wr = (float*)(ws + WS_WR);
        for (int i = blockIdx.x * NTHREADS + threadIdx.x; i < 48 * 2048; i += gridDim.x * NTHREADS) {
            const int n = i >> 11, k = i & 2047;
            float v = 0.f;
            if (n < 4) v = p.w_group[k * 4 + n] * p.norm_ffn[k]; else if (n < 36) v = p.w_er[k * 32 + (n - 4)] * p.norm_ffn[k];
            wr[i] = v;
        }
    }
    {
        float* rt = (float*)(ws + WS_ROPE);
        for (int i = blockIdx.x * NTHREADS + threadIdx.x; i < T * 32; i += gridDim.x * NTHREADS) {
            const int t = i >> 5, f = i & 31;
            const float inv_freq = exp2f(-(float)f * (13.287712379549449f / 32.0f));
            const float ang = (float)p.pos[t] * inv_freq;
            const double turns = (double)ang * 0.15915494309189535;
            const float fr = (float)(turns - floor(turns));
            rt[2 * i] = __builtin_amdgcn_cosf(fr); rt[2 * i + 1] = __builtin_amdgcn_sinf(fr);
        }
    }
    for (int row = gw; row < T + MT; row += NGW) {
        if (row < T) rms_row_to_bf16(p.x + (size_t)row * D, p.norm_mix, (bf16_t*)(ws + WS_H) + (size_t)row * D, lane);
        else rms_row_to_bf16(p.mem + (size_t)(row - T) * D, p.norm_mem_src, (bf16_t*)(ws + WS_MEMN) + (size_t)(row - T) * D, lane);
    }
}

DEV void store_rowmajor_sq(const f32x4 (&acc)[4][4], bf16_t* dst, int ldd, int m0, int ncol0, u64* sq, float scale) {
    const int lane = threadIdx.x & 63, wid = threadIdx.x >> 6, wr = wid >> 1, wc = wid & 1, fr = lane & 15, fq = lane >> 4;
#pragma unroll
    for (int j = 0; j < 4; ++j) {
        const int m = m0 + wr * 64 + j * 16 + fr; float ss = 0.f;
#pragma unroll
        for (int i = 0; i < 4; ++i) {
            const f32x4 v = acc[i][j];
            ss += v[0] * v[0] + v[1] * v[1] + v[2] * v[2] + v[3] * v[3];
            u32x2 w; w.x = cvt_pk_bf16(v[0] * scale, v[1] * scale); w.y = cvt_pk_bf16(v[2] * scale, v[3] * scale);
            *(u32x2*)(dst + (size_t)m * ldd + ncol0 + wc * 64 + i * 16 + fq * 4) = w;
        }
        if (sq) { ss += __shfl_xor(ss, 16); ss += __shfl_xor(ss, 32); if (fq == 0) sq_add(sq, m, ss); }
    }
}
DEV void store_transposed(const f32x4 (&acc)[4][4], bf16_t* dst, int L, int s0, const float* rs  ) {
    const int lane = threadIdx.x & 63, wid = threadIdx.x >> 6, wr = wid >> 1, wc = wid & 1, fr = lane & 15, fq = lane >> 4;
#pragma unroll
    for (int i = 0; i < 4; ++i) {
        const int ml = wr * 64 + i * 16 + fq * 4;
        float r0 = 1.f, r1 = 1.f, r2 = 1.f, r3 = 1.f;
        if (rs) { r0 = rs[ml]; r1 = rs[ml + 1]; r2 = rs[ml + 2]; r3 = rs[ml + 3]; }
        const int pos = vperm4(s0 + ml);
#pragma unroll
        for (int j = 0; j < 4; ++j) {
            const int n = wc * 64 + j * 16 + fr; const f32x4 v = acc[i][j];
            u32x2 w; w.x = cvt_pk_bf16(v[0] * r0, v[1] * r1); w.y = cvt_pk_bf16(v[2] * r2, v[3] * r3);
            *(u32x2*)(dst + (size_t)n * L + pos) = w;
        }
    }
}

DEV void phase1(const P& p, unsigned char* lds, bool dry = false) {
    unsigned char* ws = p.ws;
    const XcdIter xi = xcd_iter();
    const int lane = threadIdx.x & 63, wid = threadIdx.x >> 6, wr = wid >> 1, wc = wid & 1, fr = lane & 15, fq = lane >> 4;
    u64* sqb = (u64*)(ws + CTL_SQ);
    u64* sq_cq = dry ? nullptr : sqb + SQ_CQ * T; u64* sq_ckv = dry ? nullptr : sqb + SQ_CKV * T;
    const int per_x = 8 * 31 + 4, total = 64 * 31 + 32;
    for (int it = 0;; ++it) {
        int mt, nt; bool memkv = false;
        if (xi.x >= 0) { const int i = it * xi.per + xi.j; if (i >= per_x) break;
            if (i < 248) { mt = xi.x * 8 + (i & 7); nt = i >> 3; } else { memkv = true; const int q = xi.x * 4 + (i - 248); mt = q & 3; nt = q >> 2; } }
        else { const int i = it * xi.per + xi.j; if (i >= total) break;
            if (i < 1984) { mt = i & 63; nt = i >> 6; } else { memkv = true; const int q = i - 1984; mt = q & 3; nt = q >> 2; } }
        f32x4 acc[4][4]; acc_zero(acc);
        if (memkv) {
            const bool isv = nt >= 4;
            gemm_dense(acc, lds, (const bf16_t*)(ws + WS_MEMN), D, mt * 128, (const bf16_t*)(ws + WS_WMKV), D, nt * 128, 0, 32, !isv);
            const int b = mt >> 1, mm0 = (mt & 1) * 128;
            if (!isv) store_rowmajor_sq(acc, (bf16_t*)(ws + WS_KMEM) + (size_t)((b * 4 + nt) * 256) * 128, 128, mm0, 0, nullptr, 1.0f);
            else store_transposed(acc, (bf16_t*)(ws + WS_VMEMT) + (size_t)((b * 4 + (nt - 4)) * 128) * 256, 256, mm0, nullptr);
            continue;
        }
        const bool isv = (nt >= 22 && nt < 30);
        gemm_dense(acc, lds, (const bf16_t*)(ws + WS_H), D, mt * 128, (const bf16_t*)(ws + WS_WIN), D, nt * 128, 0, 32, !isv);
        const int m0 = mt * 128, b = m0 >> 12, s0 = m0 & 4095;
        if (nt < 4) store_rowmajor_sq(acc, (bf16_t*)(ws + WS_CQ), 512, m0, nt * 128, sq_cq, 1.0f);
        else if (nt < 6) store_rowmajor_sq(acc, (bf16_t*)(ws + WS_CKV), 256, m0, (nt - 4) * 128, sq_ckv, 1.0f);
        else if (nt < 14) store_rowmajor_sq(acc, (bf16_t*)(ws + WS_QSB) + (size_t)((b * 8 + (nt - 6)) * S) * 128, 128, s0, 0, nullptr, 0.08838834764831845f * LOG2E);
        else if (nt < 22) store_rowmajor_sq(acc, (bf16_t*)(ws + WS_KSB) + (size_t)((b * 8 + (nt - 14)) * S) * 128, 128, s0, 0, nullptr, 1.0f);
        else if (nt < 30) store_transposed(acc, (bf16_t*)(ws + WS_VSBT) + (size_t)((b * 8 + (nt - 22)) * 128) * S, S, s0, nullptr);
        else if (wc == 0) {
            const float* rt = (const float*)(ws + WS_ROPE);
            bf16_t* kpe = (bf16_t*)(ws + WS_KPE);
#pragma unroll
            for (int j = 0; j < 4; ++j) {
                const int m = m0 + wr * 64 + j * 16 + fr;
#pragma unroll
                for (int i = 0; i < 4; ++i) {
                    const int n = i * 16 + fq * 4; const f32x4 v = acc[i][j];
                    const f32x4 cs = *(const f32x4*)(rt + ((size_t)m * 32 + (n >> 1)) * 2);
                    u32x2 w; w.x = cvt_pk_bf16(v[0] * cs[0] - v[1] * cs[1], v[1] * cs[0] + v[0] * cs[1]);
                    w.y = cvt_pk_bf16(v[2] * cs[2] - v[3] * cs[3], v[3] * cs[2] + v[2] * cs[3]);
                    *(u32x2*)(kpe + (size_t)m * 64 + n) = w;
                }
            }
        }
    }
}

DEV void phase2(const P& p, unsigned char* lds) {
    unsigned char* ws = p.ws;
    const XcdIter xi = xcd_iter();
    const int lane = threadIdx.x & 63, wid = threadIdx.x >> 6, wr = wid >> 1, wc = wid & 1, fr = lane & 15, fq = lane >> 4;
    const u64* sqb = (const u64*)(ws + CTL_SQ);
    const int per_x = 8 * 28, total = 64 * 28;
    for (int it = 0;; ++it) {
        int mt, nt;
        if (xi.x >= 0) { const int i = it * xi.per + xi.j; if (i >= per_x) break; mt = xi.x * 8 + (i & 7); nt = i >> 3; }
        else { const int i = it * xi.per + xi.j; if (i >= total) break; mt = i & 63; nt = i >> 6; }
        const int m0 = mt * 128, b = m0 >> 12, s0 = m0 & 4095;
        f32x4 acc[4][4]; acc_zero(acc);
        if (nt < 12) {
            gemm_dense(acc, lds, (const bf16_t*)(ws + WS_CQ), 512, m0, (const bf16_t*)(ws + WS_WQB), 512, nt * 128, 0, 8, true);
            const float* rt = (const float*)(ws + WS_ROPE);
            bf16_t* qm = (bf16_t*)(ws + WS_QM);
            const float qs = 0.07216878364870322f * LOG2E;
#pragma unroll
            for (int j = 0; j < 4; ++j) {
                const int m = m0 + wr * 64 + j * 16 + fr, s = s0 + wr * 64 + j * 16 + fr;
                const float rs = sq_rs(sqb + SQ_CQ * T, m, 1.0f / 512.0f) * qs;
#pragma unroll
                for (int i = 0; i < 4; ++i) {
                    const int n = nt * 128 + wc * 64 + i * 16 + fq * 4, h = n / 192, d = n - h * 192;
                    f32x4 v = acc[i][j] * rs;
                    if (d >= 128) {
                        const f32x4 cs = *(const f32x4*)(rt + ((size_t)m * 32 + ((d - 128) >> 1)) * 2);
                        v = (f32x4){v[0] * cs[0] - v[1] * cs[1], v[1] * cs[0] + v[0] * cs[1], v[2] * cs[2] - v[3] * cs[3], v[3] * cs[2] + v[2] * cs[3]};
                    }
                    u32x2 w; w.x = cvt_pk_bf16(v[0], v[1]); w.y = cvt_pk_bf16(v[2], v[3]);
                    *(u32x2*)(qm + ((size_t)(b * 8 + h) * S + s) * 192 + d) = w;
                }
            }
        } else {
            const int nk = nt - 12, h = nk >> 1; const bool isv = nk & 1;
            gemm_dense(acc, lds, (const bf16_t*)(ws + WS_CKV), 256, m0, (const bf16_t*)(ws + WS_WKVB), 256, nk * 128, 0, 4, !isv);
            if (!isv) {
                bf16_t* kn = (bf16_t*)(ws + WS_KN) + (size_t)((b * 8 + h) * S) * 128;
#pragma unroll
                for (int j = 0; j < 4; ++j) {
                    const int ml = wr * 64 + j * 16 + fr;
                    const float rs = sq_rs(sqb + SQ_CKV * T, m0 + ml, 1.0f / 256.0f);
#pragma unroll
                    for (int i = 0; i < 4; ++i) {
                        const f32x4 v = acc[i][j] * rs;
                        u32x2 w; w.x = cvt_pk_bf16(v[0], v[1]); w.y = cvt_pk_bf16(v[2], v[3]);
                        *(u32x2*)(kn + (size_t)(s0 + ml) * 128 + wc * 64 + i * 16 + fq * 4) = w;
                    }
                }
            } else {
                bf16_t* vt = (bf16_t*)(ws + WS_VMT) + (size_t)((b * 8 + h) * 128) * S;
#pragma unroll
                for (int i = 0; i < 4; ++i) {
                    const int ml = wr * 64 + i * 16 + fq * 4;
                    const float r0 = sq_rs(sqb + SQ_CKV * T, m0 + ml, 1.0f / 256.0f), r1 = sq_rs(sqb + SQ_CKV * T, m0 + ml + 1, 1.0f / 256.0f);
                    const float r2 = sq_rs(sqb + SQ_CKV * T, m0 + ml + 2, 1.0f / 256.0f), r3 = sq_rs(sqb + SQ_CKV * T, m0 + ml + 3, 1.0f / 256.0f);
                    const int pos = vperm4(s0 + ml);
#pragma unroll
                    for (int j = 0; j < 4; ++j) {
                        const int n = wc * 64 + j * 16 + fr; const f32x4 v = acc[i][j];
                        u32x2 w; w.x = cvt_pk_bf16(v[0] * r0, v[1] * r1); w.y = cvt_pk_bf16(v[2] * r2, v[3] * r3);
                        *(u32x2*)(vt + (size_t)n * S + pos) = w;
                    }
                }
            }
        }
    }
}

template <int DQK> struct KStage {
    static constexpr int NIG = DQK / 64;
    u32x4 r[2][NIG];
    const bf16_t* gm; const bf16_t* gp; int l0, l1;
    DEV void init(const bf16_t* Kmain, const bf16_t* Kpe, int t) {
        const int row = t >> 3, c = t & 7;
        gm = Kmain + (size_t)row * 128 + c * 8; gp = (DQK == 192) ? Kpe + (size_t)row * 64 + c * 8 : nullptr;
        if (DQK == 128) { const int lo = row * 256 + ((c ^ (row & 7)) << 4), b3 = (row >> 3) & 1; l0 = lo + (b3 ? 128 : 0); l1 = lo + (b3 ? 0 : 128); }
        else { l0 = row * 384 + ((c ^ ((row >> 1) & 7)) << 4); l1 = l0 + 128; }
    }
    DEV void load(int tile) {
#pragma unroll
        for (int ps = 0; ps < 2; ++ps) {
            const bf16_t* g = gm + ((size_t)tile * 64 + ps * 32) * 128;
            r[ps][0] = *(const u32x4*)g; r[ps][1] = *(const u32x4*)(g + 64);
            if (DQK == 192) r[ps][NIG - 1] = *(const u32x4*)(gp + ((size_t)tile * 64 + ps * 32) * 64);
        }
    }
    DEV void write(unsigned char* ldsK) {
#pragma unroll
        for (int ps = 0; ps < 2; ++ps) {
            *(u32x4*)(ldsK + l0 + ps * 32 * DQK * 2) = r[ps][0]; *(u32x4*)(ldsK + l1 + ps * 32 * DQK * 2) = r[ps][1];
            if (DQK == 192) *(u32x4*)(ldsK + l0 + 256 + ps * 32 * DQK * 2) = r[ps][NIG - 1];
        }
    }
};
struct VStage {
    u32x4 r[4]; const bf16_t* g; int l; size_t rstride;
    DEV void init(const bf16_t* VT, int LV, int t) { const int row = t >> 3, c = t & 7; g = VT + (size_t)row * LV + c * 8; rstride = (size_t)32 * LV; l = row * 128 + ((c ^ ((row >> 1) & 7)) << 4); }
    DEV void load(int tile) {
#pragma unroll
        for (int i = 0; i < 4; ++i) r[i] = *(const u32x4*)(g + i * rstride + (size_t)tile * 64);
    }
    DEV void write(unsigned char* ldsV) {
#pragma unroll
        for (int i = 0; i < 4; ++i) *(u32x4*)(ldsV + l + i * 4096) = r[i];
    }
};
template <int DQK> DEV int kfrag_off(int krow, int ks, int hh) {
    const int c = 2 * ks + hh;
    if (DQK == 128) return krow * 256 + ((c ^ (krow & 15)) << 4);
    else return krow * 384 + ((((c & ~7) | ((c & 7) ^ ((krow >> 1) & 7)))) << 4);
}
DEV int vfrag_off(int r, int c) { return r * 128 + ((c ^ ((r >> 1) & 7)) << 4); }

template <int DQK, bool CAUSAL>
DEV void attn_unit(unsigned char* lds, const bf16_t* Q, const bf16_t* Kmain, const bf16_t* Kpe, const bf16_t* VT, int LV, int q0, int ntiles,
                   bf16_t* O, int ldo, u64* sq  , int orow0) {
    constexpr int NKS = DQK / 16, KTILE_BYTES = 64 * DQK * 2;
    int tid = threadIdx.x; asm volatile("" : "+v"(tid));
    const int lane = tid & 63, wid = tid >> 6, pr = wid >> 1, kh = wid & 1, l31 = lane & 31, hh = lane >> 5;
    unsigned char* ldsK = lds; unsigned char* ldsV = lds + KTILE_BYTES;
    bf16x8 qf[NKS];
    { const bf16_t* qp = Q + (size_t)(q0 + pr * 32 + l31) * DQK + hh * 8;
#pragma unroll
      for (int ks = 0; ks < NKS; ++ks) qf[ks] = *(const bf16x8*)(qp + ks * 16); }
    f32x16 oacc[4];
#pragma unroll
    for (int i = 0; i < 4; ++i)
#pragma unroll
        for (int r = 0; r < 16; ++r) oacc[i][r] = 0.f;
    float mrun = -1e30f, lrun = 0.f;
    KStage<DQK> ksg; VStage vsg;
    ksg.init(Kmain, Kpe, tid); vsg.init(VT, LV, tid);
    const int krow = kh * 32 + l31;
    int ka[DQK == 128 ? 8 : 4];
#pragma unroll
    for (int i = 0; i < (DQK == 128 ? 8 : 4); ++i) ka[i] = kfrag_off<DQK>(krow, i, hh);
    const int va0 = vfrag_off(l31, kh * 4 + hh), va1 = vfrag_off(l31, kh * 4 + 2 + hh);
    ksg.load(0); vsg.load(0); ksg.write(ldsK); vsg.write(ldsV); __syncthreads();
    const int qpos = q0 + pr * 32 + l31;
    for (int t = 0; t < ntiles; ++t) {
        const bool more = t + 1 < ntiles;
        if (more) { ksg.load(t + 1); vsg.load(t + 1); }
        __builtin_amdgcn_sched_barrier(0);
        const bool diag = CAUSAL && (t == ntiles - 1);
        if (!(diag && pr == 0 && kh == 1)) {
            f32x16 sacc;
#pragma unroll
            for (int r = 0; r < 16; ++r) sacc[r] = 0.f;
#pragma unroll
            for (int ks = 0; ks < NKS; ++ks) {
                const int off = (DQK == 128) ? ka[ks] : (ka[ks & 3] + 128 * (ks >> 2));
                const bf16x8 kf = *(const bf16x8*)(ldsK + off);
                sacc = __builtin_amdgcn_mfma_f32_32x32x16_bf16(kf, qf[ks], sacc, 0, 0, 0);
            }
            if (diag) {
                const int kbase = t * 64 + kh * 32 + 4 * hh;
#pragma unroll
                for (int r = 0; r < 16; ++r) { const int kp = kbase + (r & 3) + 8 * (r >> 2); if (kp > qpos) sacc[r] = -1e30f; }
            }
            float mx = sacc[0];
#pragma unroll
            for (int r = 1; r < 16; ++r) mx = fmaxf(mx, sacc[r]);
            mx = fmaxf(mx, __shfl_xor(mx, 32));
            const float mnew = fmaxf(mrun, mx), alpha = fexp2(mrun - mnew);
            mrun = mnew;
            float ps = 0.f;
#pragma unroll
            for (int r = 0; r < 16; ++r) { sacc[r] = fexp2(sacc[r] - mnew); ps += sacc[r]; }
            lrun = lrun * alpha + ps;
#pragma unroll
            for (int i = 0; i < 4; ++i)
#pragma unroll
                for (int r = 0; r < 16; ++r) oacc[i][r] *= alpha;
#pragma unroll
            for (int s2 = 0; s2 < 2; ++s2) {
                u32x4 pw; pw.x = cvt_pk_bf16(sacc[8 * s2 + 0], sacc[8 * s2 + 1]); pw.y = cvt_pk_bf16(sacc[8 * s2 + 2], sacc[8 * s2 + 3]);
                pw.z = cvt_pk_bf16(sacc[8 * s2 + 4], sacc[8 * s2 + 5]); pw.w = cvt_pk_bf16(sacc[8 * s2 + 6], sacc[8 * s2 + 7]);
                bf16x8 pf; __builtin_memcpy(&pf, &pw, 16);
#pragma unroll
                for (int dvb = 0; dvb < 4; ++dvb) {
                    const bf16x8 vf = *(const bf16x8*)(ldsV + (s2 ? va1 : va0) + dvb * 4096);
                    oacc[dvb] = __builtin_amdgcn_mfma_f32_32x32x16_bf16(vf, pf, oacc[dvb], 0, 0, 0);
                }
            }
        }
        __syncthreads();
        if (more) { ksg.write(ldsK); vsg.write(ldsV); }
        __syncthreads();
    }
    float lw = lrun + __shfl_xor(lrun, 32);
    float* xo = (float*)(lds + pr * 20480);
    if (kh == 1) {
#pragma unroll
        for (int i = 0; i < 4; ++i)
#pragma unroll
            for (int r = 0; r < 16; ++r) xo[(i * 16 + r) * 64 + lane] = oacc[i][r];
        xo[4096 + lane] = mrun; xo[4096 + 64 + lane] = lw;
    }
    __syncthreads();
    if (kh == 0) {
        const float m1 = xo[4096 + lane], l1 = xo[4096 + 64 + lane];
        const float m = fmaxf(mrun, m1), f0 = fexp2(mrun - m), f1 = fexp2(m1 - m);
        const float inv = 1.0f / (lw * f0 + l1 * f1);
        const float c0 = f0 * inv, c1 = f1 * inv;
        float ss = 0.f;
        bf16_t* op = O + (size_t)(orow0 + pr * 32 + l31) * ldo;
#pragma unroll
        for (int i = 0; i < 4; ++i)
#pragma unroll
            for (int rq = 0; rq < 4; ++rq) {
                float v[4];
#pragma unroll
                for (int e = 0; e < 4; ++e) { const int r = rq * 4 + e; v[e] = oacc[i][r] * c0 + xo[(i * 16 + r) * 64 + lane] * c1; ss += v[e] * v[e]; }
                u32x2 w; w.x = cvt_pk_bf16(v[0], v[1]); w.y = cvt_pk_bf16(v[2], v[3]);
                *(u32x2*)(op + i * 32 + 8 * rq + 4 * hh) = w;
            }
        if (sq) { ss += __shfl_xor(ss, 32); if (hh == 0) sq_add(sq, orow0 + pr * 32 + l31, ss); }
    }
    __syncthreads();
}

DEV void sb_unit(unsigned char* lds, const bf16_t* Q, const bf16_t* K, const bf16_t* VT, int U, bf16_t* O  , u64* sq, int tok0) {
    constexpr int KTILE_BYTES = 64 * 128 * 2;
    int tid = threadIdx.x; asm volatile("" : "+v"(tid));
    const int lane = tid & 63, wid = tid >> 6, l31 = lane & 31, hh = lane >> 5;
    unsigned char* ldsK = lds; unsigned char* ldsV = lds + KTILE_BYTES;
    volatile int* flags = (volatile int*)(lds + LDS_MAIN + 64);
    const int q0 = U * 128 + wid * 32, qpos = q0 + l31;
    bf16x8 qf[8];
    { const bf16_t* qp = Q + (size_t)qpos * 128 + hh * 8;
#pragma unroll
      for (int ks = 0; ks < 8; ++ks) qf[ks] = *(const bf16x8*)(qp + ks * 16); }
    f32x16 oacc[4];
#pragma unroll
    for (int i = 0; i < 4; ++i)
#pragma unroll
        for (int r = 0; r < 16; ++r) oacc[i][r] = 0.f;
    float R = 0.f;
    KStage<128> ksg; VStage vsg;
    ksg.init(K, nullptr, tid); vsg.init(VT, S, tid);
    int ka[8];
#pragma unroll
    for (int i = 0; i < 8; ++i) ka[i] = kfrag_off<128>(l31, i, hh);
    const int va[4] = {vfrag_off(l31, hh), vfrag_off(l31, 2 + hh), vfrag_off(l31, 4 + hh), vfrag_off(l31, 6 + hh)};
    int t = 2 * U + 1;
    ksg.load(t); vsg.load(t); ksg.write(ldsK); vsg.write(ldsV); __syncthreads();
    for (; t >= 0; --t) {
        const bool more = t > 0;
        if (more) { ksg.load(t - 1); vsg.load(t - 1); }
        __builtin_amdgcn_sched_barrier(0);
        const int kt0 = t * 64;
        if (kt0 < q0 + 31) {
            const bool need_mask = (kt0 + 63 >= q0);
#pragma unroll
            for (int kb = 1; kb >= 0; --kb) {
                f32x16 z;
#pragma unroll
                for (int r = 0; r < 16; ++r) z[r] = 0.f;
#pragma unroll
                for (int ks = 0; ks < 8; ++ks) {
                    const bf16x8 kf = *(const bf16x8*)(ldsK + ka[ks] + kb * 8192);
                    z = __builtin_amdgcn_mfma_f32_32x32x16_bf16(kf, qf[ks], z, 0, 0, 0);
                }
                float l1m[16];
#pragma unroll
                for (int r = 0; r < 16; ++r) {
                    const float zz = z[r];
                    const float sp = fmaxf(zz, 0.f) + flog2(1.0f + fexp2(-fabsf(zz)));
                    const int kp = kt0 + kb * 32 + (r & 3) + 8 * (r >> 2) + 4 * hh;
                    const bool ok = !need_mask || (kp < qpos);
                    l1m[r] = ok ? -sp : 0.f;
                    z[r] = ok ? zz : -1e30f;
                }
                float gs[4], pgs[4];
#pragma unroll
                for (int g = 0; g < 4; ++g) { gs[g] = (l1m[4 * g] + l1m[4 * g + 1]) + (l1m[4 * g + 2] + l1m[4 * g + 3]); pgs[g] = __shfl_xor(gs[g], 32); }
                float tail = 0.f;
#pragma unroll
                for (int g = 3; g >= 0; --g) {
                    const float sg = R + tail + (hh == 0 ? pgs[g] : 0.f);
                    const float e2 = l1m[4 * g + 3], e1 = e2 + l1m[4 * g + 2], e0 = e1 + l1m[4 * g + 1];
                    z[4 * g + 3] = fexp2(z[4 * g + 3] + l1m[4 * g + 3] + sg);
                    z[4 * g + 2] = fexp2(z[4 * g + 2] + l1m[4 * g + 2] + sg + e2);
                    z[4 * g + 1] = fexp2(z[4 * g + 1] + l1m[4 * g + 1] + sg + e1);
                    z[4 * g + 0] = fexp2(z[4 * g + 0] + l1m[4 * g + 0] + sg + e0);
                    tail += gs[g] + pgs[g];
                }
                R += tail;
#pragma unroll
                for (int s2 = 0; s2 < 2; ++s2) {
                    u32x4 pw; pw.x = cvt_pk_bf16(z[8 * s2 + 0], z[8 * s2 + 1]); pw.y = cvt_pk_bf16(z[8 * s2 + 2], z[8 * s2 + 3]);
                    pw.z = cvt_pk_bf16(z[8 * s2 + 4], z[8 * s2 + 5]); pw.w = cvt_pk_bf16(z[8 * s2 + 6], z[8 * s2 + 7]);
                    bf16x8 pf; __builtin_memcpy(&pf, &pw, 16);
#pragma unroll
                    for (int dvb = 0; dvb < 4; ++dvb) {
                        const bf16x8 vf = *(const bf16x8*)(ldsV + va[kb * 2 + s2] + dvb * 4096);
                        oacc[dvb] = __builtin_amdgcn_mfma_f32_32x32x16_bf16(vf, pf, oacc[dvb], 0, 0, 0);
                    }
                }
            }
        }
        const bool wdone = __all(R < -160.0f);
        if (lane == 0) flags[wid] = wdone ? 1 : 0;
        __syncthreads();
        const bool alldone = (flags[0] & flags[1] & flags[2] & flags[3]) != 0;
        if (alldone || !more) break;
        ksg.write(ldsK); vsg.write(ldsV);
        __syncthreads();
    }
    __syncthreads();
    float ss = 0.f;
    bf16_t* op = O + (size_t)qpos * 2048;
#pragma unroll
    for (int i = 0; i < 4; ++i)
#pragma unroll
        for (int rq = 0; rq < 4; ++rq) {
            const float v0 = oacc[i][rq * 4], v1 = oacc[i][rq * 4 + 1], v2 = oacc[i][rq * 4 + 2], v3 = oacc[i][rq * 4 + 3];
            ss += v0 * v0 + v1 * v1 + v2 * v2 + v3 * v3;
            u32x2 w; w.x = cvt_pk_bf16(v0, v1); w.y = cvt_pk_bf16(v2, v3);
            *(u32x2*)(op + i * 32 + 8 * rq + 4 * hh) = w;
        }
    ss += __shfl_xor(ss, 32); if (sq && hh == 0) sq_add(sq, tok0 + qpos, ss);
}

DEV void phase3(const P& p, unsigned char* lds, bool dry = false) {
    unsigned char* ws = p.ws;
    u64* sqb = (u64*)(ws + CTL_SQ);
    bf16_t* omix = (bf16_t*)(ws + WS_OMIX);
    const int G = gridDim.x;
    for (int w = blockIdx.x; w < 512; w += G) {
        const int bh = w >> 5, uu = w & 31, b = bh >> 3, h = bh & 7;
#pragma unroll 1
        for (int half = 0; half < 2; ++half) {
            const int u = half ? (63 - uu) : uu;
            attn_unit<192, true>(lds, (const bf16_t*)(ws + WS_QM) + (size_t)bh * S * 192, (const bf16_t*)(ws + WS_KN) + (size_t)bh * S * 128,
                                 (const bf16_t*)(ws + WS_KPE) + (size_t)b * S * 64, (const bf16_t*)(ws + WS_VMT) + (size_t)bh * 128 * S, S, u * 64, u + 1,
                                 omix + (size_t)b * S * 2048 + h * 128, 2048, dry ? nullptr : sqb + SQ_OMLA * T + b * S, u * 64);
        }
    }
    for (int w = blockIdx.x; w < 512; w += G) {
        const int bh = w >> 5, U = w & 31, b = bh >> 3, h = bh & 7;
        sb_unit(lds, (const bf16_t*)(ws + WS_QSB) + (size_t)bh * S * 128, (const bf16_t*)(ws + WS_KSB) + (size_t)bh * S * 128,
                (const bf16_t*)(ws + WS_VSBT) + (size_t)bh * 128 * S, U, omix + (size_t)b * S * 2048 + 1024 + h * 128, dry ? nullptr : sqb + SQ_OSB * T, b * S);
    }
}

DEV void phase4(const P& p, unsigned char* lds, bool dry = false) {
    unsigned char* ws = p.ws;
    const XcdIter xi = xcd_iter();
    const int lane = threadIdx.x & 63, wid = threadIdx.x >> 6, wr = wid >> 1, wc = wid & 1, fr = lane & 15, fq = lane >> 4;
    u64* sqb = (u64*)(ws + CTL_SQ);
    float* x1 = (float*)(ws + WS_X1); bf16_t* x1b = (bf16_t*)(ws + WS_X1B);
    const int per_x = 8 * 16, total = 64 * 16;
    for (int it = 0;; ++it) {
        int mt, nt;
        if (xi.x >= 0) { const int i = it * xi.per + xi.j; if (i >= per_x) break; mt = xi.x * 8 + (i & 7); nt = i >> 3; }
        else { const int i = it * xi.per + xi.j; if (i >= total) break; mt = i & 63; nt = i >> 6; }
        const int m0 = mt * 128;
        f32x4 acc[4][4]; acc_zero(acc);
        gemm_dense(acc, lds, (const bf16_t*)(ws + WS_OMIX), D, m0, (const bf16_t*)(ws + WS_WOUT), D, nt * 128, 0, 16, true);
        float rsb[4];
#pragma unroll
        for (int j = 0; j < 4; ++j) {
            const int m = m0 + wr * 64 + j * 16 + fr;
            const float ra = sq_rs(sqb + SQ_OMLA * T, m, 1.0f / 1024.0f); rsb[j] = sq_rs(sqb + SQ_OSB * T, m, 1.0f / 1024.0f);
            const float ratio = ra / rsb[j];
#pragma unroll
            for (int i = 0; i < 4; ++i) acc[i][j] *= ratio;
        }
        gemm_dense(acc, lds, (const bf16_t*)(ws + WS_OMIX), D, m0, (const bf16_t*)(ws + WS_WOUT), D, nt * 128, 1024, 16, true);
#pragma unroll
        for (int j = 0; j < 4; ++j) {
            const int m = m0 + wr * 64 + j * 16 + fr; float ss = 0.f;
#pragma unroll
            for (int i = 0; i < 4; ++i) {
                const int n = nt * 128 + wc * 64 + i * 16 + fq * 4;
                const f32x4 xv = *(const f32x4*)(p.x + (size_t)m * D + n);
                const f32x4 v = xv + acc[i][j] * rsb[j];
                ss += v[0] * v[0] + v[1] * v[1] + v[2] * v[2] + v[3] * v[3];
                *(f32x4*)(x1 + (size_t)m * D + n) = v;
                u32x2 w; w.x = cvt_pk_bf16(v[0], v[1]); w.y = cvt_pk_bf16(v[2], v[3]);
                *(u32x2*)(x1b + (size_t)m * D + n) = w;
            }
            ss += __shfl_xor(ss, 16); ss += __shfl_xor(ss, 32); if (fq == 0 && !dry) sq_add(sqb + SQ_X1 * T, m, ss);
        }
    }
}

DEV void phase5(const P& p, unsigned char* lds) {
    unsigned char* ws = p.ws;
    const XcdIter xi = xcd_iter();
    const int lane = threadIdx.x & 63, wid = threadIdx.x >> 6, wr = wid >> 1, wc = wid & 1, fr = lane & 15, fq = lane >> 4;
    const u64* sqb = (const u64*)(ws + CTL_SQ);
    const int per_x = 8 * 4, total = 64 * 4;
    for (int it = 0;; ++it) {
        int mt, nt;
        if (xi.x >= 0) { const int i = it * xi.per + xi.j; if (i >= per_x) break; mt = xi.x * 8 + (i & 7); nt = i >> 3; }
        else { const int i = it * xi.per + xi.j; if (i >= total) break; mt = i & 63; nt = i >> 6; }
        const int m0 = mt * 128, b = m0 >> 12, s0 = m0 & 4095;
        f32x4 acc[4][4]; acc_zero(acc);
        gemm_dense(acc, lds, (const bf16_t*)(ws + WS_X1B), D, m0, (const bf16_t*)(ws + WS_WMQ), D, nt * 128, 0, 32, true);
        bf16_t* qm = (bf16_t*)(ws + WS_QMEM) + (size_t)((b * 4 + nt) * S) * 128;
#pragma unroll
        for (int j = 0; j < 4; ++j) {
            const int ml = wr * 64 + j * 16 + fr;
            const float rs = sq_rs(sqb + SQ_X1 * T, m0 + ml, 1.0f / 2048.0f) * (0.08838834764831845f * LOG2E);
#pragma unroll
            for (int i = 0; i < 4; ++i) {
                const f32x4 v = acc[i][j] * rs;
                u32x2 w; w.x = cvt_pk_bf16(v[0], v[1]); w.y = cvt_pk_bf16(v[2], v[3]);
                *(u32x2*)(qm + (size_t)(s0 + ml) * 128 + wc * 64 + i * 16 + fq * 4) = w;
            }
        }
    }
}

DEV void phase6(const P& p, unsigned char* lds) {
    unsigned char* ws = p.ws;
    for (int w = blockIdx.x; w < 512; w += gridDim.x) {
        const int bh = w >> 6, u = w & 63, b = bh >> 2, h = bh & 3;
        attn_unit<128, false>(lds, (const bf16_t*)(ws + WS_QMEM) + (size_t)bh * S * 128, (const bf16_t*)(ws + WS_KMEM) + (size_t)bh * 256 * 128, nullptr,
                              (const bf16_t*)(ws + WS_VMEMT) + (size_t)bh * 128 * 256, 256, u * 64, 4,
                              (bf16_t*)(ws + WS_OMEM) + (size_t)b * S * 512 + h * 128, 512, nullptr, u * 64);
    }
}

DEV void phase7(const P& p, unsigned char* lds, bool dry = false) {
    unsigned char* ws = p.ws;
    const XcdIter xi = xcd_iter();
    const int lane = threadIdx.x & 63, wid = threadIdx.x >> 6, wr = wid >> 1, wc = wid & 1, fr = lane & 15, fq = lane >> 4;
    u64* sqb = (u64*)(ws + CTL_SQ);
    const float* x1 = (const float*)(ws + WS_X1); bf16_t* x2b = (bf16_t*)(ws + WS_X2B);
    const int per_x = 8 * 16, total = 64 * 16;
    for (int it = 0;; ++it) {
        int mt, nt;
        if (xi.x >= 0) { const int i = it * xi.per + xi.j; if (i >= per_x) break; mt = xi.x * 8 + (i & 7); nt = i >> 3; }
        else { const int i = it * xi.per + xi.j; if (i >= total) break; mt = i & 63; nt = i >> 6; }
        const int m0 = mt * 128;
        f32x4 acc[4][4]; acc_zero(acc);
        gemm_dense(acc, lds, (const bf16_t*)(ws + WS_OMEM), 512, m0, (const bf16_t*)(ws + WS_WMO), 512, nt * 128, 0, 8, true);
#pragma unroll
        for (int j = 0; j < 4; ++j) {
            const int m = m0 + wr * 64 + j * 16 + fr; float ss = 0.f;
#pragma unroll
            for (int i = 0; i < 4; ++i) {
                const int n = nt * 128 + wc * 64 + i * 16 + fq * 4;
                const f32x4 v = *(const f32x4*)(x1 + (size_t)m * D + n) + acc[i][j];
                ss += v[0] * v[0] + v[1] * v[1] + v[2] * v[2] + v[3] * v[3];
                *(f32x4*)(p.out + (size_t)m * D + n) = v;
                const f32x4 gf = *(const f32x4*)(p.norm_ffn + n);
                u32x2 w; w.x = cvt_pk_bf16(v[0] * gf[0], v[1] * gf[1]); w.y = cvt_pk_bf16(v[2] * gf[2], v[3] * gf[3]);
                *(u32x2*)(x2b + (size_t)m * D + n) = w;
            }
            ss += __shfl_xor(ss, 16); ss += __shfl_xor(ss, 32); if (fq == 0 && !dry) sq_add(sqb + SQ_X2 * T, m, ss);
        }
    }
}

DEV void phase8(const P& p, unsigned char* lds) {
    unsigned char* ws = p.ws;
    const int tid = threadIdx.x, lane = tid & 63, wid = tid >> 6, r16 = lane & 15, kq = lane >> 4;
    const float* wrt = (const float*)(ws + WS_WR);
    const u64* sqb = (const u64*)(ws + CTL_SQ);
    unsigned* cnt = (unsigned*)(ws + CTL_CNT);
    unsigned char* rt = ws + WS_ROUTE;
    float* red = (float*)lds;
    for (int tb = blockIdx.x; tb < T / 16; tb += gridDim.x) {
        const int t0 = tb * 16;
        f32x4 acc[3];
#pragma unroll
        for (int c = 0; c < 3; ++c) acc[c] = (f32x4){0.f, 0.f, 0.f, 0.f};
        const float* xa = p.out + (size_t)(t0 + r16) * D + wid * 512 + kq * 4;
        const float* wb = wrt + (size_t)r16 * D + wid * 512 + kq * 4;
#pragma unroll 4
        for (int k = 0; k < 512; k += 16) {
            const f32x4 a = *(const f32x4*)(xa + k);
            const f32x4 b0 = *(const f32x4*)(wb + k), b1 = *(const f32x4*)(wb + 16 * D + k), b2 = *(const f32x4*)(wb + 32 * D + k);
#pragma unroll
            for (int e = 0; e < 4; ++e) {
                acc[0] = __builtin_amdgcn_mfma_f32_16x16x4f32(a[e], b0[e], acc[0], 0, 0, 0);
                acc[1] = __builtin_amdgcn_mfma_f32_16x16x4f32(a[e], b1[e], acc[1], 0, 0, 0);
                acc[2] = __builtin_amdgcn_mfma_f32_16x16x4f32(a[e], b2[e], acc[2], 0, 0, 0);
            }
        }
#pragma unroll
        for (int c = 0; c < 3; ++c)
#pragma unroll
            for (int e = 0; e < 4; ++e) red[(wid * 16 + kq * 4 + e) * 48 + c * 16 + r16] = acc[c][e];
        __syncthreads();
        if (tid < 16) {
            const int tok = t0 + tid;
            const float rs = sq_rs(sqb + SQ_X2 * T, tok, 1.0f / 2048.0f);
            auto logit = [&](int n) { return ((red[(0 * 16 + tid) * 48 + n] + red[(1 * 16 + tid) * 48 + n]) + (red[(2 * 16 + tid) * 48 + n] + red[(3 * 16 + tid) * 48 + n])) * rs; };
            float lg0 = logit(0) + p.b_group[0], lg1 = logit(1) + p.b_group[1], lg2 = logit(2) + p.b_group[2], lg3 = logit(3) + p.b_group[3];
            int g = 0; float gm = lg0;
            if (lg1 > gm) { gm = lg1; g = 1; }
            if (lg2 > gm) { gm = lg2; g = 2; }
            if (lg3 > gm) { gm = lg3; g = 3; }
            const float gden = __expf(lg0 - gm) + __expf(lg1 - gm) + __expf(lg2 - gm) + __expf(lg3 - gm);
            const float pg = 1.0f / gden;
            float el[8];
#pragma unroll
            for (int e = 0; e < 8; ++e) el[e] = logit(4 + g * 8 + e) + p.b_er[g * 8 + e];
            int e1 = 0; float m1 = el[0];
#pragma unroll
            for (int e = 1; e < 8; ++e) if (el[e] > m1) { m1 = el[e]; e1 = e; }
            int e2 = -1; float m2 = -3.0e38f;
#pragma unroll
            for (int e = 0; e < 8; ++e) if (e != e1 && el[e] > m2) { m2 = el[e]; e2 = e; }
            const float x2e = __expf(m2 - m1);
            const float p1 = 1.0f / (1.0f + x2e), p2 = x2e / (1.0f + x2e);
            const int ex1 = g * 8 + e1, ex2 = g * 8 + e2;
            const unsigned pos1 = atomicAdd(cnt + ex1, 1u), pos2 = atomicAdd(cnt + ex2, 1u);
            int* rexp = (int*)(rt + RT_EXP); int* rpos = (int*)(rt + RT_POS); float* rgate = (float*)(rt + RT_GATE); int* rlist = (int*)(rt + RT_LIST);
            rexp[tok * 2] = ex1; rexp[tok * 2 + 1] = ex2; rpos[tok * 2] = (int)pos1; rpos[tok * 2 + 1] = (int)pos2;
            rgate[tok * 2] = pg * p1; rgate[tok * 2 + 1] = pg * p2;
            rlist[ex1 * T + pos1] = tok * 2; rlist[ex2 * T + pos2] = tok * 2 + 1;
        }
        __syncthreads();
    }
}

DEV int moe_table(const P& p, int* tbl  ) {
    const unsigned* cnt = (const unsigned*)(p.ws + CTL_CNT);
    if (threadIdx.x < 64) {
        const int e = threadIdx.x & 31;
        const int c = (int)__hip_atomic_load(cnt + e, __ATOMIC_RELAXED, __HIP_MEMORY_SCOPE_AGENT);
        const int nt = (c + 127) >> 7;
        int incl = nt;
#pragma unroll
        for (int o = 1; o < 32; o <<= 1) { const int v = __shfl_up(incl, o, 32); if (e >= o) incl += v; }
        if (threadIdx.x < 32) { tbl[e] = incl - nt; tbl[33 + e] = c; if (e == 31) tbl[32] = incl; }
    }
    __syncthreads();
    return tbl[32];
}
DEV int moe_find(const int* tbl, int mtile) { int e = 0;
#pragma unroll 1
    for (int k = 16; k >= 1; k >>= 1) if (e + k < 32 && tbl[e + k] <= mtile) e += k;
    return e; }

DEV void phase9(const P& p, unsigned char* lds) {
    unsigned char* ws = p.ws;
    int* tbl = (int*)(lds + LDS_MAIN + 256);
    const int ntm = moe_table(p, tbl);
    const int tid = threadIdx.x, lane = tid & 63, wid = tid >> 6, wr = wid >> 1, wc = wid & 1, fr = lane & 15, fq = lane >> 4;
    const int srow = tid >> 3, sc = stage_col(tid);
    const u64* sqb = (const u64*)(ws + CTL_SQ);
    const int* rlist = (const int*)(ws + WS_ROUTE + RT_LIST); const float* rgate = (const float*)(ws + WS_ROUTE + RT_GATE);
    const bf16_t* x2b = (const bf16_t*)(ws + WS_X2B);
    bf16_t* act = (bf16_t*)(ws + WS_ACT);
    for (int item = blockIdx.x; item < ntm * 8; item += gridDim.x) {
        const int mtile = item >> 3, nt = item & 7;
        const int e = moe_find(tbl, mtile), mi = mtile - tbl[e], cnt = tbl[33 + e];
        const int* le = rlist + (size_t)e * T;
        const bf16_t* ap[4];
#pragma unroll
        for (int i = 0; i < 4; ++i) { int li = mi * 128 + srow + 32 * i; li = li < cnt ? li : cnt - 1; ap[i] = x2b + (size_t)(le[li] >> 1) * D + sc; }
        const int np = (tid & 31) * 4, bi = (np >> 4) & 3;
        const float* bf = ((bi & 1) ? p.w_up : p.w_gate) + (size_t)e * 2048 * 512 + (size_t)(tid >> 5) * 512 + nt * 64 + (np >> 6) * 32 + (bi >> 1) * 16 + (np & 15);
        f32x4 acc[4][4]; acc_zero(acc);
        gemm_acc<true>(acc, lds, ap[0], ap[1], ap[2], ap[3], nullptr, nullptr, nullptr, nullptr, bf, 512, 32, true);
#pragma unroll
        for (int j = 0; j < 4; ++j) {
            const int ml = wr * 64 + j * 16 + fr; int li = mi * 128 + ml; li = li < cnt ? li : cnt - 1;
            const int ent = le[li], tok = ent >> 1;
            const float rs = sq_rs(sqb + SQ_X2 * T, tok, 1.0f / 2048.0f), gt = rgate[ent];
#pragma unroll
            for (int q = 0; q < 2; ++q) {
                const f32x4 a = acc[2 * q][j] * rs, u = acc[2 * q + 1][j] * rs;
                float o[4];
#pragma unroll
                for (int c = 0; c < 4; ++c) o[c] = a[c] / (1.0f + __expf(-a[c])) * u[c] * gt;
                u32x2 w; w.x = cvt_pk_bf16(o[0], o[1]); w.y = cvt_pk_bf16(o[2], o[3]);
                *(u32x2*)(act + (size_t)(mtile * 128 + ml) * 512 + nt * 64 + wc * 32 + q * 16 + fq * 4) = w;
            }
        }
    }
}

DEV void phase10(const P& p, unsigned char* lds) {
    unsigned char* ws = p.ws;
    int* tbl = (int*)(lds + LDS_MAIN + 256);
    const int ntm = moe_table(p, tbl);
    const int tid = threadIdx.x, lane = tid & 63, wid = tid >> 6, wr = wid >> 1, wc = wid & 1, fr = lane & 15, fq = lane >> 4;
    const int* rlist = (const int*)(ws + WS_ROUTE + RT_LIST);
    bf16_t* y = (bf16_t*)(ws + WS_Y);
    for (int item = blockIdx.x; item < ntm * 16; item += gridDim.x) {
        const int mtile = item >> 4, nt = item & 15;
        const int e = moe_find(tbl, mtile), mi = mtile - tbl[e], cnt = tbl[33 + e];
        const int* le = rlist + (size_t)e * T;
        f32x4 acc[4][4]; acc_zero(acc);
        gemm_dense_bf32(acc, lds, (const bf16_t*)(ws + WS_ACT), 512, mtile * 128, p.w_down + (size_t)e * 512 * 2048 + nt * 128, 2048, 8);
#pragma unroll
        for (int j = 0; j < 4; ++j) {
            const int ml = wr * 64 + j * 16 + fr, li = mi * 128 + ml;
            if (li < cnt) {
                const int ent = le[li], tok = ent >> 1, k = ent & 1;
                bf16_t* yp = y + ((size_t)k * T + tok) * D + nt * 128 + wc * 64 + fq * 4;
#pragma unroll
                for (int i = 0; i < 4; ++i) { const f32x4 v = acc[i][j]; u32x2 w; w.x = cvt_pk_bf16(v[0], v[1]); w.y = cvt_pk_bf16(v[2], v[3]); *(u32x2*)(yp + i * 16) = w; }
            }
        }
    }
}

DEV void phase11(const P& p) {
    const int lane = threadIdx.x & 63, gw = blockIdx.x * 4 + (threadIdx.x >> 6), NGW = gridDim.x * 4;
    const bf16_t* y = (const bf16_t*)(p.ws + WS_Y);
    for (int row = gw; row < T; row += NGW) {
        float* xr = p.out + (size_t)row * D;
        const bf16_t* y0 = y + (size_t)row * D; const bf16_t* y1 = y + ((size_t)T + row) * D;
        f32x4 v[8]; float s = 0.f;
#pragma unroll
        for (int i = 0; i < 8; ++i) {
            const int c = i * 256 + lane * 4;
            v[i] = *(const f32x4*)(xr + c);
            const u32x2 a = *(const u32x2*)(y0 + c), b = *(const u32x2*)(y1 + c);
            v[i][0] += __uint_as_float(a.x << 16) + __uint_as_float(b.x << 16);
            v[i][1] += __uint_as_float(a.x & 0xffff0000u) + __uint_as_float(b.x & 0xffff0000u);
            v[i][2] += __uint_as_float(a.y << 16) + __uint_as_float(b.y << 16);
            v[i][3] += __uint_as_float(a.y & 0xffff0000u) + __uint_as_float(b.y & 0xffff0000u);
            s += v[i][0] * v[i][0] + v[i][1] * v[i][1] + v[i][2] * v[i][2] + v[i][3] * v[i][3];
        }
        s = wave_sum(s);
        const float rs = __builtin_amdgcn_rsqf(s * (1.0f / 2048.0f) + EPS);
#pragma unroll
        for (int i = 0; i < 8; ++i) {
            const int c = i * 256 + lane * 4;
            const f32x4 g = *(const f32x4*)(p.norm_final + c);
            *(f32x4*)(xr + c) = v[i] * rs * g;
        }
    }
}

#ifndef USE_CG_SYNC
#define USE_CG_SYNC 0
#endif
__global__ void __launch_bounds__(NTHREADS, 2) hymba_fwd(P p) {
    extern __shared__ __attribute__((aligned(16))) unsigned char lds[];
    cg::grid_group grid = cg::this_grid();
    volatile unsigned* st = (volatile unsigned*)(lds + LDS_MAIN);
    if (threadIdx.x < 16) st[threadIdx.x] = 0u;
    __syncthreads();
    XcdBarrier bar = xcd_barrier_post((unsigned*)(p.ws + CTL_BAR), st);
#if USE_CG_SYNC
#define GRID_BAR() grid.sync()
#else
#define GRID_BAR() xcd_barrier(bar)
#endif
#ifndef PROBE_REPEAT
#define PROBE_REPEAT 0
#endif
#define REP(n) ((PROBE_REPEAT >> (n)) & 1)
    phase0(p);        GRID_BAR();
    if (REP(0)) { phase0(p); GRID_BAR(); }
    phase1(p, lds);   GRID_BAR();
    if (REP(1)) { phase1(p, lds, true); GRID_BAR(); }
    phase2(p, lds);   GRID_BAR();
    if (REP(2)) { phase2(p, lds); GRID_BAR(); }
    phase3(p, lds);   GRID_BAR();
    if (REP(3)) { phase3(p, lds, true); GRID_BAR(); }
    phase4(p, lds);   GRID_BAR();
    if (REP(4)) { phase4(p, lds, true); GRID_BAR(); }
    phase5(p, lds);   GRID_BAR();
    if (REP(5)) { phase5(p, lds); GRID_BAR(); }
    phase6(p, lds);   GRID_BAR();
    if (REP(6)) { phase6(p, lds); GRID_BAR(); }
    phase7(p, lds);   GRID_BAR();
    if (REP(7)) { phase7(p, lds, true); GRID_BAR(); }
    phase8(p, lds);   GRID_BAR();
    phase9(p, lds);   GRID_BAR();
    if (REP(9)) { phase9(p, lds); GRID_BAR(); }
    phase10(p, lds);  GRID_BAR();
    if (REP(10)) { phase10(p, lds); GRID_BAR(); }
    phase11(p);
    grid.sync();
    (void)bar;
}

extern "C" void kernel_launch(void* const* d_in, const int* in_sizes, int n_in, void* d_out, int out_size, void* d_ws, size_t ws_size, hipStream_t stream) {
    static int grid = 0;
    if (grid == 0) {
        if (n_in != 26 || out_size != T * D || ws_size < WS_END) {
            fprintf(stderr, "kernel_launch: unexpected shapes: n_in %d out %d ws %zu (need %zu)\n", n_in, out_size, ws_size, (size_t)WS_END); grid = -1; return; }
        int dev = 0, cus = 0, per_cu = 0;
        hipGetDevice(&dev);
        hipDeviceGetAttribute(&cus, hipDeviceAttributeMultiprocessorCount, dev);
        if (hipFuncSetAttribute((const void*)hymba_fwd, hipFuncAttributeMaxDynamicSharedMemorySize, LDS_BYTES) != hipSuccess) { fprintf(stderr, "kernel_launch: hipFuncSetAttribute failed\n"); grid = -1; return; }
        if (hipOccupancyMaxActiveBlocksPerMultiprocessor(&per_cu, (const void*)hymba_fwd, NTHREADS, LDS_BYTES) != hipSuccess || per_cu < 1) { fprintf(stderr, "kernel_launch: occupancy query failed (%d)\n", per_cu); grid = -1; return; }
        if (per_cu > 2) per_cu = 2;
        grid = cus * per_cu;
        fprintf(stderr, "kernel_launch: %d CUs x %d blocks\n", cus, per_cu);
    }
    if (grid < 0) return;
    hipMemsetAsync(d_ws, 0, CTL_BYTES, stream);
    P p{};
    p.x = (const float*)d_in[0]; p.mem = (const float*)d_in[1]; p.pos = (const int*)d_in[2];
    p.norm_mix = (const float*)d_in[3]; p.w_in = (const float*)d_in[4]; p.norm_q_lat = (const float*)d_in[5]; p.w_q_b = (const float*)d_in[6];
    p.norm_kv_lat = (const float*)d_in[7]; p.w_kv_b = (const float*)d_in[8]; p.norm_mla_out = (const float*)d_in[9]; p.norm_sb_out = (const float*)d_in[10];
    p.w_out = (const float*)d_in[11]; p.norm_mem_x = (const float*)d_in[12]; p.norm_mem_src = (const float*)d_in[13]; p.w_mem_q = (const float*)d_in[14];
    p.w_mem_kv = (const float*)d_in[15]; p.w_mem_o = (const float*)d_in[16]; p.norm_ffn = (const float*)d_in[17]; p.w_group = (const float*)d_in[18];
    p.b_group = (const float*)d_in[19]; p.w_er = (const float*)d_in[20]; p.b_er = (const float*)d_in[21]; p.w_gate = (const float*)d_in[22];
    p.w_up = (const float*)d_in[23]; p.w_down = (const float*)d_in[24]; p.norm_final = (const float*)d_in[25];
    p.out = (float*)d_out; p.ws = (unsigned char*)d_ws;
    void* args[] = {&p};
    hipError_t e = hipLaunchCooperativeKernel((const void*)hymba_fwd, dim3(grid), dim3(NTHREADS), args, LDS_BYTES, stream);
    if (e != hipSuccess) fprintf(stderr, "kernel_launch: cooperative launch failed: %s (grid %d)\n", hipGetErrorString(e), grid);
}
```

```cpp
#include <hip/hip_runtime.h>
#include <hip/hip_cooperative_groups.h>
#include <cstdio>
#include <cstdint>
namespace cg = cooperative_groups;

typedef unsigned short bf16_t;
typedef short bf16x8 __attribute__((ext_vector_type(8)));
typedef float f32x4 __attribute__((ext_vector_type(4)));
typedef float f32x16 __attribute__((ext_vector_type(16)));
typedef unsigned u32x4 __attribute__((ext_vector_type(4)));
typedef unsigned u32x2 __attribute__((ext_vector_type(2)));
typedef unsigned long long u64;

#define DEV __device__ __forceinline__

constexpr int D = 2048, NB = 2, S = 4096, T = NB * S;
constexpr int MEML = 256, MT = NB * MEML;
constexpr int NIN = 3968;
constexpr float EPS = 1e-6f;
constexpr float LOG2E = 1.4426950408889634f;
constexpr int NTHREADS = 256;
constexpr int LDS_MAIN = 65536;
constexpr int LDS_BYTES = LDS_MAIN + 1024;

constexpr size_t MB = 1024 * 1024;
constexpr size_t WS_CTL = 0;
constexpr size_t CTL_BAR = 0;
constexpr size_t CTL_CNT = 16384;
constexpr size_t CTL_SQ = 32768;
constexpr size_t CTL_BYTES = CTL_SQ + 6 * (size_t)T * 8;
constexpr size_t WS_WIN = 1 * MB;
constexpr size_t WS_WQB = WS_WIN + (size_t)NIN * D * 2;
constexpr size_t WS_WKVB = WS_WQB + 1536 * 512 * 2;
constexpr size_t WS_WOUT = WS_WKVB + 2048 * 256 * 2;
constexpr size_t WS_WMQ = WS_WOUT + (size_t)2048 * 2048 * 2;
constexpr size_t WS_WMKV = WS_WMQ + 512 * 2048 * 2;
constexpr size_t WS_WMO = WS_WMKV + 1024 * 2048 * 2;
constexpr size_t WS_WGU = WS_WMO + 2048 * 512 * 2;
constexpr size_t WS_WD = WS_WGU + (size_t)32 * 1024 * 2048 * 2;
constexpr size_t WS_WR = WS_WD + (size_t)32 * 2048 * 512 * 2;
constexpr size_t WS_H = WS_WR + 48 * 2048 * 4;
constexpr size_t WS_MEMN = WS_H + (size_t)T * D * 2;
constexpr size_t WS_ROPE = WS_MEMN + (size_t)MT * D * 2;
constexpr size_t WS_CQ = WS_ROPE + (size_t)T * 32 * 8;
constexpr size_t WS_CKV = WS_CQ + (size_t)T * 512 * 2;
constexpr size_t WS_QSB = WS_CKV + (size_t)T * 256 * 2;
constexpr size_t WS_KSB = WS_QSB + (size_t)T * 1024 * 2;
constexpr size_t WS_VSBT = WS_KSB + (size_t)T * 1024 * 2;
constexpr size_t WS_KPE = WS_VSBT + (size_t)T * 1024 * 2;
constexpr size_t WS_KMEM = WS_KPE + (size_t)T * 64 * 2;
constexpr size_t WS_VMEMT = WS_KMEM + (size_t)MT * 512 * 2;
constexpr size_t WS_QM = WS_VMEMT + (size_t)MT * 512 * 2;
constexpr size_t WS_KN = WS_QM + (size_t)T * 1536 * 2;
constexpr size_t WS_VMT = WS_KN + (size_t)T * 1024 * 2;
constexpr size_t WS_X1 = WS_VMT + (size_t)T * 1024 * 2;
constexpr size_t WS_ROUTE = WS_X1 + (size_t)T * D * 4;
constexpr size_t RT_SLOT = 0;
constexpr size_t RT_GATE = (size_t)T * 2 * 4;
constexpr size_t RT_EXP = RT_GATE + (size_t)T * 2 * 4;
constexpr size_t RT_POS = RT_EXP + (size_t)T * 2 * 4;
constexpr size_t RT_LIST = RT_POS + (size_t)T * 2 * 4;
constexpr size_t WS_END = WS_ROUTE + RT_LIST + (size_t)32 * T * 4;
constexpr size_t WS_OMIX = WS_H, WS_X2B = WS_H, WS_X1B = WS_QSB, WS_QMEM = WS_CQ, WS_OMEM = WS_KN, WS_ACT = WS_QM, WS_Y = WS_X1;
constexpr int ACT_ROWS_MAX = 2 * T + 32 * 128;

enum { SQ_CQ = 0, SQ_CKV, SQ_OMLA, SQ_OSB, SQ_X1, SQ_X2 };

struct P {
    const float* x; const float* mem; const int* pos;
    const float *norm_mix, *w_in, *norm_q_lat, *w_q_b, *norm_kv_lat, *w_kv_b, *norm_mla_out, *norm_sb_out, *w_out;
    const float *norm_mem_x, *norm_mem_src, *w_mem_q, *w_mem_kv, *w_mem_o, *norm_ffn, *w_group, *b_group, *w_er, *b_er;
    const float *w_gate, *w_up, *w_down, *norm_final;
    float* out; unsigned char* ws;
};

DEV unsigned cvt_pk_bf16(float lo, float hi) { unsigned r; asm("v_cvt_pk_bf16_f32 %0, %1, %2" : "=v"(r) : "v"(lo), "v"(hi)); return r; }
DEV float bf16_to_f32(bf16_t v) { return __uint_as_float(((unsigned)v) << 16); }
DEV float fexp2(float x) { return __builtin_amdgcn_exp2f(x); }
DEV float flog2(float x) { return __builtin_amdgcn_logf(x); }
DEV float wave_sum(float v) {
#pragma unroll
    for (int o = 32; o >= 1; o >>= 1) v += __shfl_xor(v, o);
    return v;
}
DEV void sq_add(u64* sq, int row, float partial) { atomicAdd(sq + row, (u64)__float2ull_rn(partial * 4294967296.0f)); }
DEV float sq_rs(const u64* sq, int row, float inv_n) {
    const u64 v = __hip_atomic_load(sq + row, __ATOMIC_RELAXED, __HIP_MEMORY_SCOPE_AGENT);
    const float ms = (float)((double)v * (1.0 / 4294967296.0)) * inv_n;
    return __builtin_amdgcn_rsqf(ms + EPS);
}
DEV int vperm4(int s0) { const int g = (s0 >> 2) & 3; const int gp = ((g & 1) << 1) | (g >> 1); return (s0 & ~15) | (gp << 2); }

#define XB_TMO      128
#define XB_XCNT(j)  (256  + 64 * (j))
#define XB_XSUB(j)  (1280 + 64 * (j))
#define XB_XGEN(j)  (2304 + 64 * (j))
#define XB_TOP      3328
#define XB_TOPGEN   3392
#define XCD_BAR_WORDS 3456
#define XB_SPIN_CAP (1u << 22)
#define LAS __attribute__((address_space(3)))
DEV unsigned xb_ld(unsigned* p) { return __hip_atomic_load(p, __ATOMIC_RELAXED, __HIP_MEMORY_SCOPE_AGENT); }
DEV unsigned xb_add(unsigned* p, unsigned v) { return __hip_atomic_fetch_add(p, v, __ATOMIC_RELAXED, __HIP_MEMORY_SCOPE_AGENT); }
DEV unsigned xb_xcc_id() { return (unsigned)__builtin_amdgcn_s_getreg((3 << 11) | 20) & 0xFu; }
#define XB_SPIN(cond, bar) do { unsigned _sp = 0; while (cond) { __builtin_amdgcn_s_sleep(1); \
    if ((++_sp & 255u) == 0u) { if (xb_ld(&(bar)[XB_TMO])) break; if (_sp > XB_SPIN_CAP) { atomicAdd(&(bar)[XB_TMO], 1u); break; } } } } while (0)
struct XcdBarrier { unsigned* bar; unsigned x; volatile unsigned* st; };
DEV XcdBarrier xcd_barrier_post(unsigned* bar, volatile unsigned* st) {
    XcdBarrier b; b.bar = bar; b.x = xb_xcc_id(); b.st = st;
    if (threadIdx.x == 0) (void)xb_add(&bar[XB_XCNT(b.x)], 1u);
    return b;
}
DEV void xcd_barrier_complete(unsigned* bar, unsigned x, unsigned& nloc, unsigned& nx) {
    const unsigned G = gridDim.x;
    unsigned sum, cnt, mine, sp = 0u;
    for (;;) {
        sum = 0u; cnt = 0u; mine = 0u;
#pragma unroll
        for (unsigned j = 0; j < 16; ++j) { const unsigned c = xb_ld(&bar[XB_XCNT(j)]); sum += c; cnt += (c > 0u) ? 1u : 0u; mine = (j == x) ? c : mine; }
        if (sum == G) break;
        __builtin_amdgcn_s_sleep(1);
        if ((++sp & 255u) == 0u) { if (xb_ld(&bar[XB_TMO])) break; if (sp > XB_SPIN_CAP) { atomicAdd(&bar[XB_TMO], 1u); break; } }
    }
    nloc = mine > 0u ? mine : 1u; nx = cnt > 0u ? cnt : 1u;
}
DEV void xcd_barrier(const XcdBarrier& b) {
    asm volatile("s_waitcnt vmcnt(0)" ::: "memory");
    __syncthreads();
    if (threadIdx.x == 0) {
        unsigned* bar = b.bar;
        __builtin_amdgcn_s_waitcnt(0);
        unsigned nloc = b.st[0], nx = b.st[1];
        if (nloc == 0u) { xcd_barrier_complete(bar, b.x, nloc, nx); b.st[0] = nloc; b.st[1] = nx; }
        const unsigned old = xb_add(&bar[XB_XSUB(b.x)], 1u);
        const unsigned gen = old / nloc;
        if (old + 1u == (gen + 1u) * nloc) {
            __builtin_amdgcn_fence(__ATOMIC_RELEASE, "agent");
            asm volatile("s_waitcnt vmcnt(0)" ::: "memory");
            const unsigned og = xb_add(&bar[XB_TOP], 1u);
            const unsigned tg = og / nx;
            if (og + 1u == (tg + 1u) * nx) xb_add(&bar[XB_TOPGEN], 1u);
            else XB_SPIN(xb_ld(&bar[XB_TOPGEN]) == tg, bar);
            __builtin_amdgcn_fence(__ATOMIC_ACQUIRE, "agent");
            xb_add(&bar[XB_XGEN(b.x)], 1u);
            asm volatile("s_waitcnt vmcnt(0)" ::: "memory");
        } else {
            XB_SPIN(xb_ld(&bar[XB_XGEN(b.x)]) == gen, bar);
            __builtin_amdgcn_fence(__ATOMIC_ACQUIRE, "agent");
            asm volatile("s_waitcnt vmcnt(0)" ::: "memory");
        }
    }
    __syncthreads();
}

struct XcdIter { int x, j, per; };
DEV XcdIter xcd_iter() { XcdIter r; const int G = gridDim.x; if ((G & 7) == 0) { r.x = blockIdx.x & 7; r.j = blockIdx.x >> 3; r.per = G >> 3; } else { r.x = -1; r.j = blockIdx.x; r.per = G; } return r; }

#define GLDS16(g, l) __builtin_amdgcn_global_load_lds((const unsigned*)(g), (LAS unsigned*)(l), 16, 0, 0)
typedef short s16x4 __attribute__((ext_vector_type(4)));
DEV int stage_col(int tid) { return (((tid & 7) ^ ((tid >> 3) & 7)) << 3); }
template <bool BF32>
DEV void gemm_acc(f32x4 (&acc)[4][4], unsigned char* lds, const bf16_t* a0, const bf16_t* a1, const bf16_t* a2, const bf16_t* a3,
                  const bf16_t* b0, const bf16_t* b1, const bf16_t* b2, const bf16_t* b3, const float* bf, int ldn, int nkt, bool swap) {
    int tid = threadIdx.x; asm volatile("" : "+v"(tid));
    const int lane = tid & 63, wid = tid >> 6, wr = wid >> 1, wc = wid & 1, fr = lane & 15, fq = lane >> 4;
    const int xbase = swap ? (16384 + wc * 8192) : (wr * 8192);
    const int ybase = swap ? (wr * 8192) : (16384 + wc * 8192);
    unsigned char* ldw = lds + wid * 1024;
    const int n4 = tid & 31, kr = tid >> 5;
    const int wofs = 16384 + kr * 256 + (n4 & 3) * 8, sl0 = ((n4 >> 2) ^ (kr & 3)) << 5, sl1 = ((n4 >> 2) ^ ((kr & 3) | 4)) << 5;
    const int tq = (lane >> 2) & 3, gq = tq | ((fq & 1) << 2);
    const int wrd = 16384 + (8 * fq + tq) * 256 + 8 * (lane & 3);
    f32x4 rb[8];
    auto stage_a = [&](int buf, int ko) { GLDS16(a0 + ko, ldw + buf); GLDS16(a1 + ko, ldw + buf + 4096); GLDS16(a2 + ko, ldw + buf + 8192); GLDS16(a3 + ko, ldw + buf + 12288); };
    auto stage_b = [&](int buf, int ko) { GLDS16(b0 + ko, ldw + buf + 16384); GLDS16(b1 + ko, ldw + buf + 16384 + 4096); GLDS16(b2 + ko, ldw + buf + 16384 + 8192); GLDS16(b3 + ko, ldw + buf + 16384 + 12288); };
    auto load_bf = [&](int kt) {
#pragma unroll
        for (int i = 0; i < 8; ++i) rb[i] = *(const f32x4*)(bf + (size_t)(kt * 64 + 8 * i) * ldn);
    };
    auto write_bf = [&](int buf) {
#pragma unroll
        for (int i = 0; i < 8; ++i) {
            u32x2 w; w.x = cvt_pk_bf16(rb[i][0], rb[i][1]); w.y = cvt_pk_bf16(rb[i][2], rb[i][3]);
            *(u32x2*)(lds + buf + wofs + i * 2048 + ((i & 1) ? sl1 : sl0)) = w;
        }
    };
    stage_a(0, 0);
    if (BF32) { load_bf(0); write_bf(0); } else stage_b(0, 0);
    asm volatile("s_waitcnt vmcnt(0)" ::: "memory");
    __syncthreads();
    for (int kt = 0; kt < nkt; ++kt) {
        const int cur = (kt & 1) * 32768, nxt = 32768 - cur;
        const bool more = (kt + 1 < nkt);
        if (more) { stage_a(nxt, (kt + 1) * 64); if (BF32) load_bf(kt + 1); else stage_b(nxt, (kt + 1) * 64); }
        __builtin_amdgcn_sched_barrier(0);
#pragma unroll
        for (int ks = 0; ks < 2; ++ks) {
            bf16x8 xf[4], yf[4];
            const int coff = (((ks * 4 + fq) ^ (fr & 7)) << 4) + fr * 128;
            if (BF32) {
#pragma unroll
                for (int i = 0; i < 4; ++i) {
                    const int o = cur + wrd + ks * 8192 + (((wc * 4 + i) ^ gq) << 5);
                    const s16x4 lo = __builtin_amdgcn_ds_read_tr16_b64_v4i16((LAS s16x4*)(lds + o));
                    const s16x4 hi = __builtin_amdgcn_ds_read_tr16_b64_v4i16((LAS s16x4*)(lds + o + 1024));
                    xf[i] = __builtin_shufflevector(lo, hi, 0, 1, 2, 3, 4, 5, 6, 7);
                    yf[i] = *(const bf16x8*)(lds + cur + wr * 8192 + i * 2048 + coff);
                }
            } else {
#pragma unroll
                for (int i = 0; i < 4; ++i) { xf[i] = *(const bf16x8*)(lds + cur + xbase + i * 2048 + coff); yf[i] = *(const bf16x8*)(lds + cur + ybase + i * 2048 + coff); }
            }
#pragma unroll
            for (int i = 0; i < 4; ++i)
#pragma unroll
                for (int j = 0; j < 4; ++j) acc[i][j] = __builtin_amdgcn_mfma_f32_16x16x32_bf16(xf[i], yf[j], acc[i][j], 0, 0, 0);
        }
        if (BF32 && more) write_bf(nxt);
        asm volatile("s_waitcnt vmcnt(0)" ::: "memory");
        __syncthreads();
    }
}
DEV void acc_zero(f32x4 (&acc)[4][4]) {
#pragma unroll
    for (int i = 0; i < 4; ++i)
#pragma unroll
        for (int j = 0; j < 4; ++j) acc[i][j] = (f32x4){0.f, 0.f, 0.f, 0.f};
}
DEV void gemm_dense(f32x4 (&acc)[4][4], unsigned char* lds, const bf16_t* A, int lda, int m0, const bf16_t* Bt, int ldb, int n0, int k0, int nkt, bool swap) {
    int tid = threadIdx.x; asm volatile("" : "+v"(tid));
    const int srow = tid >> 3, sc = stage_col(tid);
    const bf16_t* a = A + (size_t)(m0 + srow) * lda + k0 + sc;
    const bf16_t* b = Bt + (size_t)(n0 + srow) * ldb + k0 + sc;
    gemm_acc<false>(acc, lds, a, a + (size_t)32 * lda, a + (size_t)64 * lda, a + (size_t)96 * lda, b, b + (size_t)32 * ldb, b + (size_t)64 * ldb, b + (size_t)96 * ldb, nullptr, 0, nkt, swap);
}
DEV void gemm_dense_bf32(f32x4 (&acc)[4][4], unsigned char* lds, const bf16_t* A, int lda, int m0, const float* Bsrc, int ldn, int nkt) {
    int tid = threadIdx.x; asm volatile("" : "+v"(tid));
    const int srow = tid >> 3, sc = stage_col(tid);
    const bf16_t* a = A + (size_t)(m0 + srow) * lda + sc;
    const float* bf = Bsrc + (size_t)(tid >> 5) * ldn + (tid & 31) * 4;
    gemm_acc<true>(acc, lds, a, a + (size_t)32 * lda, a + (size_t)64 * lda, a + (size_t)96 * lda, nullptr, nullptr, nullptr, nullptr, bf, ldn, nkt, true);
}

template <class GainF, class RowF>
DEV void transpose_item(const float* src, int N, bf16_t* dst, int ldd, int k0, int n0, int lane, GainF gain, RowF dstrow) {
    const int ln = lane & 7, lk = lane >> 3;
    const int k = k0 + lk * 8, n = n0 + ln * 4;
    f32x4 v[8];
#pragma unroll
    for (int kk = 0; kk < 8; ++kk) v[kk] = *(const f32x4*)(src + (size_t)(k + kk) * N + n);
    float g[8];
#pragma unroll
    for (int kk = 0; kk < 8; ++kk) g[kk] = gain(k + kk);
#pragma unroll
    for (int j = 0; j < 4; ++j) {
        u32x4 w;
        w.x = cvt_pk_bf16(v[0][j] * g[0], v[1][j] * g[1]); w.y = cvt_pk_bf16(v[2][j] * g[2], v[3][j] * g[3]);
        w.z = cvt_pk_bf16(v[4][j] * g[4], v[5][j] * g[5]); w.w = cvt_pk_bf16(v[6][j] * g[6], v[7][j] * g[7]);
        *(u32x4*)(dst + (size_t)dstrow(n + j) * ldd + k) = w;
    }
}
DEV int rope_perm64(int i) { return i < 32 ? 2 * i : 2 * (i - 32) + 1; }

DEV void rms_row_to_bf16(const float* src, const float* g, bf16_t* dst, int lane) {
    f32x4 v[8]; float s = 0.f;
#pragma unroll
    for (int i = 0; i < 8; ++i) { v[i] = *(const f32x4*)(src + i * 256 + lane * 4); s += v[i][0] * v[i][0] + v[i][1] * v[i][1] + v[i][2] * v[i][2] + v[i][3] * v[i][3]; }
    s = wave_sum(s);
    const float rs = __builtin_amdgcn_rsqf(s * (1.0f / 2048.0f) + EPS);
#pragma unroll
    for (int i = 0; i < 8; ++i) {
        const f32x4 gg = *(const f32x4*)(g + i * 256 + lane * 4);
        u32x2 w; w.x = cvt_pk_bf16(v[i][0] * rs * gg[0], v[i][1] * rs * gg[1]); w.y = cvt_pk_bf16(v[i][2] * rs * gg[2], v[i][3] * rs * gg[3]);
        *(u32x2*)(dst + i * 256 + lane * 4) = w;
    }
}

DEV void phase0(const P& p) {
    const int lane = threadIdx.x & 63, gw = blockIdx.x * 4 + (threadIdx.x >> 6), NGW = gridDim.x * 4;
    unsigned char* ws = p.ws;
    constexpr int I_IN = 32 * 122, I_QB = 8 * 48, I_KVB = 4 * 64, I_OUT = 32 * 64, I_MQ = 32 * 16, I_MKV = 32 * 32, I_MO = 8 * 64;
    constexpr int NITEMS = I_IN + I_QB + I_KVB + I_OUT + I_MQ + I_MKV + I_MO;
    for (int it = gw; it < NITEMS; it += NGW) {
        int r = it;
        if (r < I_IN) { const int kt = r / 122, nt = r % 122;
            transpose_item(p.w_in, 3904, (bf16_t*)(ws + WS_WIN), D, kt * 64, nt * 32, lane, [](int) { return 1.0f; },
                [](int n) { return n < 768 ? n : (n < 832 ? 3840 + rope_perm64(n - 768) : n - 64); }); continue; }
        r -= I_IN;
        if (r < I_QB) { const int kt = r / 48, nt = r % 48; const float* g = p.norm_q_lat;
            transpose_item(p.w_q_b, 1536, (bf16_t*)(ws + WS_WQB), 512, kt * 64, nt * 32, lane, [g](int k) { return g[k]; },
                [](int n) { const int h = n / 192, d = n % 192; return h * 192 + (d < 128 ? d : 128 + rope_perm64(d - 128)); }); continue; }
        r -= I_QB;
        if (r < I_KVB) { const int kt = r / 64, nt = r % 64; const float* g = p.norm_kv_lat;
            transpose_item(p.w_kv_b, 2048, (bf16_t*)(ws + WS_WKVB), 256, kt * 64, nt * 32, lane, [g](int k) { return g[k]; }, [](int n) { return n; }); continue; }
        r -= I_KVB;
        if (r < I_OUT) { const int kt = r / 64, nt = r % 64; const float* g1 = p.norm_mla_out; const float* g2 = p.norm_sb_out;
            transpose_item(p.w_out, 2048, (bf16_t*)(ws + WS_WOUT), 2048, kt * 64, nt * 32, lane, [g1, g2](int k) { return k < 1024 ? g1[k] : g2[k - 1024]; }, [](int n) { return n; }); continue; }
        r -= I_OUT;
        if (r < I_MQ) { const int kt = r / 16, nt = r % 16; const float* g = p.norm_mem_x;
            transpose_item(p.w_mem_q, 512, (bf16_t*)(ws + WS_WMQ), 2048, kt * 64, nt * 32, lane, [g](int k) { return g[k]; }, [](int n) { return n; }); continue; }
        r -= I_MQ;
        if (r < I_MKV) { const int kt = r / 32, nt = r % 32;
            transpose_item(p.w_mem_kv, 1024, (bf16_t*)(ws + WS_WMKV), 2048, kt * 64, nt * 32, lane, [](int) { return 1.0f; }, [](int n) { return n; }); continue; }
        r -= I_MKV;
        { const int kt = r / 64, nt = r % 64;
            transpose_item(p.w_mem_o, 2048, (bf16_t*)(ws + WS_WMO), 512, kt * 64, nt * 32, lane, [](int) { return 1.0f; }, [](int n) { return n; }); }
    }
    {
        float* wr = (float*)(ws + WS_WR);
        for (int i = blockIdx.x * NTHREADS + threadIdx.x; i < 48 * 2048; i += gridDim.x * NTHREADS) {
            const int n = i >> 11, k = i & 2047;
            float v = 0.f;
            if (n < 4) v = p.w_group[k * 4 + n] * p.norm_ffn[k]; else if (n < 36) v = p.w_er[k * 32 + (n - 4)] * p.norm_ffn[k];
            wr[i] = v;
        }
    }
    {
        float* rt = (float*)(ws + WS_ROPE);
        for (int i = blockIdx.x * NTHREADS + threadIdx.x; i < T * 32; i += gridDim.x * NTHREADS) {
            const int t = i >> 5, f = i & 31;
            const float inv_freq = exp2f(-(float)f * (13.287712379549449f / 32.0f));
            const float ang = (float)p.pos[t] * inv_freq;
            const double turns = (double)ang * 0.15915494309189535;
            const float fr = (float)(turns - floor(turns));
            rt[2 * i] = __builtin_amdgcn_cosf(fr); rt[2 * i + 1] = __builtin_amdgcn_sinf(fr);
        }
    }
    for (int row = gw; row < T + MT; row += NGW) {
        if (row < T) rms_row_to_bf16(p.x + (size_t)row * D, p.norm_mix, (bf16_t*)(ws + WS_H) + (size_t)row * D, lane);
        else rms_row_to_bf16(p.mem + (size_t)(row - T) * D, p.norm_mem_src, (bf16_t*)(ws + WS_MEMN) + (size_t)(row - T) * D, lane);
    }
}

DEV void store_rowmajor_sq(const f32x4 (&acc)[4][4], bf16_t* dst, int ldd, int m0, int ncol0, u64* sq, float scale) {
    const int lane = threadIdx.x & 63, wid = threadIdx.x >> 6, wr = wid >> 1, wc = wid & 1, fr = lane & 15, fq = lane >> 4;
#pragma unroll
    for (int j = 0; j < 4; ++j) {
        const int m = m0 + wr * 64 + j * 16 + fr; float ss = 0.f;
#pragma unroll
        for (int i = 0; i < 4; ++i) {
            const f32x4 v = acc[i][j];
            ss += v[0] * v[0] + v[1] * v[1] + v[2] * v[2] + v[3] * v[3];
            u32x2 w; w.x = cvt_pk_bf16(v[0] * scale, v[1] * scale); w.y = cvt_pk_bf16(v[2] * scale, v[3] * scale);
            *(u32x2*)(dst + (size_t)m * ldd + ncol0 + wc * 64 + i * 16 + fq * 4) = w;
        }
        if (sq) { ss += __shfl_xor(ss, 16); ss += __shfl_xor(ss, 32); if (fq == 0) sq_add(sq, m, ss); }
    }
}
DEV void store_transposed(const f32x4 (&acc)[4][4], bf16_t* dst, int L, int s0, const float* rs  ) {
    const int lane = threadIdx.x & 63, wid = threadIdx.x >> 6, wr = wid >> 1, wc = wid & 1, fr = lane & 15, fq = lane >> 4;
#pragma unroll
    for (int i = 0; i < 4; ++i) {
        const int ml = wr * 64 + i * 16 + fq * 4;
        float r0 = 1.f, r1 = 1.f, r2 = 1.f, r3 = 1.f;
        if (rs) { r0 = rs[ml]; r1 = rs[ml + 1]; r2 = rs[ml + 2]; r3 = rs[ml + 3]; }
        const int pos = vperm4(s0 + ml);
#pragma unroll
        for (int j = 0; j < 4; ++j) {
            const int n = wc * 64 + j * 16 + fr; const f32x4 v = acc[i][j];
            u32x2 w; w.x = cvt_pk_bf16(v[0] * r0, v[1] * r1); w.y = cvt_pk_bf16(v[2] * r2, v[3] * r3);
            *(u32x2*)(dst + (size_t)n * L + pos) = w;
        }
    }
}

DEV void phase1(const P& p, unsigned char* lds, bool dry = false) {
    unsigned char* ws = p.ws;
    const XcdIter xi = xcd_iter();
    const int lane = threadIdx.x & 63, wid = threadIdx.x >> 6, wr = wid >> 1, wc = wid & 1, fr = lane & 15, fq = lane >> 4;
    u64* sqb = (u64*)(ws + CTL_SQ);
    u64* sq_cq = dry ? nullptr : sqb + SQ_CQ * T; u64* sq_ckv = dry ? nullptr : sqb + SQ_CKV * T;
    const int per_x = 8 * 31 + 4, total = 64 * 31 + 32;
    for (int it = 0;; ++it) {
        int mt, nt; bool memkv = false;
        if (xi.x >= 0) { const int i = it * xi.per + xi.j; if (i >= per_x) break;
            if (i < 248) { mt = xi.x * 8 + (i & 7); nt = i >> 3; } else { memkv = true; const int q = xi.x * 4 + (i - 248); mt = q & 3; nt = q >> 2; } }
        else { const int i = it * xi.per + xi.j; if (i >= total) break;
            if (i < 1984) { mt = i & 63; nt = i >> 6; } else { memkv = true; const int q = i - 1984; mt = q & 3; nt = q >> 2; } }
        f32x4 acc[4][4]; acc_zero(acc);
        if (memkv) {
            const bool isv = nt >= 4;
            gemm_dense(acc, lds, (const bf16_t*)(ws + WS_MEMN), D, mt * 128, (const bf16_t*)(ws + WS_WMKV), D, nt * 128, 0, 32, !isv);
            const int b = mt >> 1, mm0 = (mt & 1) * 128;
            if (!isv) store_rowmajor_sq(acc, (bf16_t*)(ws + WS_KMEM) + (size_t)((b * 4 + nt) * 256) * 128, 128, mm0, 0, nullptr, 1.0f);
            else store_transposed(acc, (bf16_t*)(ws + WS_VMEMT) + (size_t)((b * 4 + (nt - 4)) * 128) * 256, 256, mm0, nullptr);
            continue;
        }
        const bool isv = (nt >= 22 && nt < 30);
        gemm_dense(acc, lds, (const bf16_t*)(ws + WS_H), D, mt * 128, (const bf16_t*)(ws + WS_WIN), D, nt * 128, 0, 32, !isv);
        const int m0 = mt * 128, b = m0 >> 12, s0 = m0 & 4095;
        if (nt < 4) store_rowmajor_sq(acc, (bf16_t*)(ws + WS_CQ), 512, m0, nt * 128, sq_cq, 1.0f);
        else if (nt < 6) store_rowmajor_sq(acc, (bf16_t*)(ws + WS_CKV), 256, m0, (nt - 4) * 128, sq_ckv, 1.0f);
        else if (nt < 14) store_rowmajor_sq(acc, (bf16_t*)(ws + WS_QSB) + (size_t)((b * 8 + (nt - 6)) * S) * 128, 128, s0, 0, nullptr, 0.08838834764831845f * LOG2E);
        else if (nt < 22) store_rowmajor_sq(acc, (bf16_t*)(ws + WS_KSB) + (size_t)((b * 8 + (nt - 14)) * S) * 128, 128, s0, 0, nullptr, 1.0f);
        else if (nt < 30) store_transposed(acc, (bf16_t*)(ws + WS_VSBT) + (size_t)((b * 8 + (nt - 22)) * 128) * S, S, s0, nullptr);
        else if (wc == 0) {
            const float* rt = (const float*)(ws + WS_ROPE);
            bf16_t* kpe = (bf16_t*)(ws + WS_KPE);
#pragma unroll
            for (int j = 0; j < 4; ++j) {
                const int m = m0 + wr * 64 + j * 16 + fr;
#pragma unroll
                for (int i = 0; i < 4; ++i) {
                    const int n = i * 16 + fq * 4; const f32x4 v = acc[i][j];
                    const f32x4 cs = *(const f32x4*)(rt + ((size_t)m * 32 + (n >> 1)) * 2);
                    u32x2 w; w.x = cvt_pk_bf16(v[0] * cs[0] - v[1] * cs[1], v[1] * cs[0] + v[0] * cs[1]);
                    w.y = cvt_pk_bf16(v[2] * cs[2] - v[3] * cs[3], v[3] * cs[2] + v[2] * cs[3]);
                    *(u32x2*)(kpe + (size_t)m * 64 + n) = w;
                }
            }
        }
    }
}

DEV void phase2(const P& p, unsigned char* lds) {
    unsigned char* ws = p.ws;
    const XcdIter xi = xcd_iter();
    const int lane = threadIdx.x & 63, wid = threadIdx.x >> 6, wr = wid >> 1, wc = wid & 1, fr = lane & 15, fq = lane >> 4;
    const u64* sqb = (const u64*)(ws + CTL_SQ);
    const int per_x = 8 * 28, total = 64 * 28;
    for (int it = 0;; ++it) {
        int mt, nt;
        if (xi.x >= 0) { const int i = it * xi.per + xi.j; if (i >= per_x) break; mt = xi.x * 8 + (i & 7); nt = i >> 3; }
        else { const int i = it * xi.per + xi.j; if (i >= total) break; mt = i & 63; nt = i >> 6; }
        const int m0 = mt * 128, b = m0 >> 12, s0 = m0 & 4095;
        f32x4 acc[4][4]; acc_zero(acc);
        if (nt < 12) {
            gemm_dense(acc, lds, (const bf16_t*)(ws + WS_CQ), 512, m0, (const bf16_t*)(ws + WS_WQB), 512, nt * 128, 0, 8, true);
            const float* rt = (const float*)(ws + WS_ROPE);
            bf16_t* qm = (bf16_t*)(ws + WS_QM);
            const float qs = 0.07216878364870322f * LOG2E;
#pragma unroll
            for (int j = 0; j < 4; ++j) {
                const int m = m0 + wr * 64 + j * 16 + fr, s = s0 + wr * 64 + j * 16 + fr;
                const float rs = sq_rs(sqb + SQ_CQ * T, m, 1.0f / 512.0f) * qs;
#pragma unroll
                for (int i = 0; i < 4; ++i) {
                    const int n = nt * 128 + wc * 64 + i * 16 + fq * 4, h = n / 192, d = n - h * 192;
                    f32x4 v = acc[i][j] * rs;
                    if (d >= 128) {
                        const f32x4 cs = *(const f32x4*)(rt + ((size_t)m * 32 + ((d - 128) >> 1)) * 2);
                        v = (f32x4){v[0] * cs[0] - v[1] * cs[1], v[1] * cs[0] + v[0] * cs[1], v[2] * cs[2] - v[3] * cs[3], v[3] * cs[2] + v[2] * cs[3]};
                    }
                    u32x2 w; w.x = cvt_pk_bf16(v[0], v[1]); w.y = cvt_pk_bf16(v[2], v[3]);
                    *(u32x2*)(qm + ((size_t)(b * 8 + h) * S + s) * 192 + d) = w;
                }
            }
        } else {
            const int nk = nt - 12, h = nk >> 1; const bool isv = nk & 1;
            gemm_dense(acc, lds, (const bf16_t*)(ws + WS_CKV), 256, m0, (const bf16_t*)(ws + WS_WKVB), 256, nk * 128, 0, 4, !isv);
            if (!isv) {
                bf16_t* kn = (bf16_t*)(ws + WS_KN) + (size_t)((b * 8 + h) * S) * 128;
#pragma unroll
                for (int j = 0; j < 4; ++j) {
                    const int ml = wr * 64 + j * 16 + fr;
                    const float rs = sq_rs(sqb + SQ_CKV * T, m0 + ml, 1.0f / 256.0f);
#pragma unroll
                    for (int i = 0; i < 4; ++i) {
                        const f32x4 v = acc[i][j] * rs;
                        u32x2 w; w.x = cvt_pk_bf16(v[0], v[1]); w.y = cvt_pk_bf16(v[2], v[3]);
                        *(u32x2*)(kn + (size_t)(s0 + ml) * 128 + wc * 64 + i * 16 + fq * 4) = w;
                    }
                }
            } else {
                bf16_t* vt = (bf16_t*)(ws + WS_VMT) + (size_t)((b * 8 + h) * 128) * S;
#pragma unroll
                for (int i = 0; i < 4; ++i) {
                    const int ml = wr * 64 + i * 16 + fq * 4;
                    const float r0 = sq_rs(sqb + SQ_CKV * T, m0 + ml, 1.0f / 256.0f), r1 = sq_rs(sqb + SQ_CKV * T, m0 + ml + 1, 1.0f / 256.0f);
                    const float r2 = sq_rs(sqb + SQ_CKV * T, m0 + ml + 2, 1.0f / 256.0f), r3 = sq_rs(sqb + SQ_CKV * T, m0 + ml + 3, 1.0f / 256.0f);
                    const int pos = vperm4(s0 + ml);
#pragma unroll
                    for (int j = 0; j < 4; ++j) {
                        const int n = wc * 64 + j * 16 + fr; const f32x4 v = acc[i][j];
                        u32x2 w; w.x = cvt_pk_bf16(v[0] * r0, v[1] * r1); w.y = cvt_pk_bf16(v[2] * r2, v[3] * r3);
                        *(u32x2*)(vt + (size_t)n * S + pos) = w;
                    }
                }
            }
        }
    }
}

template <int DQK> struct KStage {
    static constexpr int NIG = DQK / 64;
    u32x4 r[2][NIG];
    const bf16_t* gm; const bf16_t* gp; int l0, l1;
    DEV void init(const bf16_t* Kmain, const bf16_t* Kpe, int t) {
        const int row = t >> 3, c = t & 7;
        gm = Kmain + (size_t)row * 128 + c * 8; gp = (DQK == 192) ? Kpe + (size_t)row * 64 + c * 8 : nullptr;
        if (DQK == 128) { const int lo = row * 256 + ((c ^ (row & 7)) << 4), b3 = (row >> 3) & 1; l0 = lo + (b3 ? 128 : 0); l1 = lo + (b3 ? 0 : 128); }
        else { l0 = row * 384 + ((c ^ ((row >> 1) & 7)) << 4); l1 = l0 + 128; }
    }
    DEV void load(int tile) {
#pragma unroll
        for (int ps = 0; ps < 2; ++ps) {
            const bf16_t* g = gm + ((size_t)tile * 64 + ps * 32) * 128;
            r[ps][0] = *(const u32x4*)g; r[ps][1] = *(const u32x4*)(g + 64);
            if (DQK == 192) r[ps][NIG - 1] = *(const u32x4*)(gp + ((size_t)tile * 64 + ps * 32) * 64);
        }
    }
    DEV void write(unsigned char* ldsK) {
#pragma unroll
        for (int ps = 0; ps < 2; ++ps) {
            *(u32x4*)(ldsK + l0 + ps * 32 * DQK * 2) = r[ps][0]; *(u32x4*)(ldsK + l1 + ps * 32 * DQK * 2) = r[ps][1];
            if (DQK == 192) *(u32x4*)(ldsK + l0 + 256 + ps * 32 * DQK * 2) = r[ps][NIG - 1];
        }
    }
};
struct VStage {
    u32x4 r[4]; const bf16_t* g; int l; size_t rstride;
    DEV void init(const bf16_t* VT, int LV, int t) { const int row = t >> 3, c = t & 7; g = VT + (size_t)row * LV + c * 8; rstride = (size_t)32 * LV; l = row * 128 + ((c ^ ((row >> 1) & 7)) << 4); }
    DEV void load(int tile) {
#pragma unroll
        for (int i = 0; i < 4; ++i) r[i] = *(const u32x4*)(g + i * rstride + (size_t)tile * 64);
    }
    DEV void write(unsigned char* ldsV) {
#pragma unroll
        for (int i = 0; i < 4; ++i) *(u32x4*)(ldsV + l + i * 4096) = r[i];
    }
};
template <int DQK> DEV int kfrag_off(int krow, int ks, int hh) {
    const int c = 2 * ks + hh;
    if (DQK == 128) return krow * 256 + ((c ^ (krow & 15)) << 4);
    else return krow * 384 + ((((c & ~7) | ((c & 7) ^ ((krow >> 1) & 7)))) << 4);
}
DEV int vfrag_off(int r, int c) { return r * 128 + ((c ^ ((r >> 1) & 7)) << 4); }

template <int DQK, bool CAUSAL>
DEV void attn_unit(unsigned char* lds, const bf16_t* Q, const bf16_t* Kmain, const bf16_t* Kpe, const bf16_t* VT, int LV, int q0, int ntiles,
                   bf16_t* O, int ldo, u64* sq  , int orow0) {
    constexpr int NKS = DQK / 16, KTILE_BYTES = 64 * DQK * 2;
    int tid = threadIdx.x; asm volatile("" : "+v"(tid));
    const int lane = tid & 63, wid = tid >> 6, pr = wid >> 1, kh = wid & 1, l31 = lane & 31, hh = lane >> 5;
    unsigned char* ldsK = lds; unsigned char* ldsV = lds + KTILE_BYTES;
    bf16x8 qf[NKS];
    { const bf16_t* qp = Q + (size_t)(q0 + pr * 32 + l31) * DQK + hh * 8;
#pragma unroll
      for (int ks = 0; ks < NKS; ++ks) qf[ks] = *(const bf16x8*)(qp + ks * 16); }
    f32x16 oacc[4];
#pragma unroll
    for (int i = 0; i < 4; ++i)
#pragma unroll
        for (int r = 0; r < 16; ++r) oacc[i][r] = 0.f;
    float mrun = -1e30f, lrun = 0.f;
    KStage<DQK> ksg; VStage vsg;
    ksg.init(Kmain, Kpe, tid); vsg.init(VT, LV, tid);
    const int krow = kh * 32 + l31;
    int ka[DQK == 128 ? 8 : 4];
#pragma unroll
    for (int i = 0; i < (DQK == 128 ? 8 : 4); ++i) ka[i] = kfrag_off<DQK>(krow, i, hh);
    const int va0 = vfrag_off(l31, kh * 4 + hh), va1 = vfrag_off(l31, kh * 4 + 2 + hh);
    ksg.load(0); vsg.load(0); ksg.write(ldsK); vsg.write(ldsV); __syncthreads();
    const int qpos = q0 + pr * 32 + l31;
    for (int t = 0; t < ntiles; ++t) {
        const bool more = t + 1 < ntiles;
        if (more) { ksg.load(t + 1); vsg.load(t + 1); }
        __builtin_amdgcn_sched_barrier(0);
        const bool diag = CAUSAL && (t == ntiles - 1);
        if (!(diag && pr == 0 && kh == 1)) {
            f32x16 sacc;
#pragma unroll
            for (int r = 0; r < 16; ++r) sacc[r] = 0.f;
#pragma unroll
            for (int ks = 0; ks < NKS; ++ks) {
                const int off = (DQK == 128) ? ka[ks] : (ka[ks & 3] + 128 * (ks >> 2));
                const bf16x8 kf = *(const bf16x8*)(ldsK + off);
                sacc = __builtin_amdgcn_mfma_f32_32x32x16_bf16(kf, qf[ks], sacc, 0, 0, 0);
            }
            if (diag) {
                const int kbase = t * 64 + kh * 32 + 4 * hh;
#pragma unroll
                for (int r = 0; r < 16; ++r) { const int kp = kbase + (r & 3) + 8 * (r >> 2); if (kp > qpos) sacc[r] = -1e30f; }
            }
            float mx = sacc[0];
#pragma unroll
            for (int r = 1; r < 16; ++r) mx = fmaxf(mx, sacc[r]);
            mx = fmaxf(mx, __shfl_xor(mx, 32));
            const float mnew = fmaxf(mrun, mx), alpha = fexp2(mrun - mnew);
            mrun = mnew;
            float ps = 0.f;
#pragma unroll
            for (int r = 0; r < 16; ++r) { sacc[r] = fexp2(sacc[r] - mnew); ps += sacc[r]; }
            lrun = lrun * alpha + ps;
#pragma unroll
            for (int i = 0; i < 4; ++i)
#pragma unroll
                for (int r = 0; r < 16; ++r) oacc[i][r] *= alpha;
#pragma unroll
            for (int s2 = 0; s2 < 2; ++s2) {
                u32x4 pw; pw.x = cvt_pk_bf16(sacc[8 * s2 + 0], sacc[8 * s2 + 1]); pw.y = cvt_pk_bf16(sacc[8 * s2 + 2], sacc[8 * s2 + 3]);
                pw.z = cvt_pk_bf16(sacc[8 * s2 + 4], sacc[8 * s2 + 5]); pw.w = cvt_pk_bf16(sacc[8 * s2 + 6], sacc[8 * s2 + 7]);
                bf16x8 pf; __builtin_memcpy(&pf, &pw, 16);
#pragma unroll
                for (int dvb = 0; dvb < 4; ++dvb) {
                    const bf16x8 vf = *(const bf16x8*)(ldsV + (s2 ? va1 : va0) + dvb * 4096);
                    oacc[dvb] = __builtin_amdgcn_mfma_f32_32x32x16_bf16(vf, pf, oacc[dvb], 0, 0, 0);
                }
            }
        }
        __syncthreads();
        if (more) { ksg.write(ldsK); vsg.write(ldsV); }
        __syncthreads();
    }
    float lw = lrun + __shfl_xor(lrun, 32);
    float* xo = (float*)(lds + pr * 20480);
    if (kh == 1) {
#pragma unroll
        for (int i = 0; i < 4; ++i)
#pragma unroll
            for (int r = 0; r < 16; ++r) xo[(i * 16 + r) * 64 + lane] = oacc[i][r];
        xo[4096 + lane] = mrun; xo[4096 + 64 + lane] = lw;
    }
    __syncthreads();
    if (kh == 0) {
        const float m1 = xo[4096 + lane], l1 = xo[4096 + 64 + lane];
        const float m = fmaxf(mrun, m1), f0 = fexp2(mrun - m), f1 = fexp2(m1 - m);
        const float inv = 1.0f / (lw * f0 + l1 * f1);
        const float c0 = f0 * inv, c1 = f1 * inv;
        float ss = 0.f;
        bf16_t* op = O + (size_t)(orow0 + pr * 32 + l31) * ldo;
#pragma unroll
        for (int i = 0; i < 4; ++i)
#pragma unroll
            for (int rq = 0; rq < 4; ++rq) {
                float v[4];
#pragma unroll
                for (int e = 0; e < 4; ++e) { const int r = rq * 4 + e; v[e] = oacc[i][r] * c0 + xo[(i * 16 + r) * 64 + lane] * c1; ss += v[e] * v[e]; }
                u32x2 w; w.x = cvt_pk_bf16(v[0], v[1]); w.y = cvt_pk_bf16(v[2], v[3]);
                *(u32x2*)(op + i * 32 + 8 * rq + 4 * hh) = w;
            }
        if (sq) { ss += __shfl_xor(ss, 32); if (hh == 0) sq_add(sq, orow0 + pr * 32 + l31, ss); }
    }
    __syncthreads();
}

DEV void sb_unit(unsigned char* lds, const bf16_t* Q, const bf16_t* K, const bf16_t* VT, int U, bf16_t* O  , u64* sq, int tok0) {
    constexpr int KTILE_BYTES = 64 * 128 * 2;
    int tid = threadIdx.x; asm volatile("" : "+v"(tid));
    const int lane = tid & 63, wid = tid >> 6, l31 = lane & 31, hh = lane >> 5;
    unsigned char* ldsK = lds; unsigned char* ldsV = lds + KTILE_BYTES;
    volatile int* flags = (volatile int*)(lds + LDS_MAIN + 64);
    const int q0 = U * 128 + wid * 32, qpos = q0 + l31;
    bf16x8 qf[8];
    { const bf16_t* qp = Q + (size_t)qpos * 128 + hh * 8;
#pragma unroll
      for (int ks = 0; ks < 8; ++ks) qf[ks] = *(const bf16x8*)(qp + ks * 16); }
    f32x16 oacc[4];
#pragma unroll
    for (int i = 0; i < 4; ++i)
#pragma unroll
        for (int r = 0; r < 16; ++r) oacc[i][r] = 0.f;
    float R = 0.f;
    KStage<128> ksg; VStage vsg;
    ksg.init(K, nullptr, tid); vsg.init(VT, S, tid);
    int ka[8];
#pragma unroll
    for (int i = 0; i < 8; ++i) ka[i] = kfrag_off<128>(l31, i, hh);
    const int va[4] = {vfrag_off(l31, hh), vfrag_off(l31, 2 + hh), vfrag_off(l31, 4 + hh), vfrag_off(l31, 6 + hh)};
    int t = 2 * U + 1;
    ksg.load(t); vsg.load(t); ksg.write(ldsK); vsg.write(ldsV); __syncthreads();
    for (; t >= 0; --t) {
        const bool more = t > 0;
        if (more) { ksg.load(t - 1); vsg.load(t - 1); }
        __builtin_amdgcn_sched_barrier(0);
        const int kt0 = t * 64;
        if (kt0 < q0 + 31) {
            const bool need_mask = (kt0 + 63 >= q0);
#pragma unroll
            for (int kb = 1; kb >= 0; --kb) {
                f32x16 z;
#pragma unroll
                for (int r = 0; r < 16; ++r) z[r] = 0.f;
#pragma unroll
                for (int ks = 0; ks < 8; ++ks) {
                    const bf16x8 kf = *(const bf16x8*)(ldsK + ka[ks] + kb * 8192);
                    z = __builtin_amdgcn_mfma_f32_32x32x16_bf16(kf, qf[ks], z, 0, 0, 0);
                }
                float l1m[16];
#pragma unroll
                for (int r = 0; r < 16; ++r) {
                    const float zz = z[r];
                    const float sp = fmaxf(zz, 0.f) + flog2(1.0f + fexp2(-fabsf(zz)));
                    const int kp = kt0 + kb * 32 + (r & 3) + 8 * (r >> 2) + 4 * hh;
                    const bool ok = !need_mask || (kp < qpos);
                    l1m[r] = ok ? -sp : 0.f;
                    z[r] = ok ? zz : -1e30f;
                }
                float gs[4], pgs[4];
#pragma unroll
                for (int g = 0; g < 4; ++g) { gs[g] = (l1m[4 * g] + l1m[4 * g + 1]) + (l1m[4 * g + 2] + l1m[4 * g + 3]); pgs[g] = __shfl_xor(gs[g], 32); }
                float tail = 0.f;
#pragma unroll
                for (int g = 3; g >= 0; --g) {
                    const float sg = R + tail + (hh == 0 ? pgs[g] : 0.f);
                    const float e2 = l1m[4 * g + 3], e1 = e2 + l1m[4 * g + 2], e0 = e1 + l1m[4 * g + 1];
                    z[4 * g + 3] = fexp2(z[4 * g + 3] + l1m[4 * g + 3] + sg);
                    z[4 * g + 2] = fexp2(z[4 * g + 2] + l1m[4 * g + 2] + sg + e2);
                    z[4 * g + 1] = fexp2(z[4 * g + 1] + l1m[4 * g + 1] + sg + e1);
                    z[4 * g + 0] = fexp2(z[4 * g + 0] + l1m[4 * g + 0] + sg + e0);
                    tail += gs[g] + pgs[g];
                }
                R += tail;
#pragma unroll
                for (int s2 = 0; s2 < 2; ++s2) {
                    u32x4 pw; pw.x = cvt_pk_bf16(z[8 * s2 + 0], z[8 * s2 + 1]); pw.y = cvt_pk_bf16(z[8 * s2 + 2], z[8 * s2 + 3]);
                    pw.z = cvt_pk_bf16(z[8 * s2 + 4], z[8 * s2 + 5]); pw.w = cvt_pk_bf16(z[8 * s2 + 6], z[8 * s2 + 7]);
                    bf16x8 pf; __builtin_memcpy(&pf, &pw, 16);
#pragma unroll
                    for (int dvb = 0; dvb < 4; ++dvb) {
                        const bf16x8 vf = *(const bf16x8*)(ldsV + va[kb * 2 + s2] + dvb * 4096);
                        oacc[dvb] = __builtin_amdgcn_mfma_f32_32x32x16_bf16(vf, pf, oacc[dvb], 0, 0, 0);
                    }
                }
            }
        }
        const bool wdone = __all(R < -160.0f);
        if (lane == 0) flags[wid] = wdone ? 1 : 0;
        __syncthreads();
        const bool alldone = (flags[0] & flags[1] & flags[2] & flags[3]) != 0;
        if (alldone || !more) break;
        ksg.write(ldsK); vsg.write(ldsV);
        __syncthreads();
    }
    __syncthreads();
    float ss = 0.f;
    bf16_t* op = O + (size_t)qpos * 2048;
#pragma unroll
    for (int i = 0; i < 4; ++i)
#pragma unroll
        for (int rq = 0; rq < 4; ++rq) {
            const float v0 = oacc[i][rq * 4], v1 = oacc[i][rq * 4 + 1], v2 = oacc[i][rq * 4 + 2], v3 = oacc[i][rq * 4 + 3];
            ss += v0 * v0 + v1 * v1 + v2 * v2 + v3 * v3;
            u32x2 w; w.x = cvt_pk_bf16(v0, v1); w.y = cvt_pk_bf16(v2, v3);
            *(u32x2*)(op + i * 32 + 8 * rq + 4 * hh) = w;
        }
    ss += __shfl_xor(ss, 32); if (sq && hh == 0) sq_add(sq, tok0 + qpos, ss);
}

DEV void phase3(const P& p, unsigned char* lds, bool dry = false) {
    unsigned char* ws = p.ws;
    u64* sqb = (u64*)(ws + CTL_SQ);
    bf16_t* omix = (bf16_t*)(ws + WS_OMIX);
    const int G = gridDim.x;
    for (int w = blockIdx.x; w < 512; w += G) {
        const int bh = w >> 5, uu = w & 31, b = bh >> 3, h = bh & 7;
#pragma unroll 1
        for (int half = 0; half < 2; ++half) {
            const int u = half ? (63 - uu) : uu;
            attn_unit<192, true>(lds, (const bf16_t*)(ws + WS_QM) + (size_t)bh * S * 192, (const bf16_t*)(ws + WS_KN) + (size_t)bh * S * 128,
                                 (const bf16_t*)(ws + WS_KPE) + (size_t)b * S * 64, (const bf16_t*)(ws + WS_VMT) + (size_t)bh * 128 * S, S, u * 64, u + 1,
                                 omix + (size_t)b * S * 2048 + h * 128, 2048, dry ? nullptr : sqb + SQ_OMLA * T + b * S, u * 64);
        }
    }
    for (int w = blockIdx.x; w < 512; w += G) {
        const int bh = w >> 5, U = w & 31, b = bh >> 3, h = bh & 7;
        sb_unit(lds, (const bf16_t*)(ws + WS_QSB) + (size_t)bh * S * 128, (const bf16_t*)(ws + WS_KSB) + (size_t)bh * S * 128,
                (const bf16_t*)(ws + WS_VSBT) + (size_t)bh * 128 * S, U, omix + (size_t)b * S * 2048 + 1024 + h * 128, dry ? nullptr : sqb + SQ_OSB * T, b * S);
    }
}

DEV void phase4(const P& p, unsigned char* lds, bool dry = false) {
    unsigned char* ws = p.ws;
    const XcdIter xi = xcd_iter();
    const int lane = threadIdx.x & 63, wid = threadIdx.x >> 6, wr = wid >> 1, wc = wid & 1, fr = lane & 15, fq = lane >> 4;
    u64* sqb = (u64*)(ws + CTL_SQ);
    float* x1 = (float*)(ws + WS_X1); bf16_t* x1b = (bf16_t*)(ws + WS_X1B);
    const int per_x = 8 * 16, total = 64 * 16;
    for (int it = 0;; ++it) {
        int mt, nt;
        if (xi.x >= 0) { const int i = it * xi.per + xi.j; if (i >= per_x) break; mt = xi.x * 8 + (i & 7); nt = i >> 3; }
        else { const int i = it * xi.per + xi.j; if (i >= total) break; mt = i & 63; nt = i >> 6; }
        const int m0 = mt * 128;
        f32x4 acc[4][4]; acc_zero(acc);
        gemm_dense(acc, lds, (const bf16_t*)(ws + WS_OMIX), D, m0, (const bf16_t*)(ws + WS_WOUT), D, nt * 128, 0, 16, true);
        float rsb[4];
#pragma unroll
        for (int j = 0; j < 4; ++j) {
            const int m = m0 + wr * 64 + j * 16 + fr;
            const float ra = sq_rs(sqb + SQ_OMLA * T, m, 1.0f / 1024.0f); rsb[j] = sq_rs(sqb + SQ_OSB * T, m, 1.0f / 1024.0f);
            const float ratio = ra / rsb[j];
#pragma unroll
            for (int i = 0; i < 4; ++i) acc[i][j] *= ratio;
        }
        gemm_dense(acc, lds, (const bf16_t*)(ws + WS_OMIX), D, m0, (const bf16_t*)(ws + WS_WOUT), D, nt * 128, 1024, 16, true);
#pragma unroll
        for (int j = 0; j < 4; ++j) {
            const int m = m0 + wr * 64 + j * 16 + fr; float ss = 0.f;
#pragma unroll
            for (int i = 0; i < 4; ++i) {
                const int n = nt * 128 + wc * 64 + i * 16 + fq * 4;
                const f32x4 xv = *(const f32x4*)(p.x + (size_t)m * D + n);
                const f32x4 v = xv + acc[i][j] * rsb[j];
                ss += v[0] * v[0] + v[1] * v[1] + v[2] * v[2] + v[3] * v[3];
                *(f32x4*)(x1 + (size_t)m * D + n) = v;
                u32x2 w; w.x = cvt_pk_bf16(v[0], v[1]); w.y = cvt_pk_bf16(v[2], v[3]);
                *(u32x2*)(x1b + (size_t)m * D + n) = w;
            }
            ss += __shfl_xor(ss, 16); ss += __shfl_xor(ss, 32); if (fq == 0 && !dry) sq_add(sqb + SQ_X1 * T, m, ss);
        }
    }
}

DEV void phase5(const P& p, unsigned char* lds) {
    unsigned char* ws = p.ws;
    const XcdIter xi = xcd_iter();
    const int lane = threadIdx.x & 63, wid = threadIdx.x >> 6, wr = wid >> 1, wc = wid & 1, fr = lane & 15, fq = lane >> 4;
    const u64* sqb = (const u64*)(ws + CTL_SQ);
    const int per_x = 8 * 4, total = 64 * 4;
    for (int it = 0;; ++it) {
        int mt, nt;
        if (xi.x >= 0) { const int i = it * xi.per + xi.j; if (i >= per_x) break; mt = xi.x * 8 + (i & 7); nt = i >> 3; }
        else { const int i = it * xi.per + xi.j; if (i >= total) break; mt = i & 63; nt = i >> 6; }
        const int m0 = mt * 128, b = m0 >> 12, s0 = m0 & 4095;
        f32x4 acc[4][4]; acc_zero(acc);
        gemm_dense(acc, lds, (const bf16_t*)(ws + WS_X1B), D, m0, (const bf16_t*)(ws + WS_WMQ), D, nt * 128, 0, 32, true);
        bf16_t* qm = (bf16_t*)(ws + WS_QMEM) + (size_t)((b * 4 + nt) * S) * 128;
#pragma unroll
        for (int j = 0; j < 4; ++j) {
            const int ml = wr * 64 + j * 16 + fr;
            const float rs = sq_rs(sqb + SQ_X1 * T, m0 + ml, 1.0f / 2048.0f) * (0.08838834764831845f * LOG2E);
#pragma unroll
            for (int i = 0; i < 4; ++i) {
                const f32x4 v = acc[i][j] * rs;
                u32x2 w; w.x = cvt_pk_bf16(v[0], v[1]); w.y = cvt_pk_bf16(v[2], v[3]);
                *(u32x2*)(qm + (size_t)(s0 + ml) * 128 + wc * 64 + i * 16 + fq * 4) = w;
            }
        }
    }
}

DEV void phase6(const P& p, unsigned char* lds) {
    unsigned char* ws = p.ws;
    for (int w = blockIdx.x; w < 512; w += gridDim.x) {
        const int bh = w >> 6, u = w & 63, b = bh >> 2, h = bh & 3;
        attn_unit<128, false>(lds, (const bf16_t*)(ws + WS_QMEM) + (size_t)bh * S * 128, (const bf16_t*)(ws + WS_KMEM) + (size_t)bh * 256 * 128, nullptr,
                              (const bf16_t*)(ws + WS_VMEMT) + (size_t)bh * 128 * 256, 256, u * 64, 4,
                              (bf16_t*)(ws + WS_OMEM) + (size_t)b * S * 512 + h * 128, 512, nullptr, u * 64);
    }
}

DEV void phase7(const P& p, unsigned char* lds, bool dry = false) {
    unsigned char* ws = p.ws;
    const XcdIter xi = xcd_iter();
    const int lane = threadIdx.x & 63, wid = threadIdx.x >> 6, wr = wid >> 1, wc = wid & 1, fr = lane & 15, fq = lane >> 4;
    u64* sqb = (u64*)(ws + CTL_SQ);
    const float* x1 = (const float*)(ws + WS_X1); bf16_t* x2b = (bf16_t*)(ws + WS_X2B);
    const int per_x = 8 * 16, total = 64 * 16;
    for (int it = 0;; ++it) {
        int mt, nt;
        if (xi.x >= 0) { const int i = it * xi.per + xi.j; if (i >= per_x) break; mt = xi.x * 8 + (i & 7); nt = i >> 3; }
        else { const int i = it * xi.per + xi.j; if (i >= total) break; mt = i & 63; nt = i >> 6; }
        const int m0 = mt * 128;
        f32x4 acc[4][4]; acc_zero(acc);
        gemm_dense(acc, lds, (const bf16_t*)(ws + WS_OMEM), 512, m0, (const bf16_t*)(ws + WS_WMO), 512, nt * 128, 0, 8, true);
#pragma unroll
        for (int j = 0; j < 4; ++j) {
            const int m = m0 + wr * 64 + j * 16 + fr; float ss = 0.f;
#pragma unroll
            for (int i = 0; i < 4; ++i) {
                const int n = nt * 128 + wc * 64 + i * 16 + fq * 4;
                const f32x4 v = *(const f32x4*)(x1 + (size_t)m * D + n) + acc[i][j];
                ss += v[0] * v[0] + v[1] * v[1] + v[2] * v[2] + v[3] * v[3];
                *(f32x4*)(p.out + (size_t)m * D + n) = v;
                const f32x4 gf = *(const f32x4*)(p.norm_ffn + n);
                u32x2 w; w.x = cvt_pk_bf16(v[0] * gf[0], v[1] * gf[1]); w.y = cvt_pk_bf16(v[2] * gf[2], v[3] * gf[3]);
                *(u32x2*)(x2b + (size_t)m * D + n) = w;
            }
            ss += __shfl_xor(ss, 16); ss += __shfl_xor(ss, 32); if (fq == 0 && !dry) sq_add(sqb + SQ_X2 * T, m, ss);
        }
    }
}

DEV void phase8(const P& p, unsigned char* lds) {
    unsigned char* ws = p.ws;
    const int tid = threadIdx.x, lane = tid & 63, wid = tid >> 6, r16 = lane & 15, kq = lane >> 4;
    const float* wrt = (const float*)(ws + WS_WR);
    const u64* sqb = (const u64*)(ws + CTL_SQ);
    unsigned* cnt = (unsigned*)(ws + CTL_CNT);
    unsigned char* rt = ws + WS_ROUTE;
    float* red = (float*)lds;
    for (int tb = blockIdx.x; tb < T / 16; tb += gridDim.x) {
        const int t0 = tb * 16;
        f32x4 acc[3];
#pragma unroll
        for (int c = 0; c < 3; ++c) acc[c] = (f32x4){0.f, 0.f, 0.f, 0.f};
        const float* xa = p.out + (size_t)(t0 + r16) * D + wid * 512 + kq * 4;
        const float* wb = wrt + (size_t)r16 * D + wid * 512 + kq * 4;
#pragma unroll 4
        for (int k = 0; k < 512; k += 16) {
            const f32x4 a = *(const f32x4*)(xa + k);
            const f32x4 b0 = *(const f32x4*)(wb + k), b1 = *(const f32x4*)(wb + 16 * D + k), b2 = *(const f32x4*)(wb + 32 * D + k);
#pragma unroll
            for (int e = 0; e < 4; ++e) {
                acc[0] = __builtin_amdgcn_mfma_f32_16x16x4f32(a[e], b0[e], acc[0], 0, 0, 0);
                acc[1] = __builtin_amdgcn_mfma_f32_16x16x4f32(a[e], b1[e], acc[1], 0, 0, 0);
                acc[2] = __builtin_amdgcn_mfma_f32_16x16x4f32(a[e], b2[e], acc[2], 0, 0, 0);
            }
        }
#pragma unroll
        for (int c = 0; c < 3; ++c)
#pragma unroll
            for (int e = 0; e < 4; ++e) red[(wid * 16 + kq * 4 + e) * 48 + c * 16 + r16] = acc[c][e];
        __syncthreads();
        if (tid < 16) {
            const int tok = t0 + tid;
            const float rs = sq_rs(sqb + SQ_X2 * T, tok, 1.0f / 2048.0f);
            auto logit = [&](int n) { return ((red[(0 * 16 + tid) * 48 + n] + red[(1 * 16 + tid) * 48 + n]) + (red[(2 * 16 + tid) * 48 + n] + red[(3 * 16 + tid) * 48 + n])) * rs; };
            float lg0 = logit(0) + p.b_group[0], lg1 = logit(1) + p.b_group[1], lg2 = logit(2) + p.b_group[2], lg3 = logit(3) + p.b_group[3];
            int g = 0; float gm = lg0;
            if (lg1 > gm) { gm = lg1; g = 1; }
            if (lg2 > gm) { gm = lg2; g = 2; }
            if (lg3 > gm) { gm = lg3; g = 3; }
            const float gden = __expf(lg0 - gm) + __expf(lg1 - gm) + __expf(lg2 - gm) + __expf(lg3 - gm);
            const float pg = 1.0f / gden;
            float el[8];
#pragma unroll
            for (int e = 0; e < 8; ++e) el[e] = logit(4 + g * 8 + e) + p.b_er[g * 8 + e];
            int e1 = 0; float m1 = el[0];
#pragma unroll
            for (int e = 1; e < 8; ++e) if (el[e] > m1) { m1 = el[e]; e1 = e; }
            int e2 = -1; float m2 = -3.0e38f;
#pragma unroll
            for (int e = 0; e < 8; ++e) if (e != e1 && el[e] > m2) { m2 = el[e]; e2 = e; }
            const float x2e = __expf(m2 - m1);
            const float p1 = 1.0f / (1.0f + x2e), p2 = x2e / (1.0f + x2e);
            const int ex1 = g * 8 + e1, ex2 = g * 8 + e2;
            const unsigned pos1 = atomicAdd(cnt + ex1, 1u), pos2 = atomicAdd(cnt + ex2, 1u);
            int* rexp = (int*)(rt + RT_EXP); int* rpos = (int*)(rt + RT_POS); float* rgate = (float*)(rt + RT_GATE); int* rlist = (int*)(rt + RT_LIST);
            rexp[tok * 2] = ex1; rexp[tok * 2 + 1] = ex2; rpos[tok * 2] = (int)pos1; rpos[tok * 2 + 1] = (int)pos2;
            rgate[tok * 2] = pg * p1; rgate[tok * 2 + 1] = pg * p2;
            rlist[ex1 * T + pos1] = tok * 2; rlist[ex2 * T + pos2] = tok * 2 + 1;
        }
        __syncthreads();
    }
}

DEV int moe_table(const P& p, int* tbl  ) {
    const unsigned* cnt = (const unsigned*)(p.ws + CTL_CNT);
    if (threadIdx.x < 64) {
        const int e = threadIdx.x & 31;
        const int c = (int)__hip_atomic_load(cnt + e, __ATOMIC_RELAXED, __HIP_MEMORY_SCOPE_AGENT);
        const int nt = (c + 127) >> 7;
        int incl = nt;
#pragma unroll
        for (int o = 1; o < 32; o <<= 1) { const int v = __shfl_up(incl, o, 32); if (e >= o) incl += v; }
        if (threadIdx.x < 32) { tbl[e] = incl - nt; tbl[33 + e] = c; if (e == 31) tbl[32] = incl; }
    }
    __syncthreads();
    return tbl[32];
}
DEV int moe_find(const int* tbl, int mtile) { int e = 0;
#pragma unroll 1
    for (int k = 16; k >= 1; k >>= 1) if (e + k < 32 && tbl[e + k] <= mtile) e += k;
    return e; }

DEV void phase9(const P& p, unsigned char* lds) {
    unsigned char* ws = p.ws;
    int* tbl = (int*)(lds + LDS_MAIN + 256);
    const int ntm = moe_table(p, tbl);
    const int tid = threadIdx.x, lane = tid & 63, wid = tid >> 6, wr = wid >> 1, wc = wid & 1, fr = lane & 15, fq = lane >> 4;
    const int srow = tid >> 3, sc = stage_col(tid);
    const u64* sqb = (const u64*)(ws + CTL_SQ);
    const int* rlist = (const int*)(ws + WS_ROUTE + RT_LIST); const float* rgate = (const float*)(ws + WS_ROUTE + RT_GATE);
    const bf16_t* x2b = (const bf16_t*)(ws + WS_X2B);
    bf16_t* act = (bf16_t*)(ws + WS_ACT);
    for (int item = blockIdx.x; item < ntm * 8; item += gridDim.x) {
        const int mtile = item >> 3, nt = item & 7;
        const int e = moe_find(tbl, mtile), mi = mtile - tbl[e], cnt = tbl[33 + e];
        const int* le = rlist + (size_t)e * T;
        const bf16_t* ap[4];
#pragma unroll
        for (int i = 0; i < 4; ++i) { int li = mi * 128 + srow + 32 * i; li = li < cnt ? li : cnt - 1; ap[i] = x2b + (size_t)(le[li] >> 1) * D + sc; }
        const int np = (tid & 31) * 4, bi = (np >> 4) & 3;
        const float* bf = ((bi & 1) ? p.w_up : p.w_gate) + (size_t)e * 2048 * 512 + (size_t)(tid >> 5) * 512 + nt * 64 + (np >> 6) * 32 + (bi >> 1) * 16 + (np & 15);
        f32x4 acc[4][4]; acc_zero(acc);
        gemm_acc<true>(acc, lds, ap[0], ap[1], ap[2], ap[3], nullptr, nullptr, nullptr, nullptr, bf, 512, 32, true);
#pragma unroll
        for (int j = 0; j < 4; ++j) {
            const int ml = wr * 64 + j * 16 + fr; int li = mi * 128 + ml; li = li < cnt ? li : cnt - 1;
            const int ent = le[li], tok = ent >> 1;
            const float rs = sq_rs(sqb + SQ_X2 * T, tok, 1.0f / 2048.0f), gt = rgate[ent];
#pragma unroll
            for (int q = 0; q < 2; ++q) {
                const f32x4 a = acc[2 * q][j] * rs, u = acc[2 * q + 1][j] * rs;
                float o[4];
#pragma unroll
                for (int c = 0; c < 4; ++c) o[c] = a[c] / (1.0f + __expf(-a[c])) * u[c] * gt;
                u32x2 w; w.x = cvt_pk_bf16(o[0], o[1]); w.y = cvt_pk_bf16(o[2], o[3]);
                *(u32x2*)(act + (size_t)(mtile * 128 + ml) * 512 + nt * 64 + wc * 32 + q * 16 + fq * 4) = w;
            }
        }
    }
}

DEV void phase10(const P& p, unsigned char* lds) {
    unsigned char* ws = p.ws;
    int* tbl = (int*)(lds + LDS_MAIN + 256);
    const int ntm = moe_table(p, tbl);
    const int tid = threadIdx.x, lane = tid & 63, wid = tid >> 6, wr = wid >> 1, wc = wid & 1, fr = lane & 15, fq = lane >> 4;
    const int* rlist = (const int*)(ws + WS_ROUTE + RT_LIST);
    bf16_t* y = (bf16_t*)(ws + WS_Y);
    for (int item = blockIdx.x; item < ntm * 16; item += gridDim.x) {
        const int mtile = item >> 4, nt = item & 15;
        const int e = moe_find(tbl, mtile), mi = mtile - tbl[e], cnt = tbl[33 + e];
        const int* le = rlist + (size_t)e * T;
        f32x4 acc[4][4]; acc_zero(acc);
        gemm_dense_bf32(acc, lds, (const bf16_t*)(ws + WS_ACT), 512, mtile * 128, p.w_down + (size_t)e * 512 * 2048 + nt * 128, 2048, 8);
#pragma unroll
        for (int j = 0; j < 4; ++j) {
            const int ml = wr * 64 + j * 16 + fr, li = mi * 128 + ml;
            if (li < cnt) {
                const int ent = le[li], tok = ent >> 1, k = ent & 1;
                bf16_t* yp = y + ((size_t)k * T + tok) * D + nt * 128 + wc * 64 + fq * 4;
#pragma unroll
                for (int i = 0; i < 4; ++i) { const f32x4 v = acc[i][j]; u32x2 w; w.x = cvt_pk_bf16(v[0], v[1]); w.y = cvt_pk_bf16(v[2], v[3]); *(u32x2*)(yp + i * 16) = w; }
            }
        }
    }
}

DEV void phase11(const P& p) {
    const int lane = threadIdx.x & 63, gw = blockIdx.x * 4 + (threadIdx.x >> 6), NGW = gridDim.x * 4;
    const bf16_t* y = (const bf16_t*)(p.ws + WS_Y);
    for (int row = gw; row < T; row += NGW) {
        float* xr = p.out + (size_t)row * D;
        const bf16_t* y0 = y + (size_t)row * D; const bf16_t* y1 = y + ((size_t)T + row) * D;
        f32x4 v[8]; float s = 0.f;
#pragma unroll
        for (int i = 0; i < 8; ++i) {
            const int c = i * 256 + lane * 4;
            v[i] = *(const f32x4*)(xr + c);
            const u32x2 a = *(const u32x2*)(y0 + c), b = *(const u32x2*)(y1 + c);
            v[i][0] += __uint_as_float(a.x << 16) + __uint_as_float(b.x << 16);
            v[i][1] += __uint_as_float(a.x & 0xffff0000u) + __uint_as_float(b.x & 0xffff0000u);
            v[i][2] += __uint_as_float(a.y << 16) + __uint_as_float(b.y << 16);
            v[i][3] += __uint_as_float(a.y & 0xffff0000u) + __uint_as_float(b.y & 0xffff0000u);
            s += v[i][0] * v[i][0] + v[i][1] * v[i][1] + v[i][2] * v[i][2] + v[i][3] * v[i][3];
        }
        s = wave_sum(s);
        const float rs = __builtin_amdgcn_rsqf(s * (1.0f / 2048.0f) + EPS);
#pragma unroll
        for (int i = 0; i < 8; ++i) {
            const int c = i * 256 + lane * 4;
            const f32x4 g = *(const f32x4*)(p.norm_final + c);
            *(f32x4*)(xr + c) = v[i] * rs * g;
        }
    }
}

#ifndef USE_CG_SYNC
#define USE_CG_SYNC 0
#endif
__global__ void __launch_bounds__(NTHREADS, 2) hymba_fwd(P p) {
    extern __shared__ __attribute__((aligned(16))) unsigned char lds[];
#if USE_CG_SYNC
    cg::grid_group grid = cg::this_grid();
#endif
    volatile unsigned* st = (volatile unsigned*)(lds + LDS_MAIN);
    if (threadIdx.x < 16) st[threadIdx.x] = 0u;
    __syncthreads();
    XcdBarrier bar = xcd_barrier_post((unsigned*)(p.ws + CTL_BAR), st);
#if USE_CG_SYNC
#define GRID_BAR() grid.sync()
#else
#define GRID_BAR() xcd_barrier(bar)
#endif
#ifndef PROBE_REPEAT
#define PROBE_REPEAT 0
#endif
#define REP(n) ((PROBE_REPEAT >> (n)) & 1)
    phase0(p);        GRID_BAR();
    if (REP(0)) { phase0(p); GRID_BAR(); }
    phase1(p, lds);   GRID_BAR();
    if (REP(1)) { phase1(p, lds, true); GRID_BAR(); }
    phase2(p, lds);   GRID_BAR();
    if (REP(2)) { phase2(p, lds); GRID_BAR(); }
    phase3(p, lds);   GRID_BAR();
    if (REP(3)) { phase3(p, lds, true); GRID_BAR(); }
    phase4(p, lds);   GRID_BAR();
    if (REP(4)) { phase4(p, lds, true); GRID_BAR(); }
    phase5(p, lds);   GRID_BAR();
    if (REP(5)) { phase5(p, lds); GRID_BAR(); }
    phase6(p, lds);   GRID_BAR();
    if (REP(6)) { phase6(p, lds); GRID_BAR(); }
    phase7(p, lds);   GRID_BAR();
    if (REP(7)) { phase7(p, lds, true); GRID_BAR(); }
    phase8(p, lds);   GRID_BAR();
    phase9(p, lds);   GRID_BAR();
    if (REP(9)) { phase9(p, lds); GRID_BAR(); }
    phase10(p, lds);  GRID_BAR();
    if (REP(10)) { phase10(p, lds); GRID_BAR(); }
    phase11(p);
#if USE_CG_SYNC
    grid.sync();
#endif
    (void)bar;
}

extern "C" void kernel_launch(void* const* d_in, const int* in_sizes, int n_in, void* d_out, int out_size, void* d_ws, size_t ws_size, hipStream_t stream) {
    static int grid = 0;
    if (grid == 0) {
        if (n_in != 26 || out_size != T * D || ws_size < WS_END) {
            fprintf(stderr, "kernel_launch: unexpected shapes: n_in %d out %d ws %zu (need %zu)\n", n_in, out_size, ws_size, (size_t)WS_END); grid = -1; return; }
        int dev = 0, cus = 0, per_cu = 0;
        hipGetDevice(&dev);
        hipDeviceGetAttribute(&cus, hipDeviceAttributeMultiprocessorCount, dev);
        if (hipFuncSetAttribute((const void*)hymba_fwd, hipFuncAttributeMaxDynamicSharedMemorySize, LDS_BYTES) != hipSuccess) { fprintf(stderr, "kernel_launch: hipFuncSetAttribute failed\n"); grid = -1; return; }
        if (hipOccupancyMaxActiveBlocksPerMultiprocessor(&per_cu, (const void*)hymba_fwd, NTHREADS, LDS_BYTES) != hipSuccess || per_cu < 1) { fprintf(stderr, "kernel_launch: occupancy query failed (%d)\n", per_cu); grid = -1; return; }
        if (per_cu > 2) per_cu = 2;
        grid = cus * per_cu;
        fprintf(stderr, "kernel_launch: %d CUs x %d blocks\n", cus, per_cu);
    }
    if (grid < 0) return;
    hipMemsetAsync(d_ws, 0, CTL_BYTES, stream);
    P p{};
    p.x = (const float*)d_in[0]; p.mem = (const float*)d_in[1]; p.pos = (const int*)d_in[2];
    p.norm_mix = (const float*)d_in[3]; p.w_in = (const float*)d_in[4]; p.norm_q_lat = (const float*)d_in[5]; p.w_q_b = (const float*)d_in[6];
    p.norm_kv_lat = (const float*)d_in[7]; p.w_kv_b = (const float*)d_in[8]; p.norm_mla_out = (const float*)d_in[9]; p.norm_sb_out = (const float*)d_in[10];
    p.w_out = (const float*)d_in[11]; p.norm_mem_x = (const float*)d_in[12]; p.norm_mem_src = (const float*)d_in[13]; p.w_mem_q = (const float*)d_in[14];
    p.w_mem_kv = (const float*)d_in[15]; p.w_mem_o = (const float*)d_in[16]; p.norm_ffn = (const float*)d_in[17]; p.w_group = (const float*)d_in[18];
    p.b_group = (const float*)d_in[19]; p.w_er = (const float*)d_in[20]; p.b_er = (const float*)d_in[21]; p.w_gate = (const float*)d_in[22];
    p.w_up = (const float*)d_in[23]; p.w_down = (const float*)d_in[24]; p.norm_final = (const float*)d_in[25];
    p.out = (float*)d_out; p.ws = (unsigned char*)d_ws;
    void* args[] = {&p};
    hipError_t e = hipLaunchCooperativeKernel((const void*)hymba_fwd, dim3(grid), dim3(NTHREADS), args, LDS_BYTES, stream);
    if (e != hipSuccess) fprintf(stderr, "kernel_launch: cooperative launch failed: %s (grid %d)\n", hipGetErrorString(e), grid);
}
```

```cpp
#include <hip/hip_runtime.h>
#include <hip/hip_cooperative_groups.h>
#include <cstdio>
#include <cstdint>
namespace cg = cooperative_groups;

typedef unsigned short bf16_t;
typedef short bf16x8 __attribute__((ext_vector_type(8)));
typedef float f32x4 __attribute__((ext_vector_type(4)));
typedef float f32x16 __attribute__((ext_vector_type(16)));
typedef unsigned u32x4 __attribute__((ext_vector_type(4)));
typedef unsigned u32x2 __attribute__((ext_vector_type(2)));
typedef unsigned long long u64;

#define DEV __device__ __forceinline__

constexpr int D = 2048, NB = 2, S = 4096, T = NB * S;
constexpr int MEML = 256, MT = NB * MEML;
constexpr int NIN = 3968;
constexpr float EPS = 1e-6f;
constexpr float LOG2E = 1.4426950408889634f;
constexpr int NTHREADS = 256;
constexpr int LDS_MAIN = 65536;
constexpr int LDS_BYTES = LDS_MAIN + 1024;

constexpr size_t MB = 1024 * 1024;
constexpr size_t WS_CTL = 0;
constexpr size_t CTL_BAR = 0;
constexpr size_t CTL_CNT = 16384;
constexpr size_t CTL_SQ = 32768;
constexpr size_t CTL_BYTES = CTL_SQ + 6 * (size_t)T * 8;
constexpr size_t WS_WIN = 1 * MB;
constexpr size_t WS_WQB = WS_WIN + (size_t)NIN * D * 2;
constexpr size_t WS_WKVB = WS_WQB + 1536 * 512 * 2;
constexpr size_t WS_WOUT = WS_WKVB + 2048 * 256 * 2;
constexpr size_t WS_WMQ = WS_WOUT + (size_t)2048 * 2048 * 2;
constexpr size_t WS_WMKV = WS_WMQ + 512 * 2048 * 2;
constexpr size_t WS_WMO = WS_WMKV + 1024 * 2048 * 2;
constexpr size_t WS_WGU = WS_WMO + 2048 * 512 * 2;
constexpr size_t WS_WD = WS_WGU + (size_t)32 * 1024 * 2048 * 2;
constexpr size_t WS_WR = WS_WD + (size_t)32 * 2048 * 512 * 2;
constexpr size_t WS_H = WS_WR + 48 * 2048 * 4;
constexpr size_t WS_MEMN = WS_H + (size_t)T * D * 2;
constexpr size_t WS_ROPE = WS_MEMN + (size_t)MT * D * 2;
constexpr size_t WS_CQ = WS_ROPE + (size_t)T * 32 * 8;
constexpr size_t WS_CKV = WS_CQ + (size_t)T * 512 * 2;
constexpr size_t WS_QSB = WS_CKV + (size_t)T * 256 * 2;
constexpr size_t WS_KSB = WS_QSB + (size_t)T * 1024 * 2;
constexpr size_t WS_VSBT = WS_KSB + (size_t)T * 1024 * 2;
constexpr size_t WS_KPE = WS_VSBT + (size_t)T * 1024 * 2;
constexpr size_t WS_KMEM = WS_KPE + (size_t)T * 64 * 2;
constexpr size_t WS_VMEMT = WS_KMEM + (size_t)MT * 512 * 2;
constexpr size_t WS_QM = WS_VMEMT + (size_t)MT * 512 * 2;
constexpr size_t WS_KN = WS_QM + (size_t)T * 1536 * 2;
constexpr size_t WS_VMT = WS_KN + (size_t)T * 1024 * 2;
constexpr size_t WS_X1 = WS_VMT + (size_t)T * 1024 * 2;
constexpr size_t WS_ROUTE = WS_X1 + (size_t)T * D * 4;
constexpr size_t RT_SLOT = 0;
constexpr size_t RT_GATE = (size_t)T * 2 * 4;
constexpr size_t RT_EXP = RT_GATE + (size_t)T * 2 * 4;
constexpr size_t RT_POS = RT_EXP + (size_t)T * 2 * 4;
constexpr size_t RT_LIST = RT_POS + (size_t)T * 2 * 4;
constexpr size_t WS_END = WS_ROUTE + RT_LIST + (size_t)32 * T * 4;
constexpr size_t WS_OMIX = WS_H, WS_X2B = WS_H, WS_X1B = WS_QSB, WS_QMEM = WS_CQ, WS_OMEM = WS_KN, WS_ACT = WS_QM, WS_Y = WS_X1;
constexpr int ACT_ROWS_MAX = 2 * T + 32 * 128;

enum { SQ_CQ = 0, SQ_CKV, SQ_OMLA, SQ_OSB, SQ_X1, SQ_X2 };

struct P {
    const float* x; const float* mem; const int* pos;
    const float *norm_mix, *w_in, *norm_q_lat, *w_q_b, *norm_kv_lat, *w_kv_b, *norm_mla_out, *norm_sb_out, *w_out;
    const float *norm_mem_x, *norm_mem_src, *w_mem_q, *w_mem_kv, *w_mem_o, *norm_ffn, *w_group, *b_group, *w_er, *b_er;
    const float *w_gate, *w_up, *w_down, *norm_final;
    float* out; unsigned char* ws;
};

DEV int tidf() { int t = threadIdx.x; asm volatile("" : "+v"(t)); return t; }
DEV unsigned cvt_pk_bf16(float lo, float hi) { unsigned r; asm("v_cvt_pk_bf16_f32 %0, %1, %2" : "=v"(r) : "v"(lo), "v"(hi)); return r; }
#ifndef WT_STORES
#define WT_STORES 1
#endif
DEV void st8(void* p, u32x2 v) {
#if WT_STORES
    asm volatile("global_store_dwordx2 %0, %1, off sc1" :: "v"(p), "v"(v) : "memory");
#else
    *(u32x2*)p = v;
#endif
}
DEV void st16f(void* p, f32x4 v) {
#if WT_STORES
    asm volatile("global_store_dwordx4 %0, %1, off sc1\n\ts_nop 1" :: "v"(p), "v"(v) : "memory");
#else
    *(f32x4*)p = v;
#endif
}
DEV void st16u(void* p, u32x4 v) {
#if WT_STORES
    asm volatile("global_store_dwordx4 %0, %1, off sc1\n\ts_nop 1" :: "v"(p), "v"(v) : "memory");
#else
    *(u32x4*)p = v;
#endif
}
DEV float bf16_to_f32(bf16_t v) { return __uint_as_float(((unsigned)v) << 16); }
DEV float fexp2(float x) { return __builtin_amdgcn_exp2f(x); }
DEV float flog2(float x) { return __builtin_amdgcn_logf(x); }
DEV float wave_sum(float v) {
#pragma unroll
    for (int o = 32; o >= 1; o >>= 1) v += __shfl_xor(v, o);
    return v;
}
DEV void sq_add(u64* sq, int row, float partial) { atomicAdd(sq + row, (u64)__float2ull_rn(partial * 4294967296.0f)); }
DEV float sq_rs(const u64* sq, int row, float inv_n) {
    const u64 v = __hip_atomic_load(sq + row, __ATOMIC_RELAXED, __HIP_MEMORY_SCOPE_AGENT);
    const float ms = (float)((double)v * (1.0 / 4294967296.0)) * inv_n;
    return __builtin_amdgcn_rsqf(ms + EPS);
}
DEV int vperm4(int s0) { const int g = (s0 >> 2) & 3; const int gp = ((g & 1) << 1) | (g >> 1); return (s0 & ~15) | (gp << 2); }

#define XB_TMO      128
#define XB_XCNT(j)  (256  + 64 * (j))
#define XB_XSUB(j)  (1280 + 64 * (j))
#define XB_XGEN(j)  (2304 + 64 * (j))
#define XB_TOP      3328
#define XB_TOPGEN   3392
#define XCD_BAR_WORDS 3456
#define XB_SPIN_CAP (1u << 22)
#define LAS __attribute__((address_space(3)))
DEV unsigned xb_ld(unsigned* p) { return __hip_atomic_load(p, __ATOMIC_RELAXED, __HIP_MEMORY_SCOPE_AGENT); }
DEV unsigned xb_add(unsigned* p, unsigned v) { return __hip_atomic_fetch_add(p, v, __ATOMIC_RELAXED, __HIP_MEMORY_SCOPE_AGENT); }
DEV unsigned xb_xcc_id() { return (unsigned)__builtin_amdgcn_s_getreg((3 << 11) | 20) & 0xFu; }
#define XB_SPIN(cond, bar) do { unsigned _sp = 0; while (cond) { __builtin_amdgcn_s_sleep(1); \
    if ((++_sp & 255u) == 0u) { if (xb_ld(&(bar)[XB_TMO])) break; if (_sp > XB_SPIN_CAP) { atomicAdd(&(bar)[XB_TMO], 1u); break; } } } } while (0)
struct XcdBarrier { unsigned* bar; unsigned x; volatile unsigned* st; };
DEV XcdBarrier xcd_barrier_post(unsigned* bar, volatile unsigned* st) {
    XcdBarrier b; b.bar = bar; b.x = xb_xcc_id(); b.st = st;
    if (threadIdx.x == 0) (void)xb_add(&bar[XB_XCNT(b.x)], 1u);
    return b;
}
DEV void xcd_barrier_complete(unsigned* bar, unsigned x, unsigned& nloc, unsigned& nx) {
    const unsigned G = gridDim.x;
    unsigned sum, cnt, mine, sp = 0u;
    for (;;) {
        sum = 0u; cnt = 0u; mine = 0u;
#pragma unroll
        for (unsigned j = 0; j < 16; ++j) { const unsigned c = xb_ld(&bar[XB_XCNT(j)]); sum += c; cnt += (c > 0u) ? 1u : 0u; mine = (j == x) ? c : mine; }
        if (sum == G) break;
        __builtin_amdgcn_s_sleep(1);
        if ((++sp & 255u) == 0u) { if (xb_ld(&bar[XB_TMO])) break; if (sp > XB_SPIN_CAP) { atomicAdd(&bar[XB_TMO], 1u); break; } }
    }
    nloc = mine > 0u ? mine : 1u; nx = cnt > 0u ? cnt : 1u;
}
DEV void xcd_barrier(const XcdBarrier& b) {
    asm volatile("s_waitcnt vmcnt(0)" ::: "memory");
    __syncthreads();
    if (threadIdx.x == 0) {
        unsigned* bar = b.bar;
        __builtin_amdgcn_s_waitcnt(0);
        unsigned nloc = b.st[0], nx = b.st[1];
        if (nloc == 0u) { xcd_barrier_complete(bar, b.x, nloc, nx); b.st[0] = nloc; b.st[1] = nx; }
        const unsigned old = xb_add(&bar[XB_XSUB(b.x)], 1u);
        const unsigned gen = old / nloc;
        if (old + 1u == (gen + 1u) * nloc) {
            __builtin_amdgcn_fence(__ATOMIC_RELEASE, "agent");
            asm volatile("s_waitcnt vmcnt(0)" ::: "memory");
            const unsigned og = xb_add(&bar[XB_TOP], 1u);
            const unsigned tg = og / nx;
            if (og + 1u == (tg + 1u) * nx) xb_add(&bar[XB_TOPGEN], 1u);
            else XB_SPIN(xb_ld(&bar[XB_TOPGEN]) == tg, bar);
            __builtin_amdgcn_fence(__ATOMIC_ACQUIRE, "agent");
            xb_add(&bar[XB_XGEN(b.x)], 1u);
            asm volatile("s_waitcnt vmcnt(0)" ::: "memory");
        } else {
            XB_SPIN(xb_ld(&bar[XB_XGEN(b.x)]) == gen, bar);
            __builtin_amdgcn_fence(__ATOMIC_ACQUIRE, "agent");
            asm volatile("s_waitcnt vmcnt(0)" ::: "memory");
        }
    }
    __syncthreads();
}

struct XcdIter { int x, j, per; };
DEV XcdIter xcd_iter() { XcdIter r; const int G = gridDim.x; if ((G & 7) == 0) { r.x = blockIdx.x & 7; r.j = blockIdx.x >> 3; r.per = G >> 3; } else { r.x = -1; r.j = blockIdx.x; r.per = G; } return r; }

#define GLDS16(g, l) __builtin_amdgcn_global_load_lds((const unsigned*)(g), (LAS unsigned*)(l), 16, 0, 0)
typedef short s16x4 __attribute__((ext_vector_type(4)));
DEV int stage_col(int tid) { return (((tid & 7) ^ ((tid >> 3) & 7)) << 3); }
#ifndef PF_DIST
#define PF_DIST 3
#endif
template <bool BF32>
DEV void gemm_acc(f32x4 (&acc)[4][4], unsigned char* lds, const bf16_t* a0, const bf16_t* a1, const bf16_t* a2, const bf16_t* a3,
                  const bf16_t* b0, const bf16_t* b1, const bf16_t* b2, const bf16_t* b3, const float* bf, int ldn, int nkt, bool swap, const float* pf = nullptr) {
    const int tid = tidf();
    const int lane = tid & 63, wid = tid >> 6, wr = wid >> 1, wc = wid & 1, fr = lane & 15, fq = lane >> 4;
    const int xbase = swap ? (16384 + wc * 8192) : (wr * 8192);
    const int ybase = swap ? (wr * 8192) : (16384 + wc * 8192);
    unsigned char* ldw = lds + wid * 1024;
    const int n4 = tid & 31, kr = tid >> 5;
    const int wofs = 16384 + kr * 256 + (n4 & 3) * 8, sl0 = ((n4 >> 2) ^ (kr & 3)) << 5, sl1 = ((n4 >> 2) ^ ((kr & 3) | 4)) << 5;
    const int tq = (lane >> 2) & 3, gq = tq | ((fq & 1) << 2);
    const int wrd = 16384 + (8 * fq + tq) * 256 + 8 * (lane & 3);
    f32x4 rb[8];
    auto stage_a = [&](int buf, int ko) { GLDS16(a0 + ko, ldw + buf); GLDS16(a1 + ko, ldw + buf + 4096); GLDS16(a2 + ko, ldw + buf + 8192); GLDS16(a3 + ko, ldw + buf + 12288); };
    auto stage_b = [&](int buf, int ko) { GLDS16(b0 + ko, ldw + buf + 16384); GLDS16(b1 + ko, ldw + buf + 16384 + 4096); GLDS16(b2 + ko, ldw + buf + 16384 + 8192); GLDS16(b3 + ko, ldw + buf + 16384 + 12288); };
    auto load_bf = [&](int kt) {
#pragma unroll
        for (int i = 0; i < 8; ++i) rb[i] = *(const f32x4*)(bf + (size_t)(kt * 64 + 8 * i) * ldn);
    };
    auto write_bf = [&](int buf) {
#pragma unroll
        for (int i = 0; i < 8; ++i) {
            u32x2 w; w.x = cvt_pk_bf16(rb[i][0], rb[i][1]); w.y = cvt_pk_bf16(rb[i][2], rb[i][3]);
            *(u32x2*)(lds + buf + wofs + i * 2048 + ((i & 1) ? sl1 : sl0)) = w;
        }
    };
    stage_a(0, 0);
    if (BF32) { load_bf(0); write_bf(0); } else stage_b(0, 0);
    asm volatile("s_waitcnt vmcnt(0)" ::: "memory");
    __syncthreads();
    float pf_old = 0.f;
    for (int kt = 0; kt < nkt; ++kt) {
        const int cur = (kt & 1) * 32768, nxt = 32768 - cur;
        const bool more = (kt + 1 < nkt);
        if (more) { stage_a(nxt, (kt + 1) * 64); if (BF32) load_bf(kt + 1); else stage_b(nxt, (kt + 1) * 64); }
        float pf_new = 0.f; const bool pfi = BF32 && pf && (kt + PF_DIST < nkt);
        if (pfi) pf_new = *(pf + (size_t)(kt + PF_DIST) * 64 * ldn);
        __builtin_amdgcn_sched_barrier(0);
#pragma unroll
        for (int ks = 0; ks < 2; ++ks) {
            bf16x8 xf[4], yf[4];
            const int coff = (((ks * 4 + fq) ^ (fr & 7)) << 4) + fr * 128;
            if (BF32) {
#pragma unroll
                for (int i = 0; i < 4; ++i) {
                    const int o = cur + wrd + ks * 8192 + (((wc * 4 + i) ^ gq) << 5);
                    const s16x4 lo = __builtin_amdgcn_ds_read_tr16_b64_v4i16((LAS s16x4*)(lds + o));
                    const s16x4 hi = __builtin_amdgcn_ds_read_tr16_b64_v4i16((LAS s16x4*)(lds + o + 1024));
                    xf[i] = __builtin_shufflevector(lo, hi, 0, 1, 2, 3, 4, 5, 6, 7);
                    yf[i] = *(const bf16x8*)(lds + cur + wr * 8192 + i * 2048 + coff);
                }
            } else {
#pragma unroll
                for (int i = 0; i < 4; ++i) { xf[i] = *(const bf16x8*)(lds + cur + xbase + i * 2048 + coff); yf[i] = *(const bf16x8*)(lds + cur + ybase + i * 2048 + coff); }
            }
#pragma unroll
            for (int i = 0; i < 4; ++i)
#pragma unroll
                for (int j = 0; j < 4; ++j) acc[i][j] = __builtin_amdgcn_mfma_f32_16x16x32_bf16(xf[i], yf[j], acc[i][j], 0, 0, 0);
        }
        if (BF32 && more) write_bf(nxt);
        if (BF32) {
            if (pfi) asm volatile("s_waitcnt vmcnt(1) lgkmcnt(0)" ::: "memory"); else asm volatile("s_waitcnt vmcnt(0) lgkmcnt(0)" ::: "memory");
            asm volatile("" :: "v"(pf_old));
            pf_old = pf_new;
            __builtin_amdgcn_s_barrier();
            asm volatile("" ::: "memory");
        } else {
            asm volatile("s_waitcnt vmcnt(0)" ::: "memory");
            __syncthreads();
        }
    }
    if (BF32) asm volatile("" :: "v"(pf_old));
}
DEV void acc_zero(f32x4 (&acc)[4][4]) {
#pragma unroll
    for (int i = 0; i < 4; ++i)
#pragma unroll
        for (int j = 0; j < 4; ++j) acc[i][j] = (f32x4){0.f, 0.f, 0.f, 0.f};
}
DEV void gemm_dense(f32x4 (&acc)[4][4], unsigned char* lds, const bf16_t* A, int lda, int m0, const bf16_t* Bt, int ldb, int n0, int k0, int nkt, bool swap) {
    const int tid = tidf();
    const int srow = tid >> 3, sc = stage_col(tid);
    const bf16_t* a = A + (size_t)(m0 + srow) * lda + k0 + sc;
    const bf16_t* b = Bt + (size_t)(n0 + srow) * ldb + k0 + sc;
    gemm_acc<false>(acc, lds, a, a + (size_t)32 * lda, a + (size_t)64 * lda, a + (size_t)96 * lda, b, b + (size_t)32 * ldb, b + (size_t)64 * ldb, b + (size_t)96 * ldb, nullptr, 0, nkt, swap);
}
DEV void gemm_dense_bf32(f32x4 (&acc)[4][4], unsigned char* lds, const bf16_t* A, int lda, int m0, const float* Bsrc, int ldn, int nkt) {
    const int tid = tidf();
    const int srow = tid >> 3, sc = stage_col(tid);
    const bf16_t* a = A + (size_t)(m0 + srow) * lda + sc;
    const float* bf = Bsrc + (size_t)(tid >> 5) * ldn + (tid & 31) * 4;
    const float* pf = Bsrc + (size_t)(tid >> 2) * ldn + (tid & 3) * 32;
    gemm_acc<true>(acc, lds, a, a + (size_t)32 * lda, a + (size_t)64 * lda, a + (size_t)96 * lda, nullptr, nullptr, nullptr, nullptr, bf, ldn, nkt, true, pf);
}

template <class GainF, class RowF>
DEV void transpose_item(const float* src, int N, bf16_t* dst, int ldd, int k0, int n0, int lane, GainF gain, RowF dstrow) {
    const int ln = lane & 7, lk = lane >> 3;
    const int k = k0 + lk * 8, n = n0 + ln * 4;
    f32x4 v[8];
#pragma unroll
    for (int kk = 0; kk < 8; ++kk) v[kk] = *(const f32x4*)(src + (size_t)(k + kk) * N + n);
    float g[8];
#pragma unroll
    for (int kk = 0; kk < 8; ++kk) g[kk] = gain(k + kk);
#pragma unroll
    for (int j = 0; j < 4; ++j) {
        u32x4 w;
        w.x = cvt_pk_bf16(v[0][j] * g[0], v[1][j] * g[1]); w.y = cvt_pk_bf16(v[2][j] * g[2], v[3][j] * g[3]);
        w.z = cvt_pk_bf16(v[4][j] * g[4], v[5][j] * g[5]); w.w = cvt_pk_bf16(v[6][j] * g[6], v[7][j] * g[7]);
        st16u(dst + (size_t)dstrow(n + j) * ldd + k, w);
    }
}
DEV int rope_perm64(int i) { return i < 32 ? 2 * i : 2 * (i - 32) + 1; }

DEV void rms_row_to_bf16(const float* src, const float* g, bf16_t* dst, int lane) {
    f32x4 v[8]; float s = 0.f;
#pragma unroll
    for (int i = 0; i < 8; ++i) { v[i] = *(const f32x4*)(src + i * 256 + lane * 4); s += v[i][0] * v[i][0] + v[i][1] * v[i][1] + v[i][2] * v[i][2] + v[i][3] * v[i][3]; }
    s = wave_sum(s);
    const float rs = __builtin_amdgcn_rsqf(s * (1.0f / 2048.0f) + EPS);
#pragma unroll
    for (int i = 0; i < 8; ++i) {
        const f32x4 gg = *(const f32x4*)(g + i * 256 + lane * 4);
        u32x2 w; w.x = cvt_pk_bf16(v[i][0] * rs * gg[0], v[i][1] * rs * gg[1]); w.y = cvt_pk_bf16(v[i][2] * rs * gg[2], v[i][3] * rs * gg[3]);
        st8(dst + i * 256 + lane * 4, w);
    }
}

DEV void phase0(const P& p) {
    const int lane = tidf() & 63, gw = blockIdx.x * 4 + (tidf() >> 6), NGW = gridDim.x * 4;
    unsigned char* ws = p.ws;
    constexpr int I_IN = 32 * 122, I_QB = 8 * 48, I_KVB = 4 * 64, I_OUT = 32 * 64, I_MQ = 32 * 16, I_MKV = 32 * 32, I_MO = 8 * 64;
    constexpr int NITEMS = I_IN + I_QB + I_KVB + I_OUT + I_MQ + I_MKV + I_MO;
    for (int it = gw; it < NITEMS; it += NGW) {
        int r = it;
        if (r < I_IN) { const int kt = r / 122, nt = r % 122;
            transpose_item(p.w_in, 3904, (bf16_t*)(ws + WS_WIN), D, kt * 64, nt * 32, lane, [](int) { return 1.0f; },
                [](int n) { return n < 768 ? n : (n < 832 ? 3840 + rope_perm64(n - 768) : n - 64); }); continue; }
        r -= I_IN;
        if (r < I_QB) { const int kt = r / 48, nt = r % 48; const float* g = p.norm_q_lat;
            transpose_item(p.w_q_b, 1536, (bf16_t*)(ws + WS_WQB), 512, kt * 64, nt * 32, lane, [g](int k) { return g[k]; },
                [](int n) { const int h = n / 192, d = n % 192; return h * 192 + (d < 128 ? d : 128 + rope_perm64(d - 128)); }); continue; }
        r -= I_QB;
        if (r < I_KVB) { const int kt = r / 64, nt = r % 64; const float* g = p.norm_kv_lat;
            transpose_item(p.w_kv_b, 2048, (bf16_t*)(ws + WS_WKVB), 256, kt * 64, nt * 32, lane, [g](int k) { return g[k]; }, [](int n) { return n; }); continue; }
        r -= I_KVB;
        if (r < I_OUT) { const int kt = r / 64, nt = r % 64; const float* g1 = p.norm_mla_out; const float* g2 = p.norm_sb_out;
            transpose_item(p.w_out, 2048, (bf16_t*)(ws + WS_WOUT), 2048, kt * 64, nt * 32, lane, [g1, g2](int k) { return k < 1024 ? g1[k] : g2[k - 1024]; }, [](int n) { return n; }); continue; }
        r -= I_OUT;
        if (r < I_MQ) { const int kt = r / 16, nt = r % 16; const float* g = p.norm_mem_x;
            transpose_item(p.w_mem_q, 512, (bf16_t*)(ws + WS_WMQ), 2048, kt * 64, nt * 32, lane, [g](int k) { return g[k]; }, [](int n) { return n; }); continue; }
        r -= I_MQ;
        if (r < I_MKV) { const int kt = r / 32, nt = r % 32;
            transpose_item(p.w_mem_kv, 1024, (bf16_t*)(ws + WS_WMKV), 2048, kt * 64, nt * 32, lane, [](int) { return 1.0f; }, [](int n) { return n; }); continue; }
        r -= I_MKV;
        { const int kt = r / 64, nt = r % 64;
            transpose_item(p.w_mem_o, 2048, (bf16_t*)(ws + WS_WMO), 512, kt * 64, nt * 32, lane, [](int) { return 1.0f; }, [](int n) { return n; }); }
    }
    {
        float* wr = (float*)(ws + WS_WR);
        for (int i = blockIdx.x * NTHREADS + tidf(); i < 48 * 2048; i += gridDim.x * NTHREADS) {
            const int n = i >> 11, k = i & 2047;
            float v = 0.f;
            if (n < 4) v = p.w_group[k * 4 + n] * p.norm_ffn[k]; else if (n < 36) v = p.w_er[k * 32 + (n - 4)] * p.norm_ffn[k];
            wr[i] = v;
        }
    }
    {
        float* rt = (float*)(ws + WS_ROPE);
        for (int i = blockIdx.x * NTHREADS + tidf(); i < T * 32; i += gridDim.x * NTHREADS) {
            const int t = i >> 5, f = i & 31;
            const float inv_freq = exp2f(-(float)f * (13.287712379549449f / 32.0f));
            const float ang = (float)p.pos[t] * inv_freq;
            const double turns = (double)ang * 0.15915494309189535;
            const float fr = (float)(turns - floor(turns));
            rt[2 * i] = __builtin_amdgcn_cosf(fr); rt[2 * i + 1] = __builtin_amdgcn_sinf(fr);
        }
    }
    for (int row = gw; row < T + MT; row += NGW) {
        if (row < T) rms_row_to_bf16(p.x + (size_t)row * D, p.norm_mix, (bf16_t*)(ws + WS_H) + (size_t)row * D, lane);
        else rms_row_to_bf16(p.mem + (size_t)(row - T) * D, p.norm_mem_src, (bf16_t*)(ws + WS_MEMN) + (size_t)(row - T) * D, lane);
    }
}

DEV void store_rowmajor_sq(const f32x4 (&acc)[4][4], bf16_t* dst, int ldd, int m0, int ncol0, u64* sq, float scale) {
    const int lane = tidf() & 63, wid = tidf() >> 6, wr = wid >> 1, wc = wid & 1, fr = lane & 15, fq = lane >> 4;
#pragma unroll
    for (int j = 0; j < 4; ++j) {
        const int m = m0 + wr * 64 + j * 16 + fr; float ss = 0.f;
#pragma unroll
        for (int i = 0; i < 4; ++i) {
            const f32x4 v = acc[i][j];
            ss += v[0] * v[0] + v[1] * v[1] + v[2] * v[2] + v[3] * v[3];
            u32x2 w; w.x = cvt_pk_bf16(v[0] * scale, v[1] * scale); w.y = cvt_pk_bf16(v[2] * scale, v[3] * scale);
            st8(dst + (size_t)m * ldd + ncol0 + wc * 64 + i * 16 + fq * 4, w);
        }
        if (sq) { ss += __shfl_xor(ss, 16); ss += __shfl_xor(ss, 32); if (fq == 0) sq_add(sq, m, ss); }
    }
}
DEV void store_transposed(const f32x4 (&acc)[4][4], bf16_t* dst, int L, int s0, const float* rs  ) {
    const int lane = tidf() & 63, wid = tidf() >> 6, wr = wid >> 1, wc = wid & 1, fr = lane & 15, fq = lane >> 4;
#pragma unroll
    for (int i = 0; i < 4; ++i) {
        const int ml = wr * 64 + i * 16 + fq * 4;
        float r0 = 1.f, r1 = 1.f, r2 = 1.f, r3 = 1.f;
        if (rs) { r0 = rs[ml]; r1 = rs[ml + 1]; r2 = rs[ml + 2]; r3 = rs[ml + 3]; }
        const int pos = vperm4(s0 + ml);
#pragma unroll
        for (int j = 0; j < 4; ++j) {
            const int n = wc * 64 + j * 16 + fr; const f32x4 v = acc[i][j];
            u32x2 w; w.x = cvt_pk_bf16(v[0] * r0, v[1] * r1); w.y = cvt_pk_bf16(v[2] * r2, v[3] * r3);
            st8(dst + (size_t)n * L + pos, w);
        }
    }
}

DEV void phase1(const P& p, unsigned char* lds, bool dry = false) {
    unsigned char* ws = p.ws;
    const XcdIter xi = xcd_iter();
    const int lane = tidf() & 63, wid = tidf() >> 6, wr = wid >> 1, wc = wid & 1, fr = lane & 15, fq = lane >> 4;
    u64* sqb = (u64*)(ws + CTL_SQ);
    u64* sq_cq = dry ? nullptr : sqb + SQ_CQ * T; u64* sq_ckv = dry ? nullptr : sqb + SQ_CKV * T;
    const int per_x = 8 * 31 + 4, total = 64 * 31 + 32;
    for (int it = 0;; ++it) {
        int mt, nt; bool memkv = false;
        if (xi.x >= 0) { const int i = it * xi.per + xi.j; if (i >= per_x) break;
            if (i < 248) { mt = xi.x * 8 + (i & 7); nt = i >> 3; } else { memkv = true; const int q = xi.x * 4 + (i - 248); mt = q & 3; nt = q >> 2; } }
        else { const int i = it * xi.per + xi.j; if (i >= total) break;
            if (i < 1984) { mt = i & 63; nt = i >> 6; } else { memkv = true; const int q = i - 1984; mt = q & 3; nt = q >> 2; } }
        f32x4 acc[4][4]; acc_zero(acc);
        if (memkv) {
            const bool isv = nt >= 4;
            gemm_dense(acc, lds, (const bf16_t*)(ws + WS_MEMN), D, mt * 128, (const bf16_t*)(ws + WS_WMKV), D, nt * 128, 0, 32, !isv);
            const int b = mt >> 1, mm0 = (mt & 1) * 128;
            if (!isv) store_rowmajor_sq(acc, (bf16_t*)(ws + WS_KMEM) + (size_t)((b * 4 + nt) * 256) * 128, 128, mm0, 0, nullptr, 1.0f);
            else store_transposed(acc, (bf16_t*)(ws + WS_VMEMT) + (size_t)((b * 4 + (nt - 4)) * 128) * 256, 256, mm0, nullptr);
            continue;
        }
        const bool isv = (nt >= 22 && nt < 30);
        gemm_dense(acc, lds, (const bf16_t*)(ws + WS_H), D, mt * 128, (const bf16_t*)(ws + WS_WIN), D, nt * 128, 0, 32, !isv);
        const int m0 = mt * 128, b = m0 >> 12, s0 = m0 & 4095;
        if (nt < 4) store_rowmajor_sq(acc, (bf16_t*)(ws + WS_CQ), 512, m0, nt * 128, sq_cq, 1.0f);
        else if (nt < 6) store_rowmajor_sq(acc, (bf16_t*)(ws + WS_CKV), 256, m0, (nt - 4) * 128, sq_ckv, 1.0f);
        else if (nt < 14) store_rowmajor_sq(acc, (bf16_t*)(ws + WS_QSB) + (size_t)((b * 8 + (nt - 6)) * S) * 128, 128, s0, 0, nullptr, 0.08838834764831845f * LOG2E);
        else if (nt < 22) store_rowmajor_sq(acc, (bf16_t*)(ws + WS_KSB) + (size_t)((b * 8 + (nt - 14)) * S) * 128, 128, s0, 0, nullptr, 1.0f);
        else if (nt < 30) store_transposed(acc, (bf16_t*)(ws + WS_VSBT) + (size_t)((b * 8 + (nt - 22)) * 128) * S, S, s0, nullptr);
        else if (wc == 0) {
            const float* rt = (const float*)(ws + WS_ROPE);
            bf16_t* kpe = (bf16_t*)(ws + WS_KPE);
#pragma unroll
            for (int j = 0; j < 4; ++j) {
                const int m = m0 + wr * 64 + j * 16 + fr;
#pragma unroll
                for (int i = 0; i < 4; ++i) {
                    const int n = i * 16 + fq * 4; const f32x4 v = acc[i][j];
                    const f32x4 cs = *(const f32x4*)(rt + ((size_t)m * 32 + (n >> 1)) * 2);
                    u32x2 w; w.x = cvt_pk_bf16(v[0] * cs[0] - v[1] * cs[1], v[1] * cs[0] + v[0] * cs[1]);
                    w.y = cvt_pk_bf16(v[2] * cs[2] - v[3] * cs[3], v[3] * cs[2] + v[2] * cs[3]);
                    st8(kpe + (size_t)m * 64 + n, w);
                }
            }
        }
    }
}

DEV void phase2(const P& p, unsigned char* lds) {
    unsigned char* ws = p.ws;
    const XcdIter xi = xcd_iter();
    const int lane = tidf() & 63, wid = tidf() >> 6, wr = wid >> 1, wc = wid & 1, fr = lane & 15, fq = lane >> 4;
    const u64* sqb = (const u64*)(ws + CTL_SQ);
    const int per_x = 8 * 28, total = 64 * 28;
    for (int it = 0;; ++it) {
        int mt, nt;
        if (xi.x >= 0) { const int i = it * xi.per + xi.j; if (i >= per_x) break; mt = xi.x * 8 + (i & 7); nt = i >> 3; }
        else { const int i = it * xi.per + xi.j; if (i >= total) break; mt = i & 63; nt = i >> 6; }
        const int m0 = mt * 128, b = m0 >> 12, s0 = m0 & 4095;
        f32x4 acc[4][4]; acc_zero(acc);
        if (nt < 12) {
            gemm_dense(acc, lds, (const bf16_t*)(ws + WS_CQ), 512, m0, (const bf16_t*)(ws + WS_WQB), 512, nt * 128, 0, 8, true);
            const float* rt = (const float*)(ws + WS_ROPE);
            bf16_t* qm = (bf16_t*)(ws + WS_QM);
            const float qs = 0.07216878364870322f * LOG2E;
#pragma unroll
            for (int j = 0; j < 4; ++j) {
                const int m = m0 + wr * 64 + j * 16 + fr, s = s0 + wr * 64 + j * 16 + fr;
                const float rs = sq_rs(sqb + SQ_CQ * T, m, 1.0f / 512.0f) * qs;
#pragma unroll
                for (int i = 0; i < 4; ++i) {
                    const int n = nt * 128 + wc * 64 + i * 16 + fq * 4, h = n / 192, d = n - h * 192;
                    f32x4 v = acc[i][j] * rs;
                    if (d >= 128) {
                        const f32x4 cs = *(const f32x4*)(rt + ((size_t)m * 32 + ((d - 128) >> 1)) * 2);
                        v = (f32x4){v[0] * cs[0] - v[1] * cs[1], v[1] * cs[0] + v[0] * cs[1], v[2] * cs[2] - v[3] * cs[3], v[3] * cs[2] + v[2] * cs[3]};
                    }
                    u32x2 w; w.x = cvt_pk_bf16(v[0], v[1]); w.y = cvt_pk_bf16(v[2], v[3]);
                    st8(qm + ((size_t)(b * 8 + h) * S + s) * 192 + d, w);
                }
            }
        } else {
            const int nk = nt - 12, h = nk >> 1; const bool isv = nk & 1;
            gemm_dense(acc, lds, (const bf16_t*)(ws + WS_CKV), 256, m0, (const bf16_t*)(ws + WS_WKVB), 256, nk * 128, 0, 4, !isv);
            if (!isv) {
                bf16_t* kn = (bf16_t*)(ws + WS_KN) + (size_t)((b * 8 + h) * S) * 128;
#pragma unroll
                for (int j = 0; j < 4; ++j) {
                    const int ml = wr * 64 + j * 16 + fr;
                    const float rs = sq_rs(sqb + SQ_CKV * T, m0 + ml, 1.0f / 256.0f);
#pragma unroll
                    for (int i = 0; i < 4; ++i) {
                        const f32x4 v = acc[i][j] * rs;
                        u32x2 w; w.x = cvt_pk_bf16(v[0], v[1]); w.y = cvt_pk_bf16(v[2], v[3]);
                        st8(kn + (size_t)(s0 + ml) * 128 + wc * 64 + i * 16 + fq * 4, w);
                    }
                }
            } else {
                bf16_t* vt = (bf16_t*)(ws + WS_VMT) + (size_t)((b * 8 + h) * 128) * S;
#pragma unroll
                for (int i = 0; i < 4; ++i) {
                    const int ml = wr * 64 + i * 16 + fq * 4;
                    const float r0 = sq_rs(sqb + SQ_CKV * T, m0 + ml, 1.0f / 256.0f), r1 = sq_rs(sqb + SQ_CKV * T, m0 + ml + 1, 1.0f / 256.0f);
                    const float r2 = sq_rs(sqb + SQ_CKV * T, m0 + ml + 2, 1.0f / 256.0f), r3 = sq_rs(sqb + SQ_CKV * T, m0 + ml + 3, 1.0f / 256.0f);
                    const int pos = vperm4(s0 + ml);
#pragma unroll
                    for (int j = 0; j < 4; ++j) {
                        const int n = wc * 64 + j * 16 + fr; const f32x4 v = acc[i][j];
                        u32x2 w; w.x = cvt_pk_bf16(v[0] * r0, v[1] * r1); w.y = cvt_pk_bf16(v[2] * r2, v[3] * r3);
                        st8(vt + (size_t)n * S + pos, w);
                    }
                }
            }
        }
    }
}

template <int DQK> struct KStage {
    static constexpr int NIG = DQK / 64;
    u32x4 r[2][NIG];
    const bf16_t* gm; const bf16_t* gp; int l0, l1;
    DEV void init(const bf16_t* Kmain, const bf16_t* Kpe, int t) {
        const int row = t >> 3, c = t & 7;
        gm = Kmain + (size_t)row * 128 + c * 8; gp = (DQK == 192) ? Kpe + (size_t)row * 64 + c * 8 : nullptr;
        if (DQK == 128) { const int lo = row * 256 + ((c ^ (row & 7)) << 4), b3 = (row >> 3) & 1; l0 = lo + (b3 ? 128 : 0); l1 = lo + (b3 ? 0 : 128); }
        else { l0 = row * 384 + ((c ^ ((row >> 1) & 7)) << 4); l1 = l0 + 128; }
    }
    DEV void load(int tile) {
#pragma unroll
        for (int ps = 0; ps < 2; ++ps) {
            const bf16_t* g = gm + ((size_t)tile * 64 + ps * 32) * 128;
            r[ps][0] = *(const u32x4*)g; r[ps][1] = *(const u32x4*)(g + 64);
            if (DQK == 192) r[ps][NIG - 1] = *(const u32x4*)(gp + ((size_t)tile * 64 + ps * 32) * 64);
        }
    }
    DEV void write(unsigned char* ldsK) {
#pragma unroll
        for (int ps = 0; ps < 2; ++ps) {
            *(u32x4*)(ldsK + l0 + ps * 32 * DQK * 2) = r[ps][0]; *(u32x4*)(ldsK + l1 + ps * 32 * DQK * 2) = r[ps][1];
            if (DQK == 192) *(u32x4*)(ldsK + l0 + 256 + ps * 32 * DQK * 2) = r[ps][NIG - 1];
        }
    }
};
struct VStage {
    u32x4 r[4]; const bf16_t* g; int l; size_t rstride;
    DEV void init(const bf16_t* VT, int LV, int t) { const int row = t >> 3, c = t & 7; g = VT + (size_t)row * LV + c * 8; rstride = (size_t)32 * LV; l = row * 128 + ((c ^ ((row >> 1) & 7)) << 4); }
    DEV void load(int tile) {
#pragma unroll
        for (int i = 0; i < 4; ++i) r[i] = *(const u32x4*)(g + i * rstride + (size_t)tile * 64);
    }
    DEV void write(unsigned char* ldsV) {
#pragma unroll
        for (int i = 0; i < 4; ++i) *(u32x4*)(ldsV + l + i * 4096) = r[i];
    }
};
template <int DQK> DEV int kfrag_off(int krow, int ks, int hh) {
    const int c = 2 * ks + hh;
    if (DQK == 128) return krow * 256 + ((c ^ (krow & 15)) << 4);
    else return krow * 384 + ((((c & ~7) | ((c & 7) ^ ((krow >> 1) & 7)))) << 4);
}
DEV int vfrag_off(int r, int c) { return r * 128 + ((c ^ ((r >> 1) & 7)) << 4); }

template <int DQK, bool CAUSAL>
DEV void attn_unit(unsigned char* lds, const bf16_t* Q, const bf16_t* Kmain, const bf16_t* Kpe, const bf16_t* VT, int LV, int q0, int ntiles,
                   bf16_t* O, int ldo, u64* sq  , int orow0) {
    constexpr int NKS = DQK / 16, KTILE_BYTES = 64 * DQK * 2;
    const int tid = tidf();
    const int lane = tid & 63, wid = tid >> 6, pr = wid >> 1, kh = wid & 1, l31 = lane & 31, hh = lane >> 5;
    unsigned char* ldsK = lds; unsigned char* ldsV = lds + KTILE_BYTES;
    bf16x8 qf[NKS];
    { const bf16_t* qp = Q + (size_t)(q0 + pr * 32 + l31) * DQK + hh * 8;
#pragma unroll
      for (int ks = 0; ks < NKS; ++ks) qf[ks] = *(const bf16x8*)(qp + ks * 16); }
    f32x16 oacc[4];
#pragma unroll
    for (int i = 0; i < 4; ++i)
#pragma unroll
        for (int r = 0; r < 16; ++r) oacc[i][r] = 0.f;
    float mrun = -1e30f, lrun = 0.f;
    KStage<DQK> ksg; VStage vsg;
    ksg.init(Kmain, Kpe, tid); vsg.init(VT, LV, tid);
    const int krow = kh * 32 + l31;
    int ka[DQK == 128 ? 8 : 4];
#pragma unroll
    for (int i = 0; i < (DQK == 128 ? 8 : 4); ++i) ka[i] = kfrag_off<DQK>(krow, i, hh);
    const int va0 = vfrag_off(l31, kh * 4 + hh), va1 = vfrag_off(l31, kh * 4 + 2 + hh);
    ksg.load(0); vsg.load(0); ksg.write(ldsK); vsg.write(ldsV); __syncthreads();
    const int qpos = q0 + pr * 32 + l31;
    for (int t = 0; t < ntiles; ++t) {
        const bool more = t + 1 < ntiles;
        if (more) { ksg.load(t + 1); vsg.load(t + 1); }
        __builtin_amdgcn_sched_barrier(0);
        const bool diag = CAUSAL && (t == ntiles - 1);
        if (!(diag && pr == 0 && kh == 1)) {
            f32x16 sacc;
#pragma unroll
            for (int r = 0; r < 16; ++r) sacc[r] = 0.f;
#pragma unroll
            for (int ks = 0; ks < NKS; ++ks) {
                const int off = (DQK == 128) ? ka[ks] : (ka[ks & 3] + 128 * (ks >> 2));
                const bf16x8 kf = *(const bf16x8*)(ldsK + off);
                sacc = __builtin_amdgcn_mfma_f32_32x32x16_bf16(kf, qf[ks], sacc, 0, 0, 0);
            }
            if (diag) {
                const int kbase = t * 64 + kh * 32 + 4 * hh;
#pragma unroll
                for (int r = 0; r < 16; ++r) { const int kp = kbase + (r & 3) + 8 * (r >> 2); if (kp > qpos) sacc[r] = -1e30f; }
            }
            float mx = sacc[0];
#pragma unroll
            for (int r = 1; r < 16; ++r) mx = fmaxf(mx, sacc[r]);
            mx = fmaxf(mx, __shfl_xor(mx, 32));
            const float mnew = fmaxf(mrun, mx), alpha = fexp2(mrun - mnew);
            mrun = mnew;
            float ps = 0.f;
#pragma unroll
            for (int r = 0; r < 16; ++r) { sacc[r] = fexp2(sacc[r] - mnew); ps += sacc[r]; }
            lrun = lrun * alpha + ps;
#pragma unroll
            for (int i = 0; i < 4; ++i)
#pragma unroll
                for (int r = 0; r < 16; ++r) oacc[i][r] *= alpha;
#pragma unroll
            for (int s2 = 0; s2 < 2; ++s2) {
                u32x4 pw; pw.x = cvt_pk_bf16(sacc[8 * s2 + 0], sacc[8 * s2 + 1]); pw.y = cvt_pk_bf16(sacc[8 * s2 + 2], sacc[8 * s2 + 3]);
                pw.z = cvt_pk_bf16(sacc[8 * s2 + 4], sacc[8 * s2 + 5]); pw.w = cvt_pk_bf16(sacc[8 * s2 + 6], sacc[8 * s2 + 7]);
                bf16x8 pf; __builtin_memcpy(&pf, &pw, 16);
#pragma unroll
                for (int dvb = 0; dvb < 4; ++dvb) {
                    const bf16x8 vf = *(const bf16x8*)(ldsV + (s2 ? va1 : va0) + dvb * 4096);
                    oacc[dvb] = __builtin_amdgcn_mfma_f32_32x32x16_bf16(vf, pf, oacc[dvb], 0, 0, 0);
                }
            }
        }
        __syncthreads();
        if (more) { ksg.write(ldsK); vsg.write(ldsV); }
        __syncthreads();
    }
    float lw = lrun + __shfl_xor(lrun, 32);
    float* xo = (float*)(lds + pr * 20480);
    if (kh == 1) {
#pragma unroll
        for (int i = 0; i < 4; ++i)
#pragma unroll
            for (int r = 0; r < 16; ++r) xo[(i * 16 + r) * 64 + lane] = oacc[i][r];
        xo[4096 + lane] = mrun; xo[4096 + 64 + lane] = lw;
    }
    __syncthreads();
    if (kh == 0) {
        const float m1 = xo[4096 + lane], l1 = xo[4096 + 64 + lane];
        const float m = fmaxf(mrun, m1), f0 = fexp2(mrun - m), f1 = fexp2(m1 - m);
        const float inv = 1.0f / (lw * f0 + l1 * f1);
        const float c0 = f0 * inv, c1 = f1 * inv;
        float ss = 0.f;
        bf16_t* op = O + (size_t)(orow0 + pr * 32 + l31) * ldo;
#pragma unroll
        for (int i = 0; i < 4; ++i)
#pragma unroll
            for (int rq = 0; rq < 4; ++rq) {
                float v[4];
#pragma unroll
                for (int e = 0; e < 4; ++e) { const int r = rq * 4 + e; v[e] = oacc[i][r] * c0 + xo[(i * 16 + r) * 64 + lane] * c1; ss += v[e] * v[e]; }
                u32x2 w; w.x = cvt_pk_bf16(v[0], v[1]); w.y = cvt_pk_bf16(v[2], v[3]);
                st8(op + i * 32 + 8 * rq + 4 * hh, w);
            }
        if (sq) { ss += __shfl_xor(ss, 32); if (hh == 0) sq_add(sq, orow0 + pr * 32 + l31, ss); }
    }
    __syncthreads();
}

DEV void sb_unit(unsigned char* lds, const bf16_t* Q, const bf16_t* K, const bf16_t* VT, int U, bf16_t* O  , u64* sq, int tok0) {
    constexpr int KTILE_BYTES = 64 * 128 * 2;
    const int tid = tidf();
    const int lane = tid & 63, wid = tid >> 6, l31 = lane & 31, hh = lane >> 5;
    unsigned char* ldsK = lds; unsigned char* ldsV = lds + KTILE_BYTES;
    volatile int* flags = (volatile int*)(lds + LDS_MAIN + 64);
    const int q0 = U * 128 + wid * 32, qpos = q0 + l31;
    bf16x8 qf[8];
    { const bf16_t* qp = Q + (size_t)qpos * 128 + hh * 8;
#pragma unroll
      for (int ks = 0; ks < 8; ++ks) qf[ks] = *(const bf16x8*)(qp + ks * 16); }
    f32x16 oacc[4];
#pragma unroll
    for (int i = 0; i < 4; ++i)
#pragma unroll
        for (int r = 0; r < 16; ++r) oacc[i][r] = 0.f;
    float R = 0.f;
    KStage<128> ksg; VStage vsg;
    ksg.init(K, nullptr, tid); vsg.init(VT, S, tid);
    int ka[8];
#pragma unroll
    for (int i = 0; i < 8; ++i) ka[i] = kfrag_off<128>(l31, i, hh);
    const int va[4] = {vfrag_off(l31, hh), vfrag_off(l31, 2 + hh), vfrag_off(l31, 4 + hh), vfrag_off(l31, 6 + hh)};
    int t = 2 * U + 1;
    ksg.load(t); vsg.load(t); ksg.write(ldsK); vsg.write(ldsV); __syncthreads();
    for (; t >= 0; --t) {
        const bool more = t > 0;
        if (more) { ksg.load(t - 1); vsg.load(t - 1); }
        __builtin_amdgcn_sched_barrier(0);
        const int kt0 = t * 64;
        if (kt0 < q0 + 31) {
            const bool need_mask = (kt0 + 63 >= q0);
#pragma unroll
            for (int kb = 1; kb >= 0; --kb) {
                f32x16 z;
#pragma unroll
                for (int r = 0; r < 16; ++r) z[r] = 0.f;
#pragma unroll
                for (int ks = 0; ks < 8; ++ks) {
                    const bf16x8 kf = *(const bf16x8*)(ldsK + ka[ks] + kb * 8192);
                    z = __builtin_amdgcn_mfma_f32_32x32x16_bf16(kf, qf[ks], z, 0, 0, 0);
                }
                float l1m[16];
#pragma unroll
                for (int r = 0; r < 16; ++r) {
                    const float zz = z[r];
                    const float sp = fmaxf(zz, 0.f) + flog2(1.0f + fexp2(-fabsf(zz)));
                    const int kp = kt0 + kb * 32 + (r & 3) + 8 * (r >> 2) + 4 * hh;
                    const bool ok = !need_mask || (kp < qpos);
                    l1m[r] = ok ? -sp : 0.f;
                    z[r] = ok ? zz : -1e30f;
                }
                float gs[4], pgs[4];
#pragma unroll
                for (int g = 0; g < 4; ++g) { gs[g] = (l1m[4 * g] + l1m[4 * g + 1]) + (l1m[4 * g + 2] + l1m[4 * g + 3]); pgs[g] = __shfl_xor(gs[g], 32); }
                float tail = 0.f;
#pragma unroll
                for (int g = 3; g >= 0; --g) {
                    const float sg = R + tail + (hh == 0 ? pgs[g] : 0.f);
                    const float e2 = l1m[4 * g + 3], e1 = e2 + l1m[4 * g + 2], e0 = e1 + l1m[4 * g + 1];
                    z[4 * g + 3] = fexp2(z[4 * g + 3] + l1m[4 * g + 3] + sg);
                    z[4 * g + 2] = fexp2(z[4 * g + 2] + l1m[4 * g + 2] + sg + e2);
                    z[4 * g + 1] = fexp2(z[4 * g + 1] + l1m[4 * g + 1] + sg + e1);
                    z[4 * g + 0] = fexp2(z[4 * g + 0] + l1m[4 * g + 0] + sg + e0);
                    tail += gs[g] + pgs[g];
                }
                R += tail;
#pragma unroll
                for (int s2 = 0; s2 < 2; ++s2) {
                    u32x4 pw; pw.x = cvt_pk_bf16(z[8 * s2 + 0], z[8 * s2 + 1]); pw.y = cvt_pk_bf16(z[8 * s2 + 2], z[8 * s2 + 3]);
                    pw.z = cvt_pk_bf16(z[8 * s2 + 4], z[8 * s2 + 5]); pw.w = cvt_pk_bf16(z[8 * s2 + 6], z[8 * s2 + 7]);
                    bf16x8 pf; __builtin_memcpy(&pf, &pw, 16);
#pragma unroll
                    for (int dvb = 0; dvb < 4; ++dvb) {
                        const bf16x8 vf = *(const bf16x8*)(ldsV + va[kb * 2 + s2] + dvb * 4096);
                        oacc[dvb] = __builtin_amdgcn_mfma_f32_32x32x16_bf16(vf, pf, oacc[dvb], 0, 0, 0);
                    }
                }
            }
        }
        const bool wdone = __all(R < -160.0f);
        if (lane == 0) flags[wid] = wdone ? 1 : 0;
        __syncthreads();
        const bool alldone = (flags[0] & flags[1] & flags[2] & flags[3]) != 0;
        if (alldone || !more) break;
        ksg.write(ldsK); vsg.write(ldsV);
        __syncthreads();
    }
    __syncthreads();
    float ss = 0.f;
    bf16_t* op = O + (size_t)qpos * 2048;
#pragma unroll
    for (int i = 0; i < 4; ++i)
#pragma unroll
        for (int rq = 0; rq < 4; ++rq) {
            const float v0 = oacc[i][rq * 4], v1 = oacc[i][rq * 4 + 1], v2 = oacc[i][rq * 4 + 2], v3 = oacc[i][rq * 4 + 3];
            ss += v0 * v0 + v1 * v1 + v2 * v2 + v3 * v3;
            u32x2 w; w.x = cvt_pk_bf16(v0, v1); w.y = cvt_pk_bf16(v2, v3);
            st8(op + i * 32 + 8 * rq + 4 * hh, w);
        }
    ss += __shfl_xor(ss, 32); if (sq && hh == 0) sq_add(sq, tok0 + qpos, ss);
}

DEV void phase3(const P& p, unsigned char* lds, bool dry = false) {
    unsigned char* ws = p.ws;
    u64* sqb = (u64*)(ws + CTL_SQ);
    bf16_t* omix = (bf16_t*)(ws + WS_OMIX);
    const int G = gridDim.x;
    for (int w = blockIdx.x; w < 512; w += G) {
        const int bh = w >> 5, uu = w & 31, b = bh >> 3, h = bh & 7;
#pragma unroll 1
        for (int half = 0; half < 2; ++half) {
            const int u = half ? (63 - uu) : uu;
            attn_unit<192, true>(lds, (const bf16_t*)(ws + WS_QM) + (size_t)bh * S * 192, (const bf16_t*)(ws + WS_KN) + (size_t)bh * S * 128,
                                 (const bf16_t*)(ws + WS_KPE) + (size_t)b * S * 64, (const bf16_t*)(ws + WS_VMT) + (size_t)bh * 128 * S, S, u * 64, u + 1,
                                 omix + (size_t)b * S * 2048 + h * 128, 2048, dry ? nullptr : sqb + SQ_OMLA * T + b * S, u * 64);
        }
    }
    for (int w = blockIdx.x; w < 512; w += G) {
        const int bh = w >> 5, U = w & 31, b = bh >> 3, h = bh & 7;
        sb_unit(lds, (const bf16_t*)(ws + WS_QSB) + (size_t)bh * S * 128, (const bf16_t*)(ws + WS_KSB) + (size_t)bh * S * 128,
                (const bf16_t*)(ws + WS_VSBT) + (size_t)bh * 128 * S, U, omix + (size_t)b * S * 2048 + 1024 + h * 128, dry ? nullptr : sqb + SQ_OSB * T, b * S);
    }
}

DEV void phase4(const P& p, unsigned char* lds, bool dry = false) {
    unsigned char* ws = p.ws;
    const XcdIter xi = xcd_iter();
    const int lane = tidf() & 63, wid = tidf() >> 6, wr = wid >> 1, wc = wid & 1, fr = lane & 15, fq = lane >> 4;
    u64* sqb = (u64*)(ws + CTL_SQ);
    float* x1 = (float*)(ws + WS_X1); bf16_t* x1b = (bf16_t*)(ws + WS_X1B);
    const int per_x = 8 * 16, total = 64 * 16;
    for (int it = 0;; ++it) {
        int mt, nt;
        if (xi.x >= 0) { const int i = it * xi.per + xi.j; if (i >= per_x) break; mt = xi.x * 8 + (i & 7); nt = i >> 3; }
        else { const int i = it * xi.per + xi.j; if (i >= total) break; mt = i & 63; nt = i >> 6; }
        const int m0 = mt * 128;
        f32x4 acc[4][4]; acc_zero(acc);
        gemm_dense(acc, lds, (const bf16_t*)(ws + WS_OMIX), D, m0, (const bf16_t*)(ws + WS_WOUT), D, nt * 128, 0, 16, true);
        float rsb[4];
#pragma unroll
        for (int j = 0; j < 4; ++j) {
            const int m = m0 + wr * 64 + j * 16 + fr;
            const float ra = sq_rs(sqb + SQ_OMLA * T, m, 1.0f / 1024.0f); rsb[j] = sq_rs(sqb + SQ_OSB * T, m, 1.0f / 1024.0f);
            const float ratio = ra / rsb[j];
#pragma unroll
            for (int i = 0; i < 4; ++i) acc[i][j] *= ratio;
        }
        gemm_dense(acc, lds, (const bf16_t*)(ws + WS_OMIX), D, m0, (const bf16_t*)(ws + WS_WOUT), D, nt * 128, 1024, 16, true);
#pragma unroll
        for (int j = 0; j < 4; ++j) {
            const int m = m0 + wr * 64 + j * 16 + fr; float ss = 0.f;
#pragma unroll
            for (int i = 0; i < 4; ++i) {
                const int n = nt * 128 + wc * 64 + i * 16 + fq * 4;
                const f32x4 xv = *(const f32x4*)(p.x + (size_t)m * D + n);
                const f32x4 v = xv + acc[i][j] * rsb[j];
                ss += v[0] * v[0] + v[1] * v[1] + v[2] * v[2] + v[3] * v[3];
                st16f(x1 + (size_t)m * D + n, v);
                u32x2 w; w.x = cvt_pk_bf16(v[0], v[1]); w.y = cvt_pk_bf16(v[2], v[3]);
                st8(x1b + (size_t)m * D + n, w);
            }
            ss += __shfl_xor(ss, 16); ss += __shfl_xor(ss, 32); if (fq == 0 && !dry) sq_add(sqb + SQ_X1 * T, m, ss);
        }
    }
}

DEV void phase5(const P& p, unsigned char* lds) {
    unsigned char* ws = p.ws;
    const XcdIter xi = xcd_iter();
    const int lane = tidf() & 63, wid = tidf() >> 6, wr = wid >> 1, wc = wid & 1, fr = lane & 15, fq = lane >> 4;
    const u64* sqb = (const u64*)(ws + CTL_SQ);
    const int per_x = 8 * 4, total = 64 * 4;
    for (int it = 0;; ++it) {
        int mt, nt;
        if (xi.x >= 0) { const int i = it * xi.per + xi.j; if (i >= per_x) break; mt = xi.x * 8 + (i & 7); nt = i >> 3; }
        else { const int i = it * xi.per + xi.j; if (i >= total) break; mt = i & 63; nt = i >> 6; }
        const int m0 = mt * 128, b = m0 >> 12, s0 = m0 & 4095;
        f32x4 acc[4][4]; acc_zero(acc);
        gemm_dense(acc, lds, (const bf16_t*)(ws + WS_X1B), D, m0, (const bf16_t*)(ws + WS_WMQ), D, nt * 128, 0, 32, true);
        bf16_t* qm = (bf16_t*)(ws + WS_QMEM) + (size_t)((b * 4 + nt) * S) * 128;
#pragma unroll
        for (int j = 0; j < 4; ++j) {
            const int ml = wr * 64 + j * 16 + fr;
            const float rs = sq_rs(sqb + SQ_X1 * T, m0 + ml, 1.0f / 2048.0f) * (0.08838834764831845f * LOG2E);
#pragma unroll
            for (int i = 0; i < 4; ++i) {
                const f32x4 v = acc[i][j] * rs;
                u32x2 w; w.x = cvt_pk_bf16(v[0], v[1]); w.y = cvt_pk_bf16(v[2], v[3]);
                st8(qm + (size_t)(s0 + ml) * 128 + wc * 64 + i * 16 + fq * 4, w);
            }
        }
    }
}

DEV void phase6(const P& p, unsigned char* lds) {
    unsigned char* ws = p.ws;
    for (int w = blockIdx.x; w < 512; w += gridDim.x) {
        const int bh = w >> 6, u = w & 63, b = bh >> 2, h = bh & 3;
        attn_unit<128, false>(lds, (const bf16_t*)(ws + WS_QMEM) + (size_t)bh * S * 128, (const bf16_t*)(ws + WS_KMEM) + (size_t)bh * 256 * 128, nullptr,
                              (const bf16_t*)(ws + WS_VMEMT) + (size_t)bh * 128 * 256, 256, u * 64, 4,
                              (bf16_t*)(ws + WS_OMEM) + (size_t)b * S * 512 + h * 128, 512, nullptr, u * 64);
    }
}

DEV void phase7(const P& p, unsigned char* lds, bool dry = false) {
    unsigned char* ws = p.ws;
    const XcdIter xi = xcd_iter();
    const int lane = tidf() & 63, wid = tidf() >> 6, wr = wid >> 1, wc = wid & 1, fr = lane & 15, fq = lane >> 4;
    u64* sqb = (u64*)(ws + CTL_SQ);
    const float* x1 = (const float*)(ws + WS_X1); bf16_t* x2b = (bf16_t*)(ws + WS_X2B);
    const int per_x = 8 * 16, total = 64 * 16;
    for (int it = 0;; ++it) {
        int mt, nt;
        if (xi.x >= 0) { const int i = it * xi.per + xi.j; if (i >= per_x) break; mt = xi.x * 8 + (i & 7); nt = i >> 3; }
        else { const int i = it * xi.per + xi.j; if (i >= total) break; mt = i & 63; nt = i >> 6; }
        const int m0 = mt * 128;
        f32x4 acc[4][4]; acc_zero(acc);
        gemm_dense(acc, lds, (const bf16_t*)(ws + WS_OMEM), 512, m0, (const bf16_t*)(ws + WS_WMO), 512, nt * 128, 0, 8, true);
#pragma unroll
        for (int j = 0; j < 4; ++j) {
            const int m = m0 + wr * 64 + j * 16 + fr; float ss = 0.f;
#pragma unroll
            for (int i = 0; i < 4; ++i) {
                const int n = nt * 128 + wc * 64 + i * 16 + fq * 4;
                const f32x4 v = *(const f32x4*)(x1 + (size_t)m * D + n) + acc[i][j];
                ss += v[0] * v[0] + v[1] * v[1] + v[2] * v[2] + v[3] * v[3];
                st16f(p.out + (size_t)m * D + n, v);
                const f32x4 gf = *(const f32x4*)(p.norm_ffn + n);
                u32x2 w; w.x = cvt_pk_bf16(v[0] * gf[0], v[1] * gf[1]); w.y = cvt_pk_bf16(v[2] * gf[2], v[3] * gf[3]);
                st8(x2b + (size_t)m * D + n, w);
            }
            ss += __shfl_xor(ss, 16); ss += __shfl_xor(ss, 32); if (fq == 0 && !dry) sq_add(sqb + SQ_X2 * T, m, ss);
        }
    }
}

DEV void phase8(const P& p, unsigned char* lds) {
    unsigned char* ws = p.ws;
    const int tid = tidf(), lane = tid & 63, wid = tid >> 6, r16 = lane & 15, kq = lane >> 4;
    const float* wrt = (const float*)(ws + WS_WR);
    const u64* sqb = (const u64*)(ws + CTL_SQ);
    unsigned* cnt = (unsigned*)(ws + CTL_CNT);
    unsigned char* rt = ws + WS_ROUTE;
    float* red = (float*)lds;
    for (int tb = blockIdx.x; tb < T / 16; tb += gridDim.x) {
        const int t0 = tb * 16;
        f32x4 acc[3];
#pragma unroll
        for (int c = 0; c < 3; ++c) acc[c] = (f32x4){0.f, 0.f, 0.f, 0.f};
        const float* xa = p.out + (size_t)(t0 + r16) * D + wid * 512 + kq * 4;
        const float* wb = wrt + (size_t)r16 * D + wid * 512 + kq * 4;
#pragma unroll 4
        for (int k = 0; k < 512; k += 16) {
            const f32x4 a = *(const f32x4*)(xa + k);
            const f32x4 b0 = *(const f32x4*)(wb + k), b1 = *(const f32x4*)(wb + 16 * D + k), b2 = *(const f32x4*)(wb + 32 * D + k);
#pragma unroll
            for (int e = 0; e < 4; ++e) {
                acc[0] = __builtin_amdgcn_mfma_f32_16x16x4f32(a[e], b0[e], acc[0], 0, 0, 0);
                acc[1] = __builtin_amdgcn_mfma_f32_16x16x4f32(a[e], b1[e], acc[1], 0, 0, 0);
                acc[2] = __builtin_amdgcn_mfma_f32_16x16x4f32(a[e], b2[e], acc[2], 0, 0, 0);
            }
        }
#pragma unroll
        for (int c = 0; c < 3; ++c)
#pragma unroll
            for (int e = 0; e < 4; ++e) red[(wid * 16 + kq * 4 + e) * 48 + c * 16 + r16] = acc[c][e];
        __syncthreads();
        if (tid < 16) {
            const int tok = t0 + tid;
            const float rs = sq_rs(sqb + SQ_X2 * T, tok, 1.0f / 2048.0f);
            auto logit = [&](int n) { return ((red[(0 * 16 + tid) * 48 + n] + red[(1 * 16 + tid) * 48 + n]) + (red[(2 * 16 + tid) * 48 + n] + red[(3 * 16 + tid) * 48 + n])) * rs; };
            float lg0 = logit(0) + p.b_group[0], lg1 = logit(1) + p.b_group[1], lg2 = logit(2) + p.b_group[2], lg3 = logit(3) + p.b_group[3];
            int g = 0; float gm = lg0;
            if (lg1 > gm) { gm = lg1; g = 1; }
            if (lg2 > gm) { gm = lg2; g = 2; }
            if (lg3 > gm) { gm = lg3; g = 3; }
            const float gden = __expf(lg0 - gm) + __expf(lg1 - gm) + __expf(lg2 - gm) + __expf(lg3 - gm);
            const float pg = 1.0f / gden;
            float el[8];
#pragma unroll
            for (int e = 0; e < 8; ++e) el[e] = logit(4 + g * 8 + e) + p.b_er[g * 8 + e];
            int e1 = 0; float m1 = el[0];
#pragma unroll
            for (int e = 1; e < 8; ++e) if (el[e] > m1) { m1 = el[e]; e1 = e; }
            int e2 = -1; float m2 = -3.0e38f;
#pragma unroll
            for (int e = 0; e < 8; ++e) if (e != e1 && el[e] > m2) { m2 = el[e]; e2 = e; }
            const float x2e = __expf(m2 - m1);
            const float p1 = 1.0f / (1.0f + x2e), p2 = x2e / (1.0f + x2e);
            const int ex1 = g * 8 + e1, ex2 = g * 8 + e2;
            const unsigned pos1 = atomicAdd(cnt + ex1, 1u), pos2 = atomicAdd(cnt + ex2, 1u);
            int* rexp = (int*)(rt + RT_EXP); int* rpos = (int*)(rt + RT_POS); float* rgate = (float*)(rt + RT_GATE); int* rlist = (int*)(rt + RT_LIST);
            rexp[tok * 2] = ex1; rexp[tok * 2 + 1] = ex2; rpos[tok * 2] = (int)pos1; rpos[tok * 2 + 1] = (int)pos2;
            rgate[tok * 2] = pg * p1; rgate[tok * 2 + 1] = pg * p2;
            rlist[ex1 * T + pos1] = tok * 2; rlist[ex2 * T + pos2] = tok * 2 + 1;
        }
        __syncthreads();
    }
}

DEV int moe_table(const P& p, int* tbl  ) {
    const unsigned* cnt = (const unsigned*)(p.ws + CTL_CNT);
    if (tidf() < 64) {
        const int e = tidf() & 31;
        const int c = (int)__hip_atomic_load(cnt + e, __ATOMIC_RELAXED, __HIP_MEMORY_SCOPE_AGENT);
        const int nt = (c + 127) >> 7;
        int incl = nt;
#pragma unroll
        for (int o = 1; o < 32; o <<= 1) { const int v = __shfl_up(incl, o, 32); if (e >= o) incl += v; }
        if (tidf() < 32) { tbl[e] = incl - nt; tbl[33 + e] = c; if (e == 31) tbl[32] = incl; }
    }
    __syncthreads();
    return tbl[32];
}
DEV int moe_find(const int* tbl, int mtile) { int e = 0;
#pragma unroll 1
    for (int k = 16; k >= 1; k >>= 1) if (e + k < 32 && tbl[e + k] <= mtile) e += k;
    return e; }

DEV void phase9(const P& p, unsigned char* lds) {
    unsigned char* ws = p.ws;
    int* tbl = (int*)(lds + LDS_MAIN + 256);
    const int ntm = moe_table(p, tbl);
    const int tid = tidf(), lane = tid & 63, wid = tid >> 6, wr = wid >> 1, wc = wid & 1, fr = lane & 15, fq = lane >> 4;
    const int srow = tid >> 3, sc = stage_col(tid);
    const u64* sqb = (const u64*)(ws + CTL_SQ);
    const int* rlist = (const int*)(ws + WS_ROUTE + RT_LIST); const float* rgate = (const float*)(ws + WS_ROUTE + RT_GATE);
    const bf16_t* x2b = (const bf16_t*)(ws + WS_X2B);
    bf16_t* act = (bf16_t*)(ws + WS_ACT);
    for (int item = blockIdx.x; item < ntm * 8; item += gridDim.x) {
        const int mtile = item >> 3, nt = item & 7;
        const int e = moe_find(tbl, mtile), mi = mtile - tbl[e], cnt = tbl[33 + e];
        const int* le = rlist + (size_t)e * T;
        const bf16_t* ap[4];
#pragma unroll
        for (int i = 0; i < 4; ++i) { int li = mi * 128 + srow + 32 * i; li = li < cnt ? li : cnt - 1; ap[i] = x2b + (size_t)(le[li] >> 1) * D + sc; }
        const int np = (tid & 31) * 4, bi = (np >> 4) & 3;
        const float* bf = ((bi & 1) ? p.w_up : p.w_gate) + (size_t)e * 2048 * 512 + (size_t)(tid >> 5) * 512 + nt * 64 + (np >> 6) * 32 + (bi >> 1) * 16 + (np & 15);
        f32x4 acc[4][4]; acc_zero(acc);
        const float* pf = ((tid & 2) ? p.w_up : p.w_gate) + (size_t)e * 2048 * 512 + (size_t)(tid >> 2) * 512 + nt * 64 + (tid & 1) * 32;
        float rsj[4], gtj[4];
#pragma unroll
        for (int j = 0; j < 4; ++j) {
            int li = mi * 128 + wr * 64 + j * 16 + fr; li = li < cnt ? li : cnt - 1;
            const int ent = le[li];
            rsj[j] = sq_rs(sqb + SQ_X2 * T, ent >> 1, 1.0f / 2048.0f); gtj[j] = rgate[ent];
        }
        gemm_acc<true>(acc, lds, ap[0], ap[1], ap[2], ap[3], nullptr, nullptr, nullptr, nullptr, bf, 512, 32, true, pf);
#pragma unroll
        for (int j = 0; j < 4; ++j) {
            const int ml = wr * 64 + j * 16 + fr;
            const float rs = rsj[j], gt = gtj[j];
#pragma unroll
            for (int q = 0; q < 2; ++q) {
                const f32x4 a = acc[2 * q][j] * rs, u = acc[2 * q + 1][j] * rs;
                float o[4];
#pragma unroll
                for (int c = 0; c < 4; ++c) o[c] = a[c] / (1.0f + __expf(-a[c])) * u[c] * gt;
                u32x2 w; w.x = cvt_pk_bf16(o[0], o[1]); w.y = cvt_pk_bf16(o[2], o[3]);
                st8(act + (size_t)(mtile * 128 + ml) * 512 + nt * 64 + wc * 32 + q * 16 + fq * 4, w);
            }
        }
    }
}

DEV void phase10(const P& p, unsigned char* lds) {
    unsigned char* ws = p.ws;
    int* tbl = (int*)(lds + LDS_MAIN + 256);
    const int ntm = moe_table(p, tbl);
    const int tid = tidf(), lane = tid & 63, wid = tid >> 6, wr = wid >> 1, wc = wid & 1, fr = lane & 15, fq = lane >> 4;
    const int* rlist = (const int*)(ws + WS_ROUTE + RT_LIST);
    bf16_t* y = (bf16_t*)(ws + WS_Y);
    for (int item = blockIdx.x; item < ntm * 16; item += gridDim.x) {
        const int mtile = item >> 4, nt = item & 15;
        const int e = moe_find(tbl, mtile), mi = mtile - tbl[e], cnt = tbl[33 + e];
        const int* le = rlist + (size_t)e * T;
        f32x4 acc[4][4]; acc_zero(acc);
        int entj[4];
#pragma unroll
        for (int j = 0; j < 4; ++j) { const int li = mi * 128 + wr * 64 + j * 16 + fr; entj[j] = li < cnt ? le[li] : -1; }
        gemm_dense_bf32(acc, lds, (const bf16_t*)(ws + WS_ACT), 512, mtile * 128, p.w_down + (size_t)e * 512 * 2048 + nt * 128, 2048, 8);
#pragma unroll
        for (int j = 0; j < 4; ++j) {
            if (entj[j] >= 0) {
                const int ent = entj[j], tok = ent >> 1, k = ent & 1;
                bf16_t* yp = y + ((size_t)k * T + tok) * D + nt * 128 + wc * 64 + fq * 4;
#pragma unroll
                for (int i = 0; i < 4; ++i) { const f32x4 v = acc[i][j]; u32x2 w; w.x = cvt_pk_bf16(v[0], v[1]); w.y = cvt_pk_bf16(v[2], v[3]); *(u32x2*)(yp + i * 16) = w; }
            }
        }
    }
}

DEV void phase11(const P& p) {
    const int lane = tidf() & 63, gw = blockIdx.x * 4 + (tidf() >> 6), NGW = gridDim.x * 4;
    const bf16_t* y = (const bf16_t*)(p.ws + WS_Y);
    for (int row = gw; row < T; row += NGW) {
        float* xr = p.out + (size_t)row * D;
        const bf16_t* y0 = y + (size_t)row * D; const bf16_t* y1 = y + ((size_t)T + row) * D;
        f32x4 v[8]; float s = 0.f;
#pragma unroll
        for (int i = 0; i < 8; ++i) {
            const int c = i * 256 + lane * 4;
            v[i] = *(const f32x4*)(xr + c);
            const u32x2 a = *(const u32x2*)(y0 + c), b = *(const u32x2*)(y1 + c);
            v[i][0] += __uint_as_float(a.x << 16) + __uint_as_float(b.x << 16);
            v[i][1] += __uint_as_float(a.x & 0xffff0000u) + __uint_as_float(b.x & 0xffff0000u);
            v[i][2] += __uint_as_float(a.y << 16) + __uint_as_float(b.y << 16);
            v[i][3] += __uint_as_float(a.y & 0xffff0000u) + __uint_as_float(b.y & 0xffff0000u);
            s += v[i][0] * v[i][0] + v[i][1] * v[i][1] + v[i][2] * v[i][2] + v[i][3] * v[i][3];
        }
        s = wave_sum(s);
        const float rs = __builtin_amdgcn_rsqf(s * (1.0f / 2048.0f) + EPS);
#pragma unroll
        for (int i = 0; i < 8; ++i) {
            const int c = i * 256 + lane * 4;
            const f32x4 g = *(const f32x4*)(p.norm_final + c);
            *(f32x4*)(xr + c) = v[i] * rs * g;
        }
    }
}

#ifndef USE_CG_SYNC
#define USE_CG_SYNC 0
#endif
__global__ void __launch_bounds__(NTHREADS, 2) hymba_fwd(P p) {
    extern __shared__ __attribute__((aligned(16))) unsigned char lds[];
#if USE_CG_SYNC
    cg::grid_group grid = cg::this_grid();
#endif
    volatile unsigned* st = (volatile unsigned*)(lds + LDS_MAIN);
    if (threadIdx.x < 16) st[threadIdx.x] = 0u;
    __syncthreads();
    XcdBarrier bar = xcd_barrier_post((unsigned*)(p.ws + CTL_BAR), st);
#if USE_CG_SYNC
#define GRID_BAR() grid.sync()
#else
#define GRID_BAR() xcd_barrier(bar)
#endif
#ifndef PROBE_REPEAT
#define PROBE_REPEAT 0
#endif
#define REP(n) ((PROBE_REPEAT >> (n)) & 1)
#ifdef PROBE_BARS
    for (int i = 0; i < PROBE_BARS; ++i) GRID_BAR();
#endif
    phase0(p);        GRID_BAR();
    if (REP(0)) { phase0(p); GRID_BAR(); }
    phase1(p, lds);   GRID_BAR();
    if (REP(1)) { phase1(p, lds, true); GRID_BAR(); }
    phase2(p, lds);   GRID_BAR();
    if (REP(2)) { phase2(p, lds); GRID_BAR(); }
    phase3(p, lds);   GRID_BAR();
    if (REP(3)) { phase3(p, lds, true); GRID_BAR(); }
    phase4(p, lds);   GRID_BAR();
    if (REP(4)) { phase4(p, lds, true); GRID_BAR(); }
    phase5(p, lds);   GRID_BAR();
    if (REP(5)) { phase5(p, lds); GRID_BAR(); }
    phase6(p, lds);   GRID_BAR();
    if (REP(6)) { phase6(p, lds); GRID_BAR(); }
    phase7(p, lds);   GRID_BAR();
    if (REP(7)) { phase7(p, lds, true); GRID_BAR(); }
    phase8(p, lds);   GRID_BAR();
    phase9(p, lds);   GRID_BAR();
    if (REP(9)) { phase9(p, lds); GRID_BAR(); }
    phase10(p, lds);  GRID_BAR();
    if (REP(10)) { phase10(p, lds); GRID_BAR(); }
    phase11(p);
#if USE_CG_SYNC
    grid.sync();
#endif
    (void)bar;
}

extern "C" void kernel_launch(void* const* d_in, const int* in_sizes, int n_in, void* d_out, int out_size, void* d_ws, size_t ws_size, hipStream_t stream) {
    static int grid = 0;
    if (grid == 0) {
        if (n_in != 26 || out_size != T * D || ws_size < WS_END) {
            fprintf(stderr, "kernel_launch: unexpected shapes: n_in %d out %d ws %zu (need %zu)\n", n_in, out_size, ws_size, (size_t)WS_END); grid = -1; return; }
        int dev = 0, cus = 0, per_cu = 0;
        hipGetDevice(&dev);
        hipDeviceGetAttribute(&cus, hipDeviceAttributeMultiprocessorCount, dev);
        if (hipFuncSetAttribute((const void*)hymba_fwd, hipFuncAttributeMaxDynamicSharedMemorySize, LDS_BYTES) != hipSuccess) { fprintf(stderr, "kernel_launch: hipFuncSetAttribute failed\n"); grid = -1; return; }
        if (hipOccupancyMaxActiveBlocksPerMultiprocessor(&per_cu, (const void*)hymba_fwd, NTHREADS, LDS_BYTES) != hipSuccess || per_cu < 1) { fprintf(stderr, "kernel_launch: occupancy query failed (%d)\n", per_cu); grid = -1; return; }
        if (per_cu > 2) per_cu = 2;
        grid = cus * per_cu;
        fprintf(stderr, "kernel_launch: %d CUs x %d blocks\n", cus, per_cu);
    }
    if (grid < 0) return;
    hipMemsetAsync(d_ws, 0, CTL_BYTES, stream);
    P p{};
    p.x = (const float*)d_in[0]; p.mem = (const float*)d_in[1]; p.pos = (const int*)d_in[2];
    p.norm_mix = (const float*)d_in[3]; p.w_in = (const float*)d_in[4]; p.norm_q_lat = (const float*)d_in[5]; p.w_q_b = (const float*)d_in[6];
    p.norm_kv_lat = (const float*)d_in[7]; p.w_kv_b = (const float*)d_in[8]; p.norm_mla_out = (const float*)d_in[9]; p.norm_sb_out = (const float*)d_in[10];
    p.w_out = (const float*)d_in[11]; p.norm_mem_x = (const float*)d_in[12]; p.norm_mem_src = (const float*)d_in[13]; p.w_mem_q = (const float*)d_in[14];
    p.w_mem_kv = (const float*)d_in[15]; p.w_mem_o = (const float*)d_in[16]; p.norm_ffn = (const float*)d_in[17]; p.w_group = (const float*)d_in[18];
    p.b_group = (const float*)d_in[19]; p.w_er = (const float*)d_in[20]; p.b_er = (const float*)d_in[21]; p.w_gate = (const float*)d_in[22];
    p.w_up = (const float*)d_in[23]; p.w_down = (const float*)d_in[24]; p.norm_final = (const float*)d_in[25];
    p.out = (float*)d_out; p.ws = (unsigned char*)d_ws;
    void* args[] = {&p};
    hipError_t e = hipLaunchCooperativeKernel((const void*)hymba_fwd, dim3(grid), dim3(NTHREADS), args, LDS_BYTES, stream);
    if (e != hipSuccess) fprintf(stderr, "kernel_launch: cooperative launch failed: %s (grid %d)\n", hipGetErrorString(e), grid);
}
```

```cpp
#include <hip/hip_runtime.h>
#include <hip/hip_cooperative_groups.h>
#include <cstdio>
#include <cstdint>
namespace cg = cooperative_groups;

typedef unsigned short bf16_t;
typedef short bf16x8 __attribute__((ext_vector_type(8)));
typedef float f32x4 __attribute__((ext_vector_type(4)));
typedef float f32x16 __attribute__((ext_vector_type(16)));
typedef unsigned u32x4 __attribute__((ext_vector_type(4)));
typedef unsigned u32x2 __attribute__((ext_vector_type(2)));
typedef unsigned long long u64;

#define DEV __device__ __forceinline__

constexpr int D = 2048, NB = 2, S = 4096, T = NB * S;
constexpr int MEML = 256, MT = NB * MEML;
constexpr int NIN = 3968;
constexpr float EPS = 1e-6f;
constexpr float LOG2E = 1.4426950408889634f;
constexpr int NTHREADS = 256;
constexpr int LDS_MAIN = 65536;
constexpr int LDS_BYTES = LDS_MAIN + 1024;

constexpr size_t MB = 1024 * 1024;
constexpr size_t WS_CTL = 0;
constexpr size_t CTL_BAR = 0;
constexpr size_t CTL_CNT = 16384;
constexpr size_t CTL_SQ = 32768;
constexpr size_t CTL_BYTES = CTL_SQ + 6 * (size_t)T * 8;
constexpr size_t WS_WIN = 1 * MB;
constexpr size_t WS_WQB = WS_WIN + (size_t)NIN * D * 2;
constexpr size_t WS_WKVB = WS_WQB + 1536 * 512 * 2;
constexpr size_t WS_WOUT = WS_WKVB + 2048 * 256 * 2;
constexpr size_t WS_WMQ = WS_WOUT + (size_t)2048 * 2048 * 2;
constexpr size_t WS_WMKV = WS_WMQ + 512 * 2048 * 2;
constexpr size_t WS_WMO = WS_WMKV + 1024 * 2048 * 2;
constexpr size_t WS_WGU = WS_WMO + 2048 * 512 * 2;
constexpr size_t WS_WD = WS_WGU + (size_t)32 * 1024 * 2048 * 2;
constexpr size_t WS_WR = WS_WD + (size_t)32 * 2048 * 512 * 2;
constexpr size_t WS_H = WS_WR + 48 * 2048 * 4;
constexpr size_t WS_MEMN = WS_H + (size_t)T * D * 2;
constexpr size_t WS_ROPE = WS_MEMN + (size_t)MT * D * 2;
constexpr size_t WS_CQ = WS_ROPE + (size_t)T * 32 * 8;
constexpr size_t WS_CKV = WS_CQ + (size_t)T * 512 * 2;
constexpr size_t WS_QSB = WS_CKV + (size_t)T * 256 * 2;
constexpr size_t WS_KSB = WS_QSB + (size_t)T * 1024 * 2;
constexpr size_t WS_VSBT = WS_KSB + (size_t)T * 1024 * 2;
constexpr size_t WS_KPE = WS_VSBT + (size_t)T * 1024 * 2;
constexpr size_t WS_KMEM = WS_KPE + (size_t)T * 64 * 2;
constexpr size_t WS_VMEMT = WS_KMEM + (size_t)MT * 512 * 2;
constexpr size_t WS_QM = WS_VMEMT + (size_t)MT * 512 * 2;
constexpr size_t WS_KN = WS_QM + (size_t)T * 1536 * 2;
constexpr size_t WS_VMT = WS_KN + (size_t)T * 1024 * 2;
constexpr size_t WS_X1 = WS_VMT + (size_t)T * 1024 * 2;
constexpr size_t WS_ROUTE = WS_X1 + (size_t)T * D * 4;
constexpr size_t RT_SLOT = 0;
constexpr size_t RT_GATE = (size_t)T * 2 * 4;
constexpr size_t RT_EXP = RT_GATE + (size_t)T * 2 * 4;
constexpr size_t RT_POS = RT_EXP + (size_t)T * 2 * 4;
constexpr size_t RT_LIST = RT_POS + (size_t)T * 2 * 4;
constexpr size_t WS_END = WS_ROUTE + RT_LIST + (size_t)32 * T * 4;
constexpr size_t WS_OMIX = WS_H, WS_X2B = WS_H, WS_X1B = WS_QSB, WS_QMEM = WS_CQ, WS_OMEM = WS_KN, WS_ACT = WS_QM, WS_Y = WS_X1;
constexpr int ACT_ROWS_MAX = 2 * T + 32 * 128;

enum { SQ_CQ = 0, SQ_CKV, SQ_OMLA, SQ_OSB, SQ_X1, SQ_X2 };

struct P {
    const float* x; const float* mem; const int* pos;
    const float *norm_mix, *w_in, *norm_q_lat, *w_q_b, *norm_kv_lat, *w_kv_b, *norm_mla_out, *norm_sb_out, *w_out;
    const float *norm_mem_x, *norm_mem_src, *w_mem_q, *w_mem_kv, *w_mem_o, *norm_ffn, *w_group, *b_group, *w_er, *b_er;
    const float *w_gate, *w_up, *w_down, *norm_final;
    float* out; unsigned char* ws;
};

DEV int tidf() { int t = threadIdx.x; asm volatile("" : "+v"(t)); return t; }
DEV unsigned cvt_pk_bf16(float lo, float hi) { unsigned r; asm("v_cvt_pk_bf16_f32 %0, %1, %2" : "=v"(r) : "v"(lo), "v"(hi)); return r; }
#ifndef WT_STORES
#define WT_STORES 1
#endif
DEV void st8(void* p, u32x2 v) {
#if WT_STORES > 1
    asm volatile("global_store_dwordx2 %0, %1, off sc1" :: "v"(p), "v"(v) : "memory");
#else
    *(u32x2*)p = v;
#endif
}
DEV void st16f(void* p, f32x4 v) {
#if WT_STORES
    asm volatile("global_store_dwordx4 %0, %1, off sc1\n\ts_nop 1" :: "v"(p), "v"(v) : "memory");
#else
    *(f32x4*)p = v;
#endif
}
DEV void st16u(void* p, u32x4 v) {
#if WT_STORES
    asm volatile("global_store_dwordx4 %0, %1, off sc1\n\ts_nop 1" :: "v"(p), "v"(v) : "memory");
#else
    *(u32x4*)p = v;
#endif
}
DEV float bf16_to_f32(bf16_t v) { return __uint_as_float(((unsigned)v) << 16); }
DEV float fexp2(float x) { return __builtin_amdgcn_exp2f(x); }
DEV float flog2(float x) { return __builtin_amdgcn_logf(x); }
DEV float wave_sum(float v) {
#pragma unroll
    for (int o = 32; o >= 1; o >>= 1) v += __shfl_xor(v, o);
    return v;
}
DEV void sq_add(u64* sq, int row, float partial) { atomicAdd(sq + row, (u64)__float2ull_rn(partial * 4294967296.0f)); }
DEV float sq_rs(const u64* sq, int row, float inv_n) {
    const u64 v = __hip_atomic_load(sq + row, __ATOMIC_RELAXED, __HIP_MEMORY_SCOPE_AGENT);
    const float ms = (float)((double)v * (1.0 / 4294967296.0)) * inv_n;
    return __builtin_amdgcn_rsqf(ms + EPS);
}
DEV int vperm4(int s0) { const int g = (s0 >> 2) & 3; const int gp = ((g & 1) << 1) | (g >> 1); return (s0 & ~15) | (gp << 2); }

#define XB_TMO      128
#define XB_XCNT(j)  (256  + 64 * (j))
#define XB_XSUB(j)  (1280 + 64 * (j))
#define XB_XGEN(j)  (2304 + 64 * (j))
#define XB_TOP      3328
#define XB_TOPGEN   3392
#define XCD_BAR_WORDS 3456
#define XB_SPIN_CAP (1u << 22)
#define LAS __attribute__((address_space(3)))
DEV unsigned xb_ld(unsigned* p) { return __hip_atomic_load(p, __ATOMIC_RELAXED, __HIP_MEMORY_SCOPE_AGENT); }
DEV unsigned xb_add(unsigned* p, unsigned v) { return __hip_atomic_fetch_add(p, v, __ATOMIC_RELAXED, __HIP_MEMORY_SCOPE_AGENT); }
DEV unsigned xb_xcc_id() { return (unsigned)__builtin_amdgcn_s_getreg((3 << 11) | 20) & 0xFu; }
#define XB_SPIN(cond, bar) do { unsigned _sp = 0; while (cond) { __builtin_amdgcn_s_sleep(1); \
    if ((++_sp & 255u) == 0u) { if (xb_ld(&(bar)[XB_TMO])) break; if (_sp > XB_SPIN_CAP) { atomicAdd(&(bar)[XB_TMO], 1u); break; } } } } while (0)
struct XcdBarrier { unsigned* bar; unsigned x; volatile unsigned* st; };
DEV XcdBarrier xcd_barrier_post(unsigned* bar, volatile unsigned* st) {
    XcdBarrier b; b.bar = bar; b.x = xb_xcc_id(); b.st = st;
    if (threadIdx.x == 0) (void)xb_add(&bar[XB_XCNT(b.x)], 1u);
    return b;
}
DEV void xcd_barrier_complete(unsigned* bar, unsigned x, unsigned& nloc, unsigned& nx) {
    const unsigned G = gridDim.x;
    unsigned sum, cnt, mine, sp = 0u;
    for (;;) {
        sum = 0u; cnt = 0u; mine = 0u;
#pragma unroll
        for (unsigned j = 0; j < 16; ++j) { const unsigned c = xb_ld(&bar[XB_XCNT(j)]); sum += c; cnt += (c > 0u) ? 1u : 0u; mine = (j == x) ? c : mine; }
        if (sum == G) break;
        __builtin_amdgcn_s_sleep(1);
        if ((++sp & 255u) == 0u) { if (xb_ld(&bar[XB_TMO])) break; if (sp > XB_SPIN_CAP) { atomicAdd(&bar[XB_TMO], 1u); break; } }
    }
    nloc = mine > 0u ? mine : 1u; nx = cnt > 0u ? cnt : 1u;
}
DEV void xcd_barrier(const XcdBarrier& b) {
    asm volatile("s_waitcnt vmcnt(0)" ::: "memory");
    __syncthreads();
    if (threadIdx.x == 0) {
        unsigned* bar = b.bar;
        __builtin_amdgcn_s_waitcnt(0);
        unsigned nloc = b.st[0], nx = b.st[1];
        if (nloc == 0u) { xcd_barrier_complete(bar, b.x, nloc, nx); b.st[0] = nloc; b.st[1] = nx; }
        const unsigned old = xb_add(&bar[XB_XSUB(b.x)], 1u);
        const unsigned gen = old / nloc;
        if (old + 1u == (gen + 1u) * nloc) {
            __builtin_amdgcn_fence(__ATOMIC_RELEASE, "agent");
            asm volatile("s_waitcnt vmcnt(0)" ::: "memory");
            const unsigned og = xb_add(&bar[XB_TOP], 1u);
            const unsigned tg = og / nx;
            if (og + 1u == (tg + 1u) * nx) xb_add(&bar[XB_TOPGEN], 1u);
            else XB_SPIN(xb_ld(&bar[XB_TOPGEN]) == tg, bar);
            __builtin_amdgcn_fence(__ATOMIC_ACQUIRE, "agent");
            xb_add(&bar[XB_XGEN(b.x)], 1u);
            asm volatile("s_waitcnt vmcnt(0)" ::: "memory");
        } else {
            XB_SPIN(xb_ld(&bar[XB_XGEN(b.x)]) == gen, bar);
            __builtin_amdgcn_fence(__ATOMIC_ACQUIRE, "agent");
            asm volatile("s_waitcnt vmcnt(0)" ::: "memory");
        }
    }
    __syncthreads();
}

struct XcdIter { int x, j, per; };
DEV XcdIter xcd_iter() { XcdIter r; const int G = gridDim.x; if ((G & 7) == 0) { r.x = blockIdx.x & 7; r.j = blockIdx.x >> 3; r.per = G >> 3; } else { r.x = -1; r.j = blockIdx.x; r.per = G; } return r; }

#define GLDS16(g, l) __builtin_amdgcn_global_load_lds((const unsigned*)(g), (LAS unsigned*)(l), 16, 0, 0)
typedef short s16x4 __attribute__((ext_vector_type(4)));
DEV int stage_col(int tid) { return (((tid & 7) ^ ((tid >> 3) & 7)) << 3); }
#ifndef PF_DIST
#define PF_DIST 3
#endif
template <bool BF32>
DEV void gemm_acc(f32x4 (&acc)[4][4], unsigned char* lds, const bf16_t* a0, const bf16_t* a1, const bf16_t* a2, const bf16_t* a3,
                  const bf16_t* b0, const bf16_t* b1, const bf16_t* b2, const bf16_t* b3, const float* bf, int ldn, int nkt, bool swap, const float* pf = nullptr) {
    const int tid = tidf();
    const int lane = tid & 63, wid = tid >> 6, wr = wid >> 1, wc = wid & 1, fr = lane & 15, fq = lane >> 4;
    const int xbase = swap ? (16384 + wc * 8192) : (wr * 8192);
    const int ybase = swap ? (wr * 8192) : (16384 + wc * 8192);
    unsigned char* ldw = lds + wid * 1024;
    const int n4 = tid & 31, kr = tid >> 5;
    const int wofs = 16384 + kr * 256 + (n4 & 3) * 8, sl0 = ((n4 >> 2) ^ (kr & 3)) << 5, sl1 = ((n4 >> 2) ^ ((kr & 3) | 4)) << 5;
    const int tq = (lane >> 2) & 3, gq = tq | ((fq & 1) << 2);
    const int wrd = 16384 + (8 * fq + tq) * 256 + 8 * (lane & 3);
    f32x4 rb[8];
    auto stage_a = [&](int buf, int ko) { GLDS16(a0 + ko, ldw + buf); GLDS16(a1 + ko, ldw + buf + 4096); GLDS16(a2 + ko, ldw + buf + 8192); GLDS16(a3 + ko, ldw + buf + 12288); };
    auto stage_b = [&](int buf, int ko) { GLDS16(b0 + ko, ldw + buf + 16384); GLDS16(b1 + ko, ldw + buf + 16384 + 4096); GLDS16(b2 + ko, ldw + buf + 16384 + 8192); GLDS16(b3 + ko, ldw + buf + 16384 + 12288); };
    auto load_bf = [&](int kt) {
#pragma unroll
        for (int i = 0; i < 8; ++i) rb[i] = *(const f32x4*)(bf + (size_t)(kt * 64 + 8 * i) * ldn);
    };
    auto write_bf = [&](int buf) {
#pragma unroll
        for (int i = 0; i < 8; ++i) {
            u32x2 w; w.x = cvt_pk_bf16(rb[i][0], rb[i][1]); w.y = cvt_pk_bf16(rb[i][2], rb[i][3]);
            *(u32x2*)(lds + buf + wofs + i * 2048 + ((i & 1) ? sl1 : sl0)) = w;
        }
    };
    stage_a(0, 0);
    if (BF32) { load_bf(0); write_bf(0); } else stage_b(0, 0);
    asm volatile("s_waitcnt vmcnt(0)" ::: "memory");
    __syncthreads();
    float pf_old = 0.f;
    for (int kt = 0; kt < nkt; ++kt) {
        const int cur = (kt & 1) * 32768, nxt = 32768 - cur;
        const bool more = (kt + 1 < nkt);
        if (more) { stage_a(nxt, (kt + 1) * 64); if (BF32) load_bf(kt + 1); else stage_b(nxt, (kt + 1) * 64); }
        float pf_new = 0.f; const bool pfi = BF32 && pf && (kt + PF_DIST < nkt);
        if (pfi) pf_new = *(pf + (size_t)(kt + PF_DIST) * 64 * ldn);
        __builtin_amdgcn_sched_barrier(0);
#pragma unroll
        for (int ks = 0; ks < 2; ++ks) {
            bf16x8 xf[4], yf[4];
            const int coff = (((ks * 4 + fq) ^ (fr & 7)) << 4) + fr * 128;
            if (BF32) {
#pragma unroll
                for (int i = 0; i < 4; ++i) {
                    const int o = cur + wrd + ks * 8192 + (((wc * 4 + i) ^ gq) << 5);
                    const s16x4 lo = __builtin_amdgcn_ds_read_tr16_b64_v4i16((LAS s16x4*)(lds + o));
                    const s16x4 hi = __builtin_amdgcn_ds_read_tr16_b64_v4i16((LAS s16x4*)(lds + o + 1024));
                    xf[i] = __builtin_shufflevector(lo, hi, 0, 1, 2, 3, 4, 5, 6, 7);
                    yf[i] = *(const bf16x8*)(lds + cur + wr * 8192 + i * 2048 + coff);
                }
            } else {
#pragma unroll
                for (int i = 0; i < 4; ++i) { xf[i] = *(const bf16x8*)(lds + cur + xbase + i * 2048 + coff); yf[i] = *(const bf16x8*)(lds + cur + ybase + i * 2048 + coff); }
            }
#pragma unroll
            for (int i = 0; i < 4; ++i)
#pragma unroll
                for (int j = 0; j < 4; ++j) acc[i][j] = __builtin_amdgcn_mfma_f32_16x16x32_bf16(xf[i], yf[j], acc[i][j], 0, 0, 0);
        }
        if (BF32 && more) write_bf(nxt);
        if (BF32) {
            if (pfi) asm volatile("s_waitcnt vmcnt(1) lgkmcnt(0)" ::: "memory"); else asm volatile("s_waitcnt vmcnt(0) lgkmcnt(0)" ::: "memory");
            asm volatile("" :: "v"(pf_old));
            pf_old = pf_new;
            __builtin_amdgcn_s_barrier();
            asm volatile("" ::: "memory");
        } else {
            asm volatile("s_waitcnt vmcnt(0)" ::: "memory");
            __syncthreads();
        }
    }
    if (BF32) asm volatile("" :: "v"(pf_old));
}
DEV void acc_zero(f32x4 (&acc)[4][4]) {
#pragma unroll
    for (int i = 0; i < 4; ++i)
#pragma unroll
        for (int j = 0; j < 4; ++j) acc[i][j] = (f32x4){0.f, 0.f, 0.f, 0.f};
}
DEV void gemm_dense(f32x4 (&acc)[4][4], unsigned char* lds, const bf16_t* A, int lda, int m0, const bf16_t* Bt, int ldb, int n0, int k0, int nkt, bool swap) {
    const int tid = tidf();
    const int srow = tid >> 3, sc = stage_col(tid);
    const bf16_t* a = A + (size_t)(m0 + srow) * lda + k0 + sc;
    const bf16_t* b = Bt + (size_t)(n0 + srow) * ldb + k0 + sc;
    gemm_acc<false>(acc, lds, a, a + (size_t)32 * lda, a + (size_t)64 * lda, a + (size_t)96 * lda, b, b + (size_t)32 * ldb, b + (size_t)64 * ldb, b + (size_t)96 * ldb, nullptr, 0, nkt, swap);
}
DEV void gemm_dense_bf32(f32x4 (&acc)[4][4], unsigned char* lds, const bf16_t* A, int lda, int m0, const float* Bsrc, int ldn, int nkt) {
    const int tid = tidf();
    const int srow = tid >> 3, sc = stage_col(tid);
    const bf16_t* a = A + (size_t)(m0 + srow) * lda + sc;
    const float* bf = Bsrc + (size_t)(tid >> 5) * ldn + (tid & 31) * 4;
    const float* pf = Bsrc + (size_t)(tid >> 2) * ldn + (tid & 3) * 32;
    gemm_acc<true>(acc, lds, a, a + (size_t)32 * lda, a + (size_t)64 * lda, a + (size_t)96 * lda, nullptr, nullptr, nullptr, nullptr, bf, ldn, nkt, true, pf);
}

template <class GainF, class RowF>
DEV void transpose_item(const float* src, int N, bf16_t* dst, int ldd, int k0, int n0, int lane, GainF gain, RowF dstrow) {
    const int ln = lane & 7, lk = lane >> 3;
    const int k = k0 + lk * 8, n = n0 + ln * 4;
    f32x4 v[8];
#pragma unroll
    for (int kk = 0; kk < 8; ++kk) v[kk] = *(const f32x4*)(src + (size_t)(k + kk) * N + n);
    float g[8];
#pragma unroll
    for (int kk = 0; kk < 8; ++kk) g[kk] = gain(k + kk);
#pragma unroll
    for (int j = 0; j < 4; ++j) {
        u32x4 w;
        w.x = cvt_pk_bf16(v[0][j] * g[0], v[1][j] * g[1]); w.y = cvt_pk_bf16(v[2][j] * g[2], v[3][j] * g[3]);
        w.z = cvt_pk_bf16(v[4][j] * g[4], v[5][j] * g[5]); w.w = cvt_pk_bf16(v[6][j] * g[6], v[7][j] * g[7]);
        st16u(dst + (size_t)dstrow(n + j) * ldd + k, w);
    }
}
DEV int rope_perm64(int i) { return i < 32 ? 2 * i : 2 * (i - 32) + 1; }

DEV void rms_row_to_bf16(const float* src, const float* g, bf16_t* dst, int lane) {
    f32x4 v[8]; float s = 0.f;
#pragma unroll
    for (int i = 0; i < 8; ++i) { v[i] = *(const f32x4*)(src + i * 256 + lane * 4); s += v[i][0] * v[i][0] + v[i][1] * v[i][1] + v[i][2] * v[i][2] + v[i][3] * v[i][3]; }
    s = wave_sum(s);
    const float rs = __builtin_amdgcn_rsqf(s * (1.0f / 2048.0f) + EPS);
#pragma unroll
    for (int i = 0; i < 8; ++i) {
        const f32x4 gg = *(const f32x4*)(g + i * 256 + lane * 4);
        u32x2 w; w.x = cvt_pk_bf16(v[i][0] * rs * gg[0], v[i][1] * rs * gg[1]); w.y = cvt_pk_bf16(v[i][2] * rs * gg[2], v[i][3] * rs * gg[3]);
        st8(dst + i * 256 + lane * 4, w);
    }
}

DEV void phase0(const P& p) {
    const int lane = tidf() & 63, gw = blockIdx.x * 4 + (tidf() >> 6), NGW = gridDim.x * 4;
    unsigned char* ws = p.ws;
    constexpr int I_IN = 32 * 122, I_QB = 8 * 48, I_KVB = 4 * 64, I_OUT = 32 * 64, I_MQ = 32 * 16, I_MKV = 32 * 32, I_MO = 8 * 64;
    constexpr int NITEMS = I_IN + I_QB + I_KVB + I_OUT + I_MQ + I_MKV + I_MO;
    for (int it = gw; it < NITEMS; it += NGW) {
        int r = it;
        if (r < I_IN) { const int kt = r / 122, nt = r % 122;
            transpose_item(p.w_in, 3904, (bf16_t*)(ws + WS_WIN), D, kt * 64, nt * 32, lane, [](int) { return 1.0f; },
                [](int n) { return n < 768 ? n : (n < 832 ? 3840 + rope_perm64(n - 768) : n - 64); }); continue; }
        r -= I_IN;
        if (r < I_QB) { const int kt = r / 48, nt = r % 48; const float* g = p.norm_q_lat;
            transpose_item(p.w_q_b, 1536, (bf16_t*)(ws + WS_WQB), 512, kt * 64, nt * 32, lane, [g](int k) { return g[k]; },
                [](int n) { const int h = n / 192, d = n % 192; return h * 192 + (d < 128 ? d : 128 + rope_perm64(d - 128)); }); continue; }
        r -= I_QB;
        if (r < I_KVB) { const int kt = r / 64, nt = r % 64; const float* g = p.norm_kv_lat;
            transpose_item(p.w_kv_b, 2048, (bf16_t*)(ws + WS_WKVB), 256, kt * 64, nt * 32, lane, [g](int k) { return g[k]; }, [](int n) { return n; }); continue; }
        r -= I_KVB;
        if (r < I_OUT) { const int kt = r / 64, nt = r % 64; const float* g1 = p.norm_mla_out; const float* g2 = p.norm_sb_out;
            transpose_item(p.w_out, 2048, (bf16_t*)(ws + WS_WOUT), 2048, kt * 64, nt * 32, lane, [g1, g2](int k) { return k < 1024 ? g1[k] : g2[k - 1024]; }, [](int n) { return n; }); continue; }
        r -= I_OUT;
        if (r < I_MQ) { const int kt = r / 16, nt = r % 16; const float* g = p.norm_mem_x;
            transpose_item(p.w_mem_q, 512, (bf16_t*)(ws + WS_WMQ), 2048, kt * 64, nt * 32, lane, [g](int k) { return g[k]; }, [](int n) { return n; }); continue; }
        r -= I_MQ;
        if (r < I_MKV) { const int kt = r / 32, nt = r % 32;
            transpose_item(p.w_mem_kv, 1024, (bf16_t*)(ws + WS_WMKV), 2048, kt * 64, nt * 32, lane, [](int) { return 1.0f; }, [](int n) { return n; }); continue; }
        r -= I_MKV;
        { const int kt = r / 64, nt = r % 64;
            transpose_item(p.w_mem_o, 2048, (bf16_t*)(ws + WS_WMO), 512, kt * 64, nt * 32, lane, [](int) { return 1.0f; }, [](int n) { return n; }); }
    }
    {
        float* wr = (float*)(ws + WS_WR);
        for (int i = blockIdx.x * NTHREADS + tidf(); i < 48 * 2048; i += gridDim.x * NTHREADS) {
            const int n = i >> 11, k = i & 2047;
            float v = 0.f;
            if (n < 4) v = p.w_group[k * 4 + n] * p.norm_ffn[k]; else if (n < 36) v = p.w_er[k * 32 + (n - 4)] * p.norm_ffn[k];
            wr[i] = v;
        }
    }
    {
        float* rt = (float*)(ws + WS_ROPE);
        for (int i = blockIdx.x * NTHREADS + tidf(); i < T * 32; i += gridDim.x * NTHREADS) {
            const int t = i >> 5, f = i & 31;
            const float inv_freq = exp2f(-(float)f * (13.287712379549449f / 32.0f));
            const float ang = (float)p.pos[t] * inv_freq;
            const double turns = (double)ang * 0.15915494309189535;
            const float fr = (float)(turns - floor(turns));
            rt[2 * i] = __builtin_amdgcn_cosf(fr); rt[2 * i + 1] = __builtin_amdgcn_sinf(fr);
        }
    }
    for (int row = gw; row < T + MT; row += NGW) {
        if (row < T) rms_row_to_bf16(p.x + (size_t)row * D, p.norm_mix, (bf16_t*)(ws + WS_H) + (size_t)row * D, lane);
        else rms_row_to_bf16(p.mem + (size_t)(row - T) * D, p.norm_mem_src, (bf16_t*)(ws + WS_MEMN) + (size_t)(row - T) * D, lane);
    }
}

DEV void store_rowmajor_sq(const f32x4 (&acc)[4][4], bf16_t* dst, int ldd, int m0, int ncol0, u64* sq, float scale) {
    const int lane = tidf() & 63, wid = tidf() >> 6, wr = wid >> 1, wc = wid & 1, fr = lane & 15, fq = lane >> 4;
#pragma unroll
    for (int j = 0; j < 4; ++j) {
        const int m = m0 + wr * 64 + j * 16 + fr; float ss = 0.f;
#pragma unroll
        for (int i = 0; i < 4; ++i) {
            const f32x4 v = acc[i][j];
            ss += v[0] * v[0] + v[1] * v[1] + v[2] * v[2] + v[3] * v[3];
            u32x2 w; w.x = cvt_pk_bf16(v[0] * scale, v[1] * scale); w.y = cvt_pk_bf16(v[2] * scale, v[3] * scale);
            st8(dst + (size_t)m * ldd + ncol0 + wc * 64 + i * 16 + fq * 4, w);
        }
        if (sq) { ss += __shfl_xor(ss, 16); ss += __shfl_xor(ss, 32); if (fq == 0) sq_add(sq, m, ss); }
    }
}
DEV void store_transposed(const f32x4 (&acc)[4][4], bf16_t* dst, int L, int s0, const float* rs  ) {
    const int lane = tidf() & 63, wid = tidf() >> 6, wr = wid >> 1, wc = wid & 1, fr = lane & 15, fq = lane >> 4;
#pragma unroll
    for (int i = 0; i < 4; ++i) {
        const int ml = wr * 64 + i * 16 + fq * 4;
        float r0 = 1.f, r1 = 1.f, r2 = 1.f, r3 = 1.f;
        if (rs) { r0 = rs[ml]; r1 = rs[ml + 1]; r2 = rs[ml + 2]; r3 = rs[ml + 3]; }
        const int pos = vperm4(s0 + ml);
#pragma unroll
        for (int j = 0; j < 4; ++j) {
            const int n = wc * 64 + j * 16 + fr; const f32x4 v = acc[i][j];
            u32x2 w; w.x = cvt_pk_bf16(v[0] * r0, v[1] * r1); w.y = cvt_pk_bf16(v[2] * r2, v[3] * r3);
            st8(dst + (size_t)n * L + pos, w);
        }
    }
}

DEV void phase1(const P& p, unsigned char* lds, bool dry = false) {
    unsigned char* ws = p.ws;
    const XcdIter xi = xcd_iter();
    const int lane = tidf() & 63, wid = tidf() >> 6, wr = wid >> 1, wc = wid & 1, fr = lane & 15, fq = lane >> 4;
    u64* sqb = (u64*)(ws + CTL_SQ);
    u64* sq_cq = dry ? nullptr : sqb + SQ_CQ * T; u64* sq_ckv = dry ? nullptr : sqb + SQ_CKV * T;
    const int per_x = 8 * 31 + 4, total = 64 * 31 + 32;
    for (int it = 0;; ++it) {
        int mt, nt; bool memkv = false;
        if (xi.x >= 0) { const int i = it * xi.per + xi.j; if (i >= per_x) break;
            if (i < 248) { mt = xi.x * 8 + (i & 7); nt = i >> 3; } else { memkv = true; const int q = xi.x * 4 + (i - 248); mt = q & 3; nt = q >> 2; } }
        else { const int i = it * xi.per + xi.j; if (i >= total) break;
            if (i < 1984) { mt = i & 63; nt = i >> 6; } else { memkv = true; const int q = i - 1984; mt = q & 3; nt = q >> 2; } }
        f32x4 acc[4][4]; acc_zero(acc);
        if (memkv) {
            const bool isv = nt >= 4;
            gemm_dense(acc, lds, (const bf16_t*)(ws + WS_MEMN), D, mt * 128, (const bf16_t*)(ws + WS_WMKV), D, nt * 128, 0, 32, !isv);
            const int b = mt >> 1, mm0 = (mt & 1) * 128;
            if (!isv) store_rowmajor_sq(acc, (bf16_t*)(ws + WS_KMEM) + (size_t)((b * 4 + nt) * 256) * 128, 128, mm0, 0, nullptr, 1.0f);
            else store_transposed(acc, (bf16_t*)(ws + WS_VMEMT) + (size_t)((b * 4 + (nt - 4)) * 128) * 256, 256, mm0, nullptr);
            continue;
        }
        const bool isv = (nt >= 22 && nt < 30);
        gemm_dense(acc, lds, (const bf16_t*)(ws + WS_H), D, mt * 128, (const bf16_t*)(ws + WS_WIN), D, nt * 128, 0, 32, !isv);
        const int m0 = mt * 128, b = m0 >> 12, s0 = m0 & 4095;
        if (nt < 4) store_rowmajor_sq(acc, (bf16_t*)(ws + WS_CQ), 512, m0, nt * 128, sq_cq, 1.0f);
        else if (nt < 6) store_rowmajor_sq(acc, (bf16_t*)(ws + WS_CKV), 256, m0, (nt - 4) * 128, sq_ckv, 1.0f);
        else if (nt < 14) store_rowmajor_sq(acc, (bf16_t*)(ws + WS_QSB) + (size_t)((b * 8 + (nt - 6)) * S) * 128, 128, s0, 0, nullptr, 0.08838834764831845f * LOG2E);
        else if (nt < 22) store_rowmajor_sq(acc, (bf16_t*)(ws + WS_KSB) + (size_t)((b * 8 + (nt - 14)) * S) * 128, 128, s0, 0, nullptr, 1.0f);
        else if (nt < 30) store_transposed(acc, (bf16_t*)(ws + WS_VSBT) + (size_t)((b * 8 + (nt - 22)) * 128) * S, S, s0, nullptr);
        else if (wc == 0) {
            const float* rt = (const float*)(ws + WS_ROPE);
            bf16_t* kpe = (bf16_t*)(ws + WS_KPE);
#pragma unroll
            for (int j = 0; j < 4; ++j) {
                const int m = m0 + wr * 64 + j * 16 + fr;
#pragma unroll
                for (int i = 0; i < 4; ++i) {
                    const int n = i * 16 + fq * 4; const f32x4 v = acc[i][j];
                    const f32x4 cs = *(const f32x4*)(rt + ((size_t)m * 32 + (n >> 1)) * 2);
                    u32x2 w; w.x = cvt_pk_bf16(v[0] * cs[0] - v[1] * cs[1], v[1] * cs[0] + v[0] * cs[1]);
                    w.y = cvt_pk_bf16(v[2] * cs[2] - v[3] * cs[3], v[3] * cs[2] + v[2] * cs[3]);
                    st8(kpe + (size_t)m * 64 + n, w);
                }
            }
        }
    }
}

DEV void phase2(const P& p, unsigned char* lds) {
    unsigned char* ws = p.ws;
    const XcdIter xi = xcd_iter();
    const int lane = tidf() & 63, wid = tidf() >> 6, wr = wid >> 1, wc = wid & 1, fr = lane & 15, fq = lane >> 4;
    const u64* sqb = (const u64*)(ws + CTL_SQ);
    const int per_x = 8 * 28, total = 64 * 28;
    for (int it = 0;; ++it) {
        int mt, nt;
        if (xi.x >= 0) { const int i = it * xi.per + xi.j; if (i >= per_x) break; mt = xi.x * 8 + (i & 7); nt = i >> 3; }
        else { const int i = it * xi.per + xi.j; if (i >= total) break; mt = i & 63; nt = i >> 6; }
        const int m0 = mt * 128, b = m0 >> 12, s0 = m0 & 4095;
        f32x4 acc[4][4]; acc_zero(acc);
        if (nt < 12) {
            gemm_dense(acc, lds, (const bf16_t*)(ws + WS_CQ), 512, m0, (const bf16_t*)(ws + WS_WQB), 512, nt * 128, 0, 8, true);
            const float* rt = (const float*)(ws + WS_ROPE);
            bf16_t* qm = (bf16_t*)(ws + WS_QM);
            const float qs = 0.07216878364870322f * LOG2E;
#pragma unroll
            for (int j = 0; j < 4; ++j) {
                const int m = m0 + wr * 64 + j * 16 + fr, s = s0 + wr * 64 + j * 16 + fr;
                const float rs = sq_rs(sqb + SQ_CQ * T, m, 1.0f / 512.0f) * qs;
#pragma unroll
                for (int i = 0; i < 4; ++i) {
                    const int n = nt * 128 + wc * 64 + i * 16 + fq * 4, h = n / 192, d = n - h * 192;
                    f32x4 v = acc[i][j] * rs;
                    if (d >= 128) {
                        const f32x4 cs = *(const f32x4*)(rt + ((size_t)m * 32 + ((d - 128) >> 1)) * 2);
                        v = (f32x4){v[0] * cs[0] - v[1] * cs[1], v[1] * cs[0] + v[0] * cs[1], v[2] * cs[2] - v[3] * cs[3], v[3] * cs[2] + v[2] * cs[3]};
                    }
                    u32x2 w; w.x = cvt_pk_bf16(v[0], v[1]); w.y = cvt_pk_bf16(v[2], v[3]);
                    st8(qm + ((size_t)(b * 8 + h) * S + s) * 192 + d, w);
                }
            }
        } else {
            const int nk = nt - 12, h = nk >> 1; const bool isv = nk & 1;
            gemm_dense(acc, lds, (const bf16_t*)(ws + WS_CKV), 256, m0, (const bf16_t*)(ws + WS_WKVB), 256, nk * 128, 0, 4, !isv);
            if (!isv) {
                bf16_t* kn = (bf16_t*)(ws + WS_KN) + (size_t)((b * 8 + h) * S) * 128;
#pragma unroll
                for (int j = 0; j < 4; ++j) {
                    const int ml = wr * 64 + j * 16 + fr;
                    const float rs = sq_rs(sqb + SQ_CKV * T, m0 + ml, 1.0f / 256.0f);
#pragma unroll
                    for (int i = 0; i < 4; ++i) {
                        const f32x4 v = acc[i][j] * rs;
                        u32x2 w; w.x = cvt_pk_bf16(v[0], v[1]); w.y = cvt_pk_bf16(v[2], v[3]);
                        st8(kn + (size_t)(s0 + ml) * 128 + wc * 64 + i * 16 + fq * 4, w);
                    }
                }
            } else {
                bf16_t* vt = (bf16_t*)(ws + WS_VMT) + (size_t)((b * 8 + h) * 128) * S;
#pragma unroll
                for (int i = 0; i < 4; ++i) {
                    const int ml = wr * 64 + i * 16 + fq * 4;
                    const float r0 = sq_rs(sqb + SQ_CKV * T, m0 + ml, 1.0f / 256.0f), r1 = sq_rs(sqb + SQ_CKV * T, m0 + ml + 1, 1.0f / 256.0f);
                    const float r2 = sq_rs(sqb + SQ_CKV * T, m0 + ml + 2, 1.0f / 256.0f), r3 = sq_rs(sqb + SQ_CKV * T, m0 + ml + 3, 1.0f / 256.0f);
                    const int pos = vperm4(s0 + ml);
#pragma unroll
                    for (int j = 0; j < 4; ++j) {
                        const int n = wc * 64 + j * 16 + fr; const f32x4 v = acc[i][j];
                        u32x2 w; w.x = cvt_pk_bf16(v[0] * r0, v[1] * r1); w.y = cvt_pk_bf16(v[2] * r2, v[3] * r3);
                        st8(vt + (size_t)n * S + pos, w);
                    }
                }
            }
        }
    }
}

template <int DQK> struct KStage {
    static constexpr int NIG = DQK / 64;
    u32x4 r[2][NIG];
    const bf16_t* gm; const bf16_t* gp; int l0, l1;
    DEV void init(const bf16_t* Kmain, const bf16_t* Kpe, int t) {
        const int row = t >> 3, c = t & 7;
        gm = Kmain + (size_t)row * 128 + c * 8; gp = (DQK == 192) ? Kpe + (size_t)row * 64 + c * 8 : nullptr;
        if (DQK == 128) { const int lo = row * 256 + ((c ^ (row & 7)) << 4), b3 = (row >> 3) & 1; l0 = lo + (b3 ? 128 : 0); l1 = lo + (b3 ? 0 : 128); }
        else { l0 = row * 384 + ((c ^ ((row >> 1) & 7)) << 4); l1 = l0 + 128; }
    }
    DEV void load(int tile) {
#pragma unroll
        for (int ps = 0; ps < 2; ++ps) {
            const bf16_t* g = gm + ((size_t)tile * 64 + ps * 32) * 128;
            r[ps][0] = *(const u32x4*)g; r[ps][1] = *(const u32x4*)(g + 64);
            if (DQK == 192) r[ps][NIG - 1] = *(const u32x4*)(gp + ((size_t)tile * 64 + ps * 32) * 64);
        }
    }
    DEV void write(unsigned char* ldsK) {
#pragma unroll
        for (int ps = 0; ps < 2; ++ps) {
            *(u32x4*)(ldsK + l0 + ps * 32 * DQK * 2) = r[ps][0]; *(u32x4*)(ldsK + l1 + ps * 32 * DQK * 2) = r[ps][1];
            if (DQK == 192) *(u32x4*)(ldsK + l0 + 256 + ps * 32 * DQK * 2) = r[ps][NIG - 1];
        }
    }
};
struct VStage {
    u32x4 r[4]; const bf16_t* g; int l; size_t rstride;
    DEV void init(const bf16_t* VT, int LV, int t) { const int row = t >> 3, c = t & 7; g = VT + (size_t)row * LV + c * 8; rstride = (size_t)32 * LV; l = row * 128 + ((c ^ ((row >> 1) & 7)) << 4); }
    DEV void load(int tile) {
#pragma unroll
        for (int i = 0; i < 4; ++i) r[i] = *(const u32x4*)(g + i * rstride + (size_t)tile * 64);
    }
    DEV void write(unsigned char* ldsV) {
#pragma unroll
        for (int i = 0; i < 4; ++i) *(u32x4*)(ldsV + l + i * 4096) = r[i];
    }
};
template <int DQK> DEV int kfrag_off(int krow, int ks, int hh) {
    const int c = 2 * ks + hh;
    if (DQK == 128) return krow * 256 + ((c ^ (krow & 15)) << 4);
    else return krow * 384 + ((((c & ~7) | ((c & 7) ^ ((krow >> 1) & 7)))) << 4);
}
DEV int vfrag_off(int r, int c) { return r * 128 + ((c ^ ((r >> 1) & 7)) << 4); }

template <int DQK, bool CAUSAL>
DEV void attn_unit(unsigned char* lds, const bf16_t* Q, const bf16_t* Kmain, const bf16_t* Kpe, const bf16_t* VT, int LV, int q0, int ntiles,
                   bf16_t* O, int ldo, u64* sq  , int orow0) {
    constexpr int NKS = DQK / 16, KTILE_BYTES = 64 * DQK * 2;
    const int tid = tidf();
    const int lane = tid & 63, wid = tid >> 6, pr = wid >> 1, kh = wid & 1, l31 = lane & 31, hh = lane >> 5;
    unsigned char* ldsK = lds; unsigned char* ldsV = lds + KTILE_BYTES;
    bf16x8 qf[NKS];
    { const bf16_t* qp = Q + (size_t)(q0 + pr * 32 + l31) * DQK + hh * 8;
#pragma unroll
      for (int ks = 0; ks < NKS; ++ks) qf[ks] = *(const bf16x8*)(qp + ks * 16); }
    f32x16 oacc[4];
#pragma unroll
    for (int i = 0; i < 4; ++i)
#pragma unroll
        for (int r = 0; r < 16; ++r) oacc[i][r] = 0.f;
    float mrun = -1e30f, lrun = 0.f;
    KStage<DQK> ksg; VStage vsg;
    ksg.init(Kmain, Kpe, tid); vsg.init(VT, LV, tid);
    const int krow = kh * 32 + l31;
    int ka[DQK == 128 ? 8 : 4];
#pragma unroll
    for (int i = 0; i < (DQK == 128 ? 8 : 4); ++i) ka[i] = kfrag_off<DQK>(krow, i, hh);
    const int va0 = vfrag_off(l31, kh * 4 + hh), va1 = vfrag_off(l31, kh * 4 + 2 + hh);
    ksg.load(0); vsg.load(0); ksg.write(ldsK); vsg.write(ldsV); __syncthreads();
    const int qpos = q0 + pr * 32 + l31;
    for (int t = 0; t < ntiles; ++t) {
        const bool more = t + 1 < ntiles;
        if (more) { ksg.load(t + 1); vsg.load(t + 1); }
        __builtin_amdgcn_sched_barrier(0);
        const bool diag = CAUSAL && (t == ntiles - 1);
        if (!(diag && pr == 0 && kh == 1)) {
            f32x16 sacc;
#pragma unroll
            for (int r = 0; r < 16; ++r) sacc[r] = 0.f;
#pragma unroll
            for (int ks = 0; ks < NKS; ++ks) {
                const int off = (DQK == 128) ? ka[ks] : (ka[ks & 3] + 128 * (ks >> 2));
                const bf16x8 kf = *(const bf16x8*)(ldsK + off);
                sacc = __builtin_amdgcn_mfma_f32_32x32x16_bf16(kf, qf[ks], sacc, 0, 0, 0);
            }
            if (diag) {
                const int kbase = t * 64 + kh * 32 + 4 * hh;
#pragma unroll
                for (int r = 0; r < 16; ++r) { const int kp = kbase + (r & 3) + 8 * (r >> 2); if (kp > qpos) sacc[r] = -1e30f; }
            }
            float mx = sacc[0];
#pragma unroll
            for (int r = 1; r < 16; ++r) mx = fmaxf(mx, sacc[r]);
            mx = fmaxf(mx, __shfl_xor(mx, 32));
            const float mnew = fmaxf(mrun, mx), alpha = fexp2(mrun - mnew);
            mrun = mnew;
            float ps = 0.f;
#pragma unroll
            for (int r = 0; r < 16; ++r) { sacc[r] = fexp2(sacc[r] - mnew); ps += sacc[r]; }
            lrun = lrun * alpha + ps;
#pragma unroll
            for (int i = 0; i < 4; ++i)
#pragma unroll
                for (int r = 0; r < 16; ++r) oacc[i][r] *= alpha;
#pragma unroll
            for (int s2 = 0; s2 < 2; ++s2) {
                u32x4 pw; pw.x = cvt_pk_bf16(sacc[8 * s2 + 0], sacc[8 * s2 + 1]); pw.y = cvt_pk_bf16(sacc[8 * s2 + 2], sacc[8 * s2 + 3]);
                pw.z = cvt_pk_bf16(sacc[8 * s2 + 4], sacc[8 * s2 + 5]); pw.w = cvt_pk_bf16(sacc[8 * s2 + 6], sacc[8 * s2 + 7]);
                bf16x8 pf; __builtin_memcpy(&pf, &pw, 16);
#pragma unroll
                for (int dvb = 0; dvb < 4; ++dvb) {
                    const bf16x8 vf = *(const bf16x8*)(ldsV + (s2 ? va1 : va0) + dvb * 4096);
                    oacc[dvb] = __builtin_amdgcn_mfma_f32_32x32x16_bf16(vf, pf, oacc[dvb], 0, 0, 0);
                }
            }
        }
        __syncthreads();
        if (more) { ksg.write(ldsK); vsg.write(ldsV); }
        __syncthreads();
    }
    float lw = lrun + __shfl_xor(lrun, 32);
    float* xo = (float*)(lds + pr * 20480);
    if (kh == 1) {
#pragma unroll
        for (int i = 0; i < 4; ++i)
#pragma unroll
            for (int r = 0; r < 16; ++r) xo[(i * 16 + r) * 64 + lane] = oacc[i][r];
        xo[4096 + lane] = mrun; xo[4096 + 64 + lane] = lw;
    }
    __syncthreads();
    if (kh == 0) {
        const float m1 = xo[4096 + lane], l1 = xo[4096 + 64 + lane];
        const float m = fmaxf(mrun, m1), f0 = fexp2(mrun - m), f1 = fexp2(m1 - m);
        const float inv = 1.0f / (lw * f0 + l1 * f1);
        const float c0 = f0 * inv, c1 = f1 * inv;
        float ss = 0.f;
        bf16_t* op = O + (size_t)(orow0 + pr * 32 + l31) * ldo;
#pragma unroll
        for (int i = 0; i < 4; ++i)
#pragma unroll
            for (int rq = 0; rq < 4; ++rq) {
                float v[4];
#pragma unroll
                for (int e = 0; e < 4; ++e) { const int r = rq * 4 + e; v[e] = oacc[i][r] * c0 + xo[(i * 16 + r) * 64 + lane] * c1; ss += v[e] * v[e]; }
                u32x2 w; w.x = cvt_pk_bf16(v[0], v[1]); w.y = cvt_pk_bf16(v[2], v[3]);
                st8(op + i * 32 + 8 * rq + 4 * hh, w);
            }
        if (sq) { ss += __shfl_xor(ss, 32); if (hh == 0) sq_add(sq, orow0 + pr * 32 + l31, ss); }
    }
    __syncthreads();
}

DEV void sb_unit(unsigned char* lds, const bf16_t* Q, const bf16_t* K, const bf16_t* VT, int U, bf16_t* O  , u64* sq, int tok0) {
    constexpr int KTILE_BYTES = 64 * 128 * 2;
    const int tid = tidf();
    const int lane = tid & 63, wid = tid >> 6, l31 = lane & 31, hh = lane >> 5;
    unsigned char* ldsK = lds; unsigned char* ldsV = lds + KTILE_BYTES;
    volatile int* flags = (volatile int*)(lds + LDS_MAIN + 64);
    const int q0 = U * 128 + wid * 32, qpos = q0 + l31;
    bf16x8 qf[8];
    { const bf16_t* qp = Q + (size_t)qpos * 128 + hh * 8;
#pragma unroll
      for (int ks = 0; ks < 8; ++ks) qf[ks] = *(const bf16x8*)(qp + ks * 16); }
    f32x16 oacc[4];
#pragma unroll
    for (int i = 0; i < 4; ++i)
#pragma unroll
        for (int r = 0; r < 16; ++r) oacc[i][r] = 0.f;
    float R = 0.f;
    KStage<128> ksg; VStage vsg;
    ksg.init(K, nullptr, tid); vsg.init(VT, S, tid);
    int ka[8];
#pragma unroll
    for (int i = 0; i < 8; ++i) ka[i] = kfrag_off<128>(l31, i, hh);
    const int va[4] = {vfrag_off(l31, hh), vfrag_off(l31, 2 + hh), vfrag_off(l31, 4 + hh), vfrag_off(l31, 6 + hh)};
    int t = 2 * U + 1;
    ksg.load(t); vsg.load(t); ksg.write(ldsK); vsg.write(ldsV); __syncthreads();
    for (; t >= 0; --t) {
        const bool more = t > 0;
        if (more) { ksg.load(t - 1); vsg.load(t - 1); }
        __builtin_amdgcn_sched_barrier(0);
        const int kt0 = t * 64;
        if (kt0 < q0 + 31) {
            const bool need_mask = (kt0 + 63 >= q0);
#pragma unroll
            for (int kb = 1; kb >= 0; --kb) {
                f32x16 z;
#pragma unroll
                for (int r = 0; r < 16; ++r) z[r] = 0.f;
#pragma unroll
                for (int ks = 0; ks < 8; ++ks) {
                    const bf16x8 kf = *(const bf16x8*)(ldsK + ka[ks] + kb * 8192);
                    z = __builtin_amdgcn_mfma_f32_32x32x16_bf16(kf, qf[ks], z, 0, 0, 0);
                }
                float l1m[16];
#pragma unroll
                for (int r = 0; r < 16; ++r) {
                    const float zz = z[r];
                    const float sp = fmaxf(zz, 0.f) + flog2(1.0f + fexp2(-fabsf(zz)));
                    const int kp = kt0 + kb * 32 + (r & 3) + 8 * (r >> 2) + 4 * hh;
                    const bool ok = !need_mask || (kp < qpos);
                    l1m[r] = ok ? -sp : 0.f;
                    z[r] = ok ? zz : -1e30f;
                }
                float gs[4], pgs[4];
#pragma unroll
                for (int g = 0; g < 4; ++g) { gs[g] = (l1m[4 * g] + l1m[4 * g + 1]) + (l1m[4 * g + 2] + l1m[4 * g + 3]); pgs[g] = __shfl_xor(gs[g], 32); }
                float tail = 0.f;
#pragma unroll
                for (int g = 3; g >= 0; --g) {
                    const float sg = R + tail + (hh == 0 ? pgs[g] : 0.f);
                    const float e2 = l1m[4 * g + 3], e1 = e2 + l1m[4 * g + 2], e0 = e1 + l1m[4 * g + 1];
                    z[4 * g + 3] = fexp2(z[4 * g + 3] + l1m[4 * g + 3] + sg);
                    z[4 * g + 2] = fexp2(z[4 * g + 2] + l1m[4 * g + 2] + sg + e2);
                    z[4 * g + 1] = fexp2(z[4 * g + 1] + l1m[4 * g + 1] + sg + e1);
                    z[4 * g + 0] = fexp2(z[4 * g + 0] + l1m[4 * g + 0] + sg + e0);
                    tail += gs[g] + pgs[g];
                }
                R += tail;
#pragma unroll
                for (int s2 = 0; s2 < 2; ++s2) {
                    u32x4 pw; pw.x = cvt_pk_bf16(z[8 * s2 + 0], z[8 * s2 + 1]); pw.y = cvt_pk_bf16(z[8 * s2 + 2], z[8 * s2 + 3]);
                    pw.z = cvt_pk_bf16(z[8 * s2 + 4], z[8 * s2 + 5]); pw.w = cvt_pk_bf16(z[8 * s2 + 6], z[8 * s2 + 7]);
                    bf16x8 pf; __builtin_memcpy(&pf, &pw, 16);
#pragma unroll
                    for (int dvb = 0; dvb < 4; ++dvb) {
                        const bf16x8 vf = *(const bf16x8*)(ldsV + va[kb * 2 + s2] + dvb * 4096);
                        oacc[dvb] = __builtin_amdgcn_mfma_f32_32x32x16_bf16(vf, pf, oacc[dvb], 0, 0, 0);
                    }
                }
            }
        }
        const bool wdone = __all(R < -160.0f);
        if (lane == 0) flags[wid] = wdone ? 1 : 0;
        __syncthreads();
        const bool alldone = (flags[0] & flags[1] & flags[2] & flags[3]) != 0;
        if (alldone || !more) break;
        ksg.write(ldsK); vsg.write(ldsV);
        __syncthreads();
    }
    __syncthreads();
    float ss = 0.f;
    bf16_t* op = O + (size_t)qpos * 2048;
#pragma unroll
    for (int i = 0; i < 4; ++i)
#pragma unroll
        for (int rq = 0; rq < 4; ++rq) {
            const float v0 = oacc[i][rq * 4], v1 = oacc[i][rq * 4 + 1], v2 = oacc[i][rq * 4 + 2], v3 = oacc[i][rq * 4 + 3];
            ss += v0 * v0 + v1 * v1 + v2 * v2 + v3 * v3;
            u32x2 w; w.x = cvt_pk_bf16(v0, v1); w.y = cvt_pk_bf16(v2, v3);
            st8(op + i * 32 + 8 * rq + 4 * hh, w);
        }
    ss += __shfl_xor(ss, 32); if (sq && hh == 0) sq_add(sq, tok0 + qpos, ss);
}

DEV void phase3(const P& p, unsigned char* lds, bool dry = false) {
    unsigned char* ws = p.ws;
    u64* sqb = (u64*)(ws + CTL_SQ);
    bf16_t* omix = (bf16_t*)(ws + WS_OMIX);
    const int G = gridDim.x;
    for (int w = blockIdx.x; w < 512; w += G) {
        const int bh = w >> 5, uu = w & 31, b = bh >> 3, h = bh & 7;
#pragma unroll 1
        for (int half = 0; half < 2; ++half) {
            const int u = half ? (63 - uu) : uu;
            attn_unit<192, true>(lds, (const bf16_t*)(ws + WS_QM) + (size_t)bh * S * 192, (const bf16_t*)(ws + WS_KN) + (size_t)bh * S * 128,
                                 (const bf16_t*)(ws + WS_KPE) + (size_t)b * S * 64, (const bf16_t*)(ws + WS_VMT) + (size_t)bh * 128 * S, S, u * 64, u + 1,
                                 omix + (size_t)b * S * 2048 + h * 128, 2048, dry ? nullptr : sqb + SQ_OMLA * T + b * S, u * 64);
        }
    }
    for (int w = blockIdx.x; w < 512; w += G) {
        const int bh = w >> 5, U = w & 31, b = bh >> 3, h = bh & 7;
        sb_unit(lds, (const bf16_t*)(ws + WS_QSB) + (size_t)bh * S * 128, (const bf16_t*)(ws + WS_KSB) + (size_t)bh * S * 128,
                (const bf16_t*)(ws + WS_VSBT) + (size_t)bh * 128 * S, U, omix + (size_t)b * S * 2048 + 1024 + h * 128, dry ? nullptr : sqb + SQ_OSB * T, b * S);
    }
}

DEV void phase4(const P& p, unsigned char* lds, bool dry = false) {
    unsigned char* ws = p.ws;
    const XcdIter xi = xcd_iter();
    const int lane = tidf() & 63, wid = tidf() >> 6, wr = wid >> 1, wc = wid & 1, fr = lane & 15, fq = lane >> 4;
    u64* sqb = (u64*)(ws + CTL_SQ);
    float* x1 = (float*)(ws + WS_X1); bf16_t* x1b = (bf16_t*)(ws + WS_X1B);
    const int per_x = 8 * 16, total = 64 * 16;
    for (int it = 0;; ++it) {
        int mt, nt;
        if (xi.x >= 0) { const int i = it * xi.per + xi.j; if (i >= per_x) break; mt = xi.x * 8 + (i & 7); nt = i >> 3; }
        else { const int i = it * xi.per + xi.j; if (i >= total) break; mt = i & 63; nt = i >> 6; }
        const int m0 = mt * 128;
        f32x4 acc[4][4]; acc_zero(acc);
        gemm_dense(acc, lds, (const bf16_t*)(ws + WS_OMIX), D, m0, (const bf16_t*)(ws + WS_WOUT), D, nt * 128, 0, 16, true);
        float rsb[4];
#pragma unroll
        for (int j = 0; j < 4; ++j) {
            const int m = m0 + wr * 64 + j * 16 + fr;
            const float ra = sq_rs(sqb + SQ_OMLA * T, m, 1.0f / 1024.0f); rsb[j] = sq_rs(sqb + SQ_OSB * T, m, 1.0f / 1024.0f);
            const float ratio = ra / rsb[j];
#pragma unroll
            for (int i = 0; i < 4; ++i) acc[i][j] *= ratio;
        }
        gemm_dense(acc, lds, (const bf16_t*)(ws + WS_OMIX), D, m0, (const bf16_t*)(ws + WS_WOUT), D, nt * 128, 1024, 16, true);
#pragma unroll
        for (int j = 0; j < 4; ++j) {
            const int m = m0 + wr * 64 + j * 16 + fr; float ss = 0.f;
#pragma unroll
            for (int i = 0; i < 4; ++i) {
                const int n = nt * 128 + wc * 64 + i * 16 + fq * 4;
                const f32x4 xv = *(const f32x4*)(p.x + (size_t)m * D + n);
                const f32x4 v = xv + acc[i][j] * rsb[j];
                ss += v[0] * v[0] + v[1] * v[1] + v[2] * v[2] + v[3] * v[3];
                st16f(x1 + (size_t)m * D + n, v);
                u32x2 w; w.x = cvt_pk_bf16(v[0], v[1]); w.y = cvt_pk_bf16(v[2], v[3]);
                st8(x1b + (size_t)m * D + n, w);
            }
            ss += __shfl_xor(ss, 16); ss += __shfl_xor(ss, 32); if (fq == 0 && !dry) sq_add(sqb + SQ_X1 * T, m, ss);
        }
    }
}

DEV void phase5(const P& p, unsigned char* lds) {
    unsigned char* ws = p.ws;
    const XcdIter xi = xcd_iter();
    const int lane = tidf() & 63, wid = tidf() >> 6, wr = wid >> 1, wc = wid & 1, fr = lane & 15, fq = lane >> 4;
    const u64* sqb = (const u64*)(ws + CTL_SQ);
    const int per_x = 8 * 4, total = 64 * 4;
    for (int it = 0;; ++it) {
        int mt, nt;
        if (xi.x >= 0) { const int i = it * xi.per + xi.j; if (i >= per_x) break; mt = xi.x * 8 + (i & 7); nt = i >> 3; }
        else { const int i = it * xi.per + xi.j; if (i >= total) break; mt = i & 63; nt = i >> 6; }
        const int m0 = mt * 128, b = m0 >> 12, s0 = m0 & 4095;
        f32x4 acc[4][4]; acc_zero(acc);
        gemm_dense(acc, lds, (const bf16_t*)(ws + WS_X1B), D, m0, (const bf16_t*)(ws + WS_WMQ), D, nt * 128, 0, 32, true);
        bf16_t* qm = (bf16_t*)(ws + WS_QMEM) + (size_t)((b * 4 + nt) * S) * 128;
#pragma unroll
        for (int j = 0; j < 4; ++j) {
            const int ml = wr * 64 + j * 16 + fr;
            const float rs = sq_rs(sqb + SQ_X1 * T, m0 + ml, 1.0f / 2048.0f) * (0.08838834764831845f * LOG2E);
#pragma unroll
            for (int i = 0; i < 4; ++i) {
                const f32x4 v = acc[i][j] * rs;
                u32x2 w; w.x = cvt_pk_bf16(v[0], v[1]); w.y = cvt_pk_bf16(v[2], v[3]);
                st8(qm + (size_t)(s0 + ml) * 128 + wc * 64 + i * 16 + fq * 4, w);
            }
        }
    }
}

DEV void phase6(const P& p, unsigned char* lds) {
    unsigned char* ws = p.ws;
    for (int w = blockIdx.x; w < 512; w += gridDim.x) {
        const int bh = w >> 6, u = w & 63, b = bh >> 2, h = bh & 3;
        attn_unit<128, false>(lds, (const bf16_t*)(ws + WS_QMEM) + (size_t)bh * S * 128, (const bf16_t*)(ws + WS_KMEM) + (size_t)bh * 256 * 128, nullptr,
                              (const bf16_t*)(ws + WS_VMEMT) + (size_t)bh * 128 * 256, 256, u * 64, 4,
                              (bf16_t*)(ws + WS_OMEM) + (size_t)b * S * 512 + h * 128, 512, nullptr, u * 64);
    }
}

DEV void phase7(const P& p, unsigned char* lds, bool dry = false) {
    unsigned char* ws = p.ws;
    const XcdIter xi = xcd_iter();
    const int lane = tidf() & 63, wid = tidf() >> 6, wr = wid >> 1, wc = wid & 1, fr = lane & 15, fq = lane >> 4;
    u64* sqb = (u64*)(ws + CTL_SQ);
    const float* x1 = (const float*)(ws + WS_X1); bf16_t* x2b = (bf16_t*)(ws + WS_X2B);
    const int per_x = 8 * 16, total = 64 * 16;
    for (int it = 0;; ++it) {
        int mt, nt;
        if (xi.x >= 0) { const int i = it * xi.per + xi.j; if (i >= per_x) break; mt = xi.x * 8 + (i & 7); nt = i >> 3; }
        else { const int i = it * xi.per + xi.j; if (i >= total) break; mt = i & 63; nt = i >> 6; }
        const int m0 = mt * 128;
        f32x4 acc[4][4]; acc_zero(acc);
        gemm_dense(acc, lds, (const bf16_t*)(ws + WS_OMEM), 512, m0, (const bf16_t*)(ws + WS_WMO), 512, nt * 128, 0, 8, true);
#pragma unroll
        for (int j = 0; j < 4; ++j) {
            const int m = m0 + wr * 64 + j * 16 + fr; float ss = 0.f;
#pragma unroll
            for (int i = 0; i < 4; ++i) {
                const int n = nt * 128 + wc * 64 + i * 16 + fq * 4;
                const f32x4 v = *(const f32x4*)(x1 + (size_t)m * D + n) + acc[i][j];
                ss += v[0] * v[0] + v[1] * v[1] + v[2] * v[2] + v[3] * v[3];
                st16f(p.out + (size_t)m * D + n, v);
                const f32x4 gf = *(const f32x4*)(p.norm_ffn + n);
                u32x2 w; w.x = cvt_pk_bf16(v[0] * gf[0], v[1] * gf[1]); w.y = cvt_pk_bf16(v[2] * gf[2], v[3] * gf[3]);
                st8(x2b + (size_t)m * D + n, w);
            }
            ss += __shfl_xor(ss, 16); ss += __shfl_xor(ss, 32); if (fq == 0 && !dry) sq_add(sqb + SQ_X2 * T, m, ss);
        }
    }
}

DEV void phase8(const P& p, unsigned char* lds) {
    unsigned char* ws = p.ws;
    const int tid = tidf(), lane = tid & 63, wid = tid >> 6, r16 = lane & 15, kq = lane >> 4;
    const float* wrt = (const float*)(ws + WS_WR);
    const u64* sqb = (const u64*)(ws + CTL_SQ);
    unsigned* cnt = (unsigned*)(ws + CTL_CNT);
    unsigned char* rt = ws + WS_ROUTE;
    float* red = (float*)lds;
    for (int tb = blockIdx.x; tb < T / 16; tb += gridDim.x) {
        const int t0 = tb * 16;
        f32x4 acc[3];
#pragma unroll
        for (int c = 0; c < 3; ++c) acc[c] = (f32x4){0.f, 0.f, 0.f, 0.f};
        const float* xa = p.out + (size_t)(t0 + r16) * D + wid * 512 + kq * 4;
        const float* wb = wrt + (size_t)r16 * D + wid * 512 + kq * 4;
#pragma unroll 4
        for (int k = 0; k < 512; k += 16) {
            const f32x4 a = *(const f32x4*)(xa + k);
            const f32x4 b0 = *(const f32x4*)(wb + k), b1 = *(const f32x4*)(wb + 16 * D + k), b2 = *(const f32x4*)(wb + 32 * D + k);
#pragma unroll
            for (int e = 0; e < 4; ++e) {
                acc[0] = __builtin_amdgcn_mfma_f32_16x16x4f32(a[e], b0[e], acc[0], 0, 0, 0);
                acc[1] = __builtin_amdgcn_mfma_f32_16x16x4f32(a[e], b1[e], acc[1], 0, 0, 0);
                acc[2] = __builtin_amdgcn_mfma_f32_16x16x4f32(a[e], b2[e], acc[2], 0, 0, 0);
            }
        }
#pragma unroll
        for (int c = 0; c < 3; ++c)
#pragma unroll
            for (int e = 0; e < 4; ++e) red[(wid * 16 + kq * 4 + e) * 48 + c * 16 + r16] = acc[c][e];
        __syncthreads();
        if (tid < 16) {
            const int tok = t0 + tid;
            const float rs = sq_rs(sqb + SQ_X2 * T, tok, 1.0f / 2048.0f);
            auto logit = [&](int n) { return ((red[(0 * 16 + tid) * 48 + n] + red[(1 * 16 + tid) * 48 + n]) + (red[(2 * 16 + tid) * 48 + n] + red[(3 * 16 + tid) * 48 + n])) * rs; };
            float lg0 = logit(0) + p.b_group[0], lg1 = logit(1) + p.b_group[1], lg2 = logit(2) + p.b_group[2], lg3 = logit(3) + p.b_group[3];
            int g = 0; float gm = lg0;
            if (lg1 > gm) { gm = lg1; g = 1; }
            if (lg2 > gm) { gm = lg2; g = 2; }
            if (lg3 > gm) { gm = lg3; g = 3; }
            const float gden = __expf(lg0 - gm) + __expf(lg1 - gm) + __expf(lg2 - gm) + __expf(lg3 - gm);
            const float pg = 1.0f / gden;
            float el[8];
#pragma unroll
            for (int e = 0; e < 8; ++e) el[e] = logit(4 + g * 8 + e) + p.b_er[g * 8 + e];
            int e1 = 0; float m1 = el[0];
#pragma unroll
            for (int e = 1; e < 8; ++e) if (el[e] > m1) { m1 = el[e]; e1 = e; }
            int e2 = -1; float m2 = -3.0e38f;
#pragma unroll
            for (int e = 0; e < 8; ++e) if (e != e1 && el[e] > m2) { m2 = el[e]; e2 = e; }
            const float x2e = __expf(m2 - m1);
            const float p1 = 1.0f / (1.0f + x2e), p2 = x2e / (1.0f + x2e);
            const int ex1 = g * 8 + e1, ex2 = g * 8 + e2;
            const unsigned pos1 = atomicAdd(cnt + ex1, 1u), pos2 = atomicAdd(cnt + ex2, 1u);
            int* rexp = (int*)(rt + RT_EXP); int* rpos = (int*)(rt + RT_POS); float* rgate = (float*)(rt + RT_GATE); int* rlist = (int*)(rt + RT_LIST);
            rexp[tok * 2] = ex1; rexp[tok * 2 + 1] = ex2; rpos[tok * 2] = (int)pos1; rpos[tok * 2 + 1] = (int)pos2;
            rgate[tok * 2] = pg * p1; rgate[tok * 2 + 1] = pg * p2;
            rlist[ex1 * T + pos1] = tok * 2; rlist[ex2 * T + pos2] = tok * 2 + 1;
        }
        __syncthreads();
    }
}

DEV int moe_table(const P& p, int* tbl  ) {
    const unsigned* cnt = (const unsigned*)(p.ws + CTL_CNT);
    if (tidf() < 64) {
        const int e = tidf() & 31;
        const int c = (int)__hip_atomic_load(cnt + e, __ATOMIC_RELAXED, __HIP_MEMORY_SCOPE_AGENT);
        const int nt = (c + 127) >> 7;
        int incl = nt;
#pragma unroll
        for (int o = 1; o < 32; o <<= 1) { const int v = __shfl_up(incl, o, 32); if (e >= o) incl += v; }
        if (tidf() < 32) { tbl[e] = incl - nt; tbl[33 + e] = c; if (e == 31) tbl[32] = incl; }
    }
    __syncthreads();
    return tbl[32];
}
DEV int moe_find(const int* tbl, int mtile) { int e = 0;
#pragma unroll 1
    for (int k = 16; k >= 1; k >>= 1) if (e + k < 32 && tbl[e + k] <= mtile) e += k;
    return e; }

DEV void phase9(const P& p, unsigned char* lds) {
    unsigned char* ws = p.ws;
    int* tbl = (int*)(lds + LDS_MAIN + 256);
    const int ntm = moe_table(p, tbl);
    const int tid = tidf(), lane = tid & 63, wid = tid >> 6, wr = wid >> 1, wc = wid & 1, fr = lane & 15, fq = lane >> 4;
    const int srow = tid >> 3, sc = stage_col(tid);
    const u64* sqb = (const u64*)(ws + CTL_SQ);
    const int* rlist = (const int*)(ws + WS_ROUTE + RT_LIST); const float* rgate = (const float*)(ws + WS_ROUTE + RT_GATE);
    const bf16_t* x2b = (const bf16_t*)(ws + WS_X2B);
    bf16_t* act = (bf16_t*)(ws + WS_ACT);
    for (int item = blockIdx.x; item < ntm * 8; item += gridDim.x) {
        const int mtile = item >> 3, nt = item & 7;
        const int e = moe_find(tbl, mtile), mi = mtile - tbl[e], cnt = tbl[33 + e];
        const int* le = rlist + (size_t)e * T;
        const bf16_t* ap[4];
#pragma unroll
        for (int i = 0; i < 4; ++i) { int li = mi * 128 + srow + 32 * i; li = li < cnt ? li : cnt - 1; ap[i] = x2b + (size_t)(le[li] >> 1) * D + sc; }
        const int np = (tid & 31) * 4, bi = (np >> 4) & 3;
        const float* bf = ((bi & 1) ? p.w_up : p.w_gate) + (size_t)e * 2048 * 512 + (size_t)(tid >> 5) * 512 + nt * 64 + (np >> 6) * 32 + (bi >> 1) * 16 + (np & 15);
        f32x4 acc[4][4]; acc_zero(acc);
        const float* pf = ((tid & 2) ? p.w_up : p.w_gate) + (size_t)e * 2048 * 512 + (size_t)(tid >> 2) * 512 + nt * 64 + (tid & 1) * 32;
        float rsj[4], gtj[4];
#pragma unroll
        for (int j = 0; j < 4; ++j) {
            int li = mi * 128 + wr * 64 + j * 16 + fr; li = li < cnt ? li : cnt - 1;
            const int ent = le[li];
            rsj[j] = sq_rs(sqb + SQ_X2 * T, ent >> 1, 1.0f / 2048.0f); gtj[j] = rgate[ent];
        }
        gemm_acc<true>(acc, lds, ap[0], ap[1], ap[2], ap[3], nullptr, nullptr, nullptr, nullptr, bf, 512, 32, true, pf);
#pragma unroll
        for (int j = 0; j < 4; ++j) {
            const int ml = wr * 64 + j * 16 + fr;
            const float rs = rsj[j], gt = gtj[j];
#pragma unroll
            for (int q = 0; q < 2; ++q) {
                const f32x4 a = acc[2 * q][j] * rs, u = acc[2 * q + 1][j] * rs;
                float o[4];
#pragma unroll
                for (int c = 0; c < 4; ++c) o[c] = a[c] / (1.0f + __expf(-a[c])) * u[c] * gt;
                u32x2 w; w.x = cvt_pk_bf16(o[0], o[1]); w.y = cvt_pk_bf16(o[2], o[3]);
                st8(act + (size_t)(mtile * 128 + ml) * 512 + nt * 64 + wc * 32 + q * 16 + fq * 4, w);
            }
        }
    }
}

DEV void phase10(const P& p, unsigned char* lds) {
    unsigned char* ws = p.ws;
    int* tbl = (int*)(lds + LDS_MAIN + 256);
    const int ntm = moe_table(p, tbl);
    const int tid = tidf(), lane = tid & 63, wid = tid >> 6, wr = wid >> 1, wc = wid & 1, fr = lane & 15, fq = lane >> 4;
    const int* rlist = (const int*)(ws + WS_ROUTE + RT_LIST);
    bf16_t* y = (bf16_t*)(ws + WS_Y);
    for (int item = blockIdx.x; item < ntm * 16; item += gridDim.x) {
        const int mtile = item >> 4, nt = item & 15;
        const int e = moe_find(tbl, mtile), mi = mtile - tbl[e], cnt = tbl[33 + e];
        const int* le = rlist + (size_t)e * T;
        f32x4 acc[4][4]; acc_zero(acc);
        int entj[4];
#pragma unroll
        for (int j = 0; j < 4; ++j) { const int li = mi * 128 + wr * 64 + j * 16 + fr; entj[j] = li < cnt ? le[li] : -1; }
        gemm_dense_bf32(acc, lds, (const bf16_t*)(ws + WS_ACT), 512, mtile * 128, p.w_down + (size_t)e * 512 * 2048 + nt * 128, 2048, 8);
#pragma unroll
        for (int j = 0; j < 4; ++j) {
            if (entj[j] >= 0) {
                const int ent = entj[j], tok = ent >> 1, k = ent & 1;
                bf16_t* yp = y + ((size_t)k * T + tok) * D + nt * 128 + wc * 64 + fq * 4;
#pragma unroll
                for (int i = 0; i < 4; ++i) { const f32x4 v = acc[i][j]; u32x2 w; w.x = cvt_pk_bf16(v[0], v[1]); w.y = cvt_pk_bf16(v[2], v[3]); *(u32x2*)(yp + i * 16) = w; }
            }
        }
    }
}

DEV void phase11(const P& p) {
    const int lane = tidf() & 63, gw = blockIdx.x * 4 + (tidf() >> 6), NGW = gridDim.x * 4;
    const bf16_t* y = (const bf16_t*)(p.ws + WS_Y);
    for (int row = gw; row < T; row += NGW) {
        float* xr = p.out + (size_t)row * D;
        const bf16_t* y0 = y + (size_t)row * D; const bf16_t* y1 = y + ((size_t)T + row) * D;
        f32x4 v[8]; float s = 0.f;
#pragma unroll
        for (int i = 0; i < 8; ++i) {
            const int c = i * 256 + lane * 4;
            v[i] = *(const f32x4*)(xr + c);
            const u32x2 a = *(const u32x2*)(y0 + c), b = *(const u32x2*)(y1 + c);
            v[i][0] += __uint_as_float(a.x << 16) + __uint_as_float(b.x << 16);
            v[i][1] += __uint_as_float(a.x & 0xffff0000u) + __uint_as_float(b.x & 0xffff0000u);
            v[i][2] += __uint_as_float(a.y << 16) + __uint_as_float(b.y << 16);
            v[i][3] += __uint_as_float(a.y & 0xffff0000u) + __uint_as_float(b.y & 0xffff0000u);
            s += v[i][0] * v[i][0] + v[i][1] * v[i][1] + v[i][2] * v[i][2] + v[i][3] * v[i][3];
        }
        s = wave_sum(s);
        const float rs = __builtin_amdgcn_rsqf(s * (1.0f / 2048.0f) + EPS);
#pragma unroll
        for (int i = 0; i < 8; ++i) {
            const int c = i * 256 + lane * 4;
            const f32x4 g = *(const f32x4*)(p.norm_final + c);
            *(f32x4*)(xr + c) = v[i] * rs * g;
        }
    }
}

#ifndef USE_CG_SYNC
#define USE_CG_SYNC 0
#endif
__global__ void __launch_bounds__(NTHREADS, 2) hymba_fwd(P p) {
    extern __shared__ __attribute__((aligned(16))) unsigned char lds[];
#if USE_CG_SYNC
    cg::grid_group grid = cg::this_grid();
#endif
    volatile unsigned* st = (volatile unsigned*)(lds + LDS_MAIN);
    if (threadIdx.x < 16) st[threadIdx.x] = 0u;
    __syncthreads();
    XcdBarrier bar = xcd_barrier_post((unsigned*)(p.ws + CTL_BAR), st);
#if USE_CG_SYNC
#define GRID_BAR() grid.sync()
#else
#define GRID_BAR() xcd_barrier(bar)
#endif
#ifndef PROBE_REPEAT
#define PROBE_REPEAT 0
#endif
#define REP(n) ((PROBE_REPEAT >> (n)) & 1)
#ifdef PROBE_BARS
    for (int i = 0; i < PROBE_BARS; ++i) GRID_BAR();
#endif
    phase0(p);        GRID_BAR();
    if (REP(0)) { phase0(p); GRID_BAR(); }
    phase1(p, lds);   GRID_BAR();
    if (REP(1)) { phase1(p, lds, true); GRID_BAR(); }
    phase2(p, lds);   GRID_BAR();
    if (REP(2)) { phase2(p, lds); GRID_BAR(); }
    phase3(p, lds);   GRID_BAR();
    if (REP(3)) { phase3(p, lds, true); GRID_BAR(); }
    phase4(p, lds);   GRID_BAR();
    if (REP(4)) { phase4(p, lds, true); GRID_BAR(); }
    phase5(p, lds);   GRID_BAR();
    if (REP(5)) { phase5(p, lds); GRID_BAR(); }
    phase6(p, lds);   GRID_BAR();
    if (REP(6)) { phase6(p, lds); GRID_BAR(); }
    phase7(p, lds);   GRID_BAR();
    if (REP(7)) { phase7(p, lds, true); GRID_BAR(); }
    phase8(p, lds);   GRID_BAR();
    phase9(p, lds);   GRID_BAR();
    if (REP(9)) { phase9(p, lds); GRID_BAR(); }
    phase10(p, lds);  GRID_BAR();
    if (REP(10)) { phase10(p, lds); GRID_BAR(); }
    phase11(p);
#if USE_CG_SYNC
    grid.sync();
#endif
    (void)bar;
}

extern "C" void kernel_launch(void* const* d_in, const int* in_sizes, int n_in, void* d_out, int out_size, void* d_ws, size_t ws_size, hipStream_t stream) {
    static int grid = 0;
    if (grid == 0) {
        if (n_in != 26 || out_size != T * D || ws_size < WS_END) {
            fprintf(stderr, "kernel_launch: unexpected shapes: n_in %d out %d ws %zu (need %zu)\n", n_in, out_size, ws_size, (size_t)WS_END); grid = -1; return; }
        int dev = 0, cus = 0, per_cu = 0;
        hipGetDevice(&dev);
        hipDeviceGetAttribute(&cus, hipDeviceAttributeMultiprocessorCount, dev);
        if (hipFuncSetAttribute((const void*)hymba_fwd, hipFuncAttributeMaxDynamicSharedMemorySize, LDS_BYTES) != hipSuccess) { fprintf(stderr, "kernel_launch: hipFuncSetAttribute failed\n"); grid = -1; return; }
        if (hipOccupancyMaxActiveBlocksPerMultiprocessor(&per_cu, (const void*)hymba_fwd, NTHREADS, LDS_BYTES) != hipSuccess || per_cu < 1) { fprintf(stderr, "kernel_launch: occupancy query failed (%d)\n", per_cu); grid = -1; return; }
        if (per_cu > 2) per_cu = 2;
        grid = cus * per_cu;
        fprintf(stderr, "kernel_launch: %d CUs x %d blocks\n", cus, per_cu);
    }
    if (grid < 0) return;
    hipMemsetAsync(d_ws, 0, CTL_BYTES, stream);
    P p{};
    p.x = (const float*)d_in[0]; p.mem = (const float*)d_in[1]; p.pos = (const int*)d_in[2];
    p.norm_mix = (const float*)d_in[3]; p.w_in = (const float*)d_in[4]; p.norm_q_lat = (const float*)d_in[5]; p.w_q_b = (const float*)d_in[6];
    p.norm_kv_lat = (const float*)d_in[7]; p.w_kv_b = (const float*)d_in[8]; p.norm_mla_out = (const float*)d_in[9]; p.norm_sb_out = (const float*)d_in[10];
    p.w_out = (const float*)d_in[11]; p.norm_mem_x = (const float*)d_in[12]; p.norm_mem_src = (const float*)d_in[13]; p.w_mem_q = (const float*)d_in[14];
    p.w_mem_kv = (const float*)d_in[15]; p.w_mem_o = (const float*)d_in[16]; p.norm_ffn = (const float*)d_in[17]; p.w_group = (const float*)d_in[18];
    p.b_group = (const float*)d_in[19]; p.w_er = (const float*)d_in[20]; p.b_er = (const float*)d_in[21]; p.w_gate = (const float*)d_in[22];
    p.w_up = (const float*)d_in[23]; p.w_down = (const float*)d_in[24]; p.norm_final = (const float*)d_in[25];
    p.out = (float*)d_out; p.ws = (unsigned char*)d_ws;
    void* args[] = {&p};
    hipError_t e = hipLaunchCooperativeKernel((const void*)hymba_fwd, dim3(grid), dim3(NTHREADS), args, LDS_BYTES, stream);
    if (e != hipSuccess) fprintf(stderr, "kernel_launch: cooperative launch failed: %s (grid %d)\n", hipGetErrorString(e), grid);
}
```

```cpp
#include <hip/hip_runtime.h>
#include <hip/hip_cooperative_groups.h>
#include <cstdio>
#include <cstdint>
namespace cg = cooperative_groups;

typedef unsigned short bf16_t;
typedef short bf16x8 __attribute__((ext_vector_type(8)));
typedef float f32x4 __attribute__((ext_vector_type(4)));
typedef float f32x16 __attribute__((ext_vector_type(16)));
typedef unsigned u32x4 __attribute__((ext_vector_type(4)));
typedef unsigned u32x2 __attribute__((ext_vector_type(2)));
typedef unsigned long long u64;

#define DEV __device__ __forceinline__

constexpr int D = 2048, NB = 2, S = 4096, T = NB * S;
constexpr int MEML = 256, MT = NB * MEML;
constexpr int NIN = 3968;
constexpr float EPS = 1e-6f;
constexpr float LOG2E = 1.4426950408889634f;
constexpr int NTHREADS = 256;
constexpr int LDS_MAIN = 65536;
constexpr int LDS_BYTES = LDS_MAIN + 1024;

constexpr size_t MB = 1024 * 1024;
constexpr size_t WS_CTL = 0;
constexpr size_t CTL_BAR = 0;
constexpr size_t CTL_CNT = 16384;
constexpr size_t CTL_SQ = 32768;
constexpr size_t CTL_CU = CTL_SQ + 6 * (size_t)T * 8;
constexpr size_t CTL_BYTES = CTL_CU + 8192;
constexpr size_t WS_WIN = 1 * MB;
constexpr size_t WS_WQB = WS_WIN + (size_t)NIN * D * 2;
constexpr size_t WS_WKVB = WS_WQB + 1536 * 512 * 2;
constexpr size_t WS_WOUT = WS_WKVB + 2048 * 256 * 2;
constexpr size_t WS_WMQ = WS_WOUT + (size_t)2048 * 2048 * 2;
constexpr size_t WS_WMKV = WS_WMQ + 512 * 2048 * 2;
constexpr size_t WS_WMO = WS_WMKV + 1024 * 2048 * 2;
constexpr size_t WS_WGU = WS_WMO + 2048 * 512 * 2;
constexpr size_t WS_WD = WS_WGU + (size_t)32 * 1024 * 2048 * 2;
constexpr size_t WS_WR = WS_WD + (size_t)32 * 2048 * 512 * 2;
constexpr size_t WS_H = WS_WR + 48 * 2048 * 4;
constexpr size_t WS_MEMN = WS_H + (size_t)T * D * 2;
constexpr size_t WS_ROPE = WS_MEMN + (size_t)MT * D * 2;
constexpr size_t WS_CQ = WS_ROPE + (size_t)T * 32 * 8;
constexpr size_t WS_CKV = WS_CQ + (size_t)T * 512 * 2;
constexpr size_t WS_QSB = WS_CKV + (size_t)T * 256 * 2;
constexpr size_t WS_KSB = WS_QSB + (size_t)T * 1024 * 2;
constexpr size_t WS_VSBT = WS_KSB + (size_t)T * 1024 * 2;
constexpr size_t WS_KPE = WS_VSBT + (size_t)T * 1024 * 2;
constexpr size_t WS_KMEM = WS_KPE + (size_t)T * 64 * 2;
constexpr size_t WS_VMEMT = WS_KMEM + (size_t)MT * 512 * 2;
constexpr size_t WS_QM = WS_VMEMT + (size_t)MT * 512 * 2;
constexpr size_t WS_KN = WS_QM + (size_t)T * 1536 * 2;
constexpr size_t WS_VMT = WS_KN + (size_t)T * 1024 * 2;
constexpr size_t WS_X1 = WS_VMT + (size_t)T * 1024 * 2;
constexpr size_t WS_ROUTE = WS_X1 + (size_t)T * D * 4;
constexpr size_t RT_SLOT = 0;
constexpr size_t RT_GATE = (size_t)T * 2 * 4;
constexpr size_t RT_EXP = RT_GATE + (size_t)T * 2 * 4;
constexpr size_t RT_POS = RT_EXP + (size_t)T * 2 * 4;
constexpr size_t RT_LIST = RT_POS + (size_t)T * 2 * 4;
constexpr size_t WS_END = WS_ROUTE + RT_LIST + (size_t)32 * T * 4;
constexpr size_t WS_OMIX = WS_H, WS_X2B = WS_H, WS_X1B = WS_QSB, WS_QMEM = WS_CQ, WS_OMEM = WS_KN, WS_ACT = WS_QM, WS_Y = WS_X1;
constexpr int ACT_ROWS_MAX = 2 * T + 32 * 128;

enum { SQ_CQ = 0, SQ_CKV, SQ_OMLA, SQ_OSB, SQ_X1, SQ_X2 };

struct P {
    const float* x; const float* mem; const int* pos;
    const float *norm_mix, *w_in, *norm_q_lat, *w_q_b, *norm_kv_lat, *w_kv_b, *norm_mla_out, *norm_sb_out, *w_out;
    const float *norm_mem_x, *norm_mem_src, *w_mem_q, *w_mem_kv, *w_mem_o, *norm_ffn, *w_group, *b_group, *w_er, *b_er;
    const float *w_gate, *w_up, *w_down, *norm_final;
    float* out; unsigned char* ws;
};

DEV int tidf() { int t = threadIdx.x; asm volatile("" : "+v"(t)); return t; }
DEV unsigned cvt_pk_bf16(float lo, float hi) { unsigned r; asm("v_cvt_pk_bf16_f32 %0, %1, %2" : "=v"(r) : "v"(lo), "v"(hi)); return r; }
#ifndef WT_STORES
#define WT_STORES 0
#endif
DEV void st8(void* p, u32x2 v) {
#if WT_STORES > 1
    asm volatile("global_store_dwordx2 %0, %1, off sc1" :: "v"(p), "v"(v) : "memory");
#else
    *(u32x2*)p = v;
#endif
}
DEV void st16f(void* p, f32x4 v) {
#if WT_STORES
    asm volatile("global_store_dwordx4 %0, %1, off sc1\n\ts_nop 1" :: "v"(p), "v"(v) : "memory");
#else
    *(f32x4*)p = v;
#endif
}
DEV void st16u(void* p, u32x4 v) {
#if WT_STORES
    asm volatile("global_store_dwordx4 %0, %1, off sc1\n\ts_nop 1" :: "v"(p), "v"(v) : "memory");
#else
    *(u32x4*)p = v;
#endif
}
DEV float bf16_to_f32(bf16_t v) { return __uint_as_float(((unsigned)v) << 16); }
DEV float fexp2(float x) { return __builtin_amdgcn_exp2f(x); }
DEV float flog2(float x) { return __builtin_amdgcn_logf(x); }
DEV float wave_sum(float v) {
#pragma unroll
    for (int o = 32; o >= 1; o >>= 1) v += __shfl_xor(v, o);
    return v;
}
DEV void sq_add(u64* sq, int row, float partial) { atomicAdd(sq + row, (u64)__float2ull_rn(partial * 4294967296.0f)); }
DEV float sq_rs(const u64* sq, int row, float inv_n) {
    const u64 v = __hip_atomic_load(sq + row, __ATOMIC_RELAXED, __HIP_MEMORY_SCOPE_AGENT);
    const float ms = (float)((double)v * (1.0 / 4294967296.0)) * inv_n;
    return __builtin_amdgcn_rsqf(ms + EPS);
}
DEV int vperm4(int s0) { const int g = (s0 >> 2) & 3; const int gp = ((g & 1) << 1) | (g >> 1); return (s0 & ~15) | (gp << 2); }

#define XB_TMO      128
#define XB_XCNT(j)  (256  + 64 * (j))
#define XB_XSUB(j)  (1280 + 64 * (j))
#define XB_XGEN(j)  (2304 + 64 * (j))
#define XB_TOP      3328
#define XB_TOPGEN   3392
#define XCD_BAR_WORDS 3456
#define XB_SPIN_CAP (1u << 22)
#define LAS __attribute__((address_space(3)))
DEV unsigned xb_ld(unsigned* p) { return __hip_atomic_load(p, __ATOMIC_RELAXED, __HIP_MEMORY_SCOPE_AGENT); }
DEV unsigned xb_add(unsigned* p, unsigned v) { return __hip_atomic_fetch_add(p, v, __ATOMIC_RELAXED, __HIP_MEMORY_SCOPE_AGENT); }
DEV unsigned xb_xcc_id() { return (unsigned)__builtin_amdgcn_s_getreg((3 << 11) | 20) & 0xFu; }
#define XB_SPIN(cond, bar) do { unsigned _sp = 0; while (cond) { __builtin_amdgcn_s_sleep(1); \
    if ((++_sp & 255u) == 0u) { if (xb_ld(&(bar)[XB_TMO])) break; if (_sp > XB_SPIN_CAP) { atomicAdd(&(bar)[XB_TMO], 1u); break; } } } } while (0)
struct XcdBarrier { unsigned* bar; unsigned x; volatile unsigned* st; };
DEV XcdBarrier xcd_barrier_post(unsigned* bar, volatile unsigned* st) {
    XcdBarrier b; b.bar = bar; b.x = xb_xcc_id(); b.st = st;
    if (threadIdx.x == 0) (void)xb_add(&bar[XB_XCNT(b.x)], 1u);
    return b;
}
DEV void xcd_barrier_complete(unsigned* bar, unsigned x, unsigned& nloc, unsigned& nx) {
    const unsigned G = gridDim.x;
    unsigned sum, cnt, mine, sp = 0u;
    for (;;) {
        sum = 0u; cnt = 0u; mine = 0u;
#pragma unroll
        for (unsigned j = 0; j < 16; ++j) { const unsigned c = xb_ld(&bar[XB_XCNT(j)]); sum += c; cnt += (c > 0u) ? 1u : 0u; mine = (j == x) ? c : mine; }
        if (sum == G) break;
        __builtin_amdgcn_s_sleep(1);
        if ((++sp & 255u) == 0u) { if (xb_ld(&bar[XB_TMO])) break; if (sp > XB_SPIN_CAP) { atomicAdd(&bar[XB_TMO], 1u); break; } }
    }
    nloc = mine > 0u ? mine : 1u; nx = cnt > 0u ? cnt : 1u;
}
DEV void xcd_barrier(const XcdBarrier& b) {
    asm volatile("s_waitcnt vmcnt(0)" ::: "memory");
    __syncthreads();
    if (threadIdx.x == 0) {
        unsigned* bar = b.bar;
        __builtin_amdgcn_s_waitcnt(0);
        unsigned nloc = b.st[0], nx = b.st[1];
        if (nloc == 0u) { xcd_barrier_complete(bar, b.x, nloc, nx); b.st[0] = nloc; b.st[1] = nx; }
        const unsigned old = xb_add(&bar[XB_XSUB(b.x)], 1u);
        const unsigned gen = old / nloc;
        if (old + 1u == (gen + 1u) * nloc) {
            __builtin_amdgcn_fence(__ATOMIC_RELEASE, "agent");
            asm volatile("s_waitcnt vmcnt(0)" ::: "memory");
            const unsigned og = xb_add(&bar[XB_TOP], 1u);
            const unsigned tg = og / nx;
            if (og + 1u == (tg + 1u) * nx) xb_add(&bar[XB_TOPGEN], 1u);
            else XB_SPIN(xb_ld(&bar[XB_TOPGEN]) == tg, bar);
            __builtin_amdgcn_fence(__ATOMIC_ACQUIRE, "agent");
            xb_add(&bar[XB_XGEN(b.x)], 1u);
            asm volatile("s_waitcnt vmcnt(0)" ::: "memory");
        } else {
            XB_SPIN(xb_ld(&bar[XB_XGEN(b.x)]) == gen, bar);
            __builtin_amdgcn_fence(__ATOMIC_ACQUIRE, "agent");
            asm volatile("s_waitcnt vmcnt(0)" ::: "memory");
        }
    }
    __syncthreads();
}

struct XcdIter { int x, j, per; };
DEV XcdIter xcd_iter() { XcdIter r; const int G = gridDim.x; if ((G & 7) == 0) { r.x = blockIdx.x & 7; r.j = blockIdx.x >> 3; r.per = G >> 3; } else { r.x = -1; r.j = blockIdx.x; r.per = G; } return r; }

#define GLDS16(g, l) __builtin_amdgcn_global_load_lds((const unsigned*)(g), (LAS unsigned*)(l), 16, 0, 0)
typedef short s16x4 __attribute__((ext_vector_type(4)));
DEV int stage_col(int tid) { return (((tid & 7) ^ ((tid >> 3) & 7)) << 3); }
#ifndef PF_DIST
#define PF_DIST 3
#endif
template <bool BF32, int ABL = 0>
DEV void gemm_acc(f32x4 (&acc)[4][4], unsigned char* lds, const bf16_t* a0, const bf16_t* a1, const bf16_t* a2, const bf16_t* a3,
                  const bf16_t* b0, const bf16_t* b1, const bf16_t* b2, const bf16_t* b3, const float* bf, int ldn, int nkt, bool swap, const float* pf = nullptr) {
    const int tid = tidf();
    const int lane = tid & 63, wid = tid >> 6, wr = wid >> 1, wc = wid & 1, fr = lane & 15, fq = lane >> 4;
    const int xbase = swap ? (16384 + wc * 8192) : (wr * 8192);
    const int ybase = swap ? (wr * 8192) : (16384 + wc * 8192);
    unsigned char* ldw = lds + wid * 1024;
    const int n4 = tid & 31, kr = tid >> 5;
    const int wofs = 16384 + kr * 256 + (n4 & 3) * 8, sl0 = ((n4 >> 2) ^ (kr & 3)) << 5, sl1 = ((n4 >> 2) ^ ((kr & 3) | 4)) << 5;
    const int tq = (lane >> 2) & 3, gq = tq | ((fq & 1) << 2);
    const int wrd = 16384 + (8 * fq + tq) * 256 + 8 * (lane & 3);
    f32x4 rb[8];
    auto stage_a = [&](int buf, int ko) { GLDS16(a0 + ko, ldw + buf); GLDS16(a1 + ko, ldw + buf + 4096); GLDS16(a2 + ko, ldw + buf + 8192); GLDS16(a3 + ko, ldw + buf + 12288); };
    auto stage_b = [&](int buf, int ko) { GLDS16(b0 + ko, ldw + buf + 16384); GLDS16(b1 + ko, ldw + buf + 16384 + 4096); GLDS16(b2 + ko, ldw + buf + 16384 + 8192); GLDS16(b3 + ko, ldw + buf + 16384 + 12288); };
    auto load_bf = [&](int kt) {
#pragma unroll
        for (int i = 0; i < 8; ++i) rb[i] = *(const f32x4*)(bf + (size_t)(kt * 64 + 8 * i) * ldn);
    };
    auto write_bf = [&](int buf) {
#pragma unroll
        for (int i = 0; i < 8; ++i) {
            u32x2 w; w.x = cvt_pk_bf16(rb[i][0], rb[i][1]); w.y = cvt_pk_bf16(rb[i][2], rb[i][3]);
            *(u32x2*)(lds + buf + wofs + i * 2048 + ((i & 1) ? sl1 : sl0)) = w;
        }
    };
    stage_a(0, 0);
    if (BF32) { load_bf(0); write_bf(0); } else stage_b(0, 0);
    asm volatile("s_waitcnt vmcnt(0)" ::: "memory");
    __syncthreads();
    float pf_old = 0.f;
    for (int kt = 0; kt < nkt; ++kt) {
        const int cur = (kt & 1) * 32768, nxt = 32768 - cur;
        const bool more = (kt + 1 < nkt);
#ifndef GEMM_INTERLEAVE
#define GEMM_INTERLEAVE 0
#endif
        constexpr bool ILV = GEMM_INTERLEAVE && !BF32 && ABL == 0;
        if (more && !ILV && !(ABL == 2 && !BF32)) { stage_a(nxt, (kt + 1) * 64); if (BF32) load_bf(kt + 1); else stage_b(nxt, (kt + 1) * 64); }
        float pf_new = 0.f; const bool pfi = BF32 && pf && (kt + PF_DIST < nkt);
        if (pfi) pf_new = *(pf + (size_t)(kt + PF_DIST) * 64 * ldn);
        __builtin_amdgcn_sched_barrier(0);
#pragma unroll
        for (int ks = 0; ks < 2; ++ks) {
            bf16x8 xf[4], yf[4];
            const int coff = (((ks * 4 + fq) ^ (fr & 7)) << 4) + fr * 128;
            if (BF32) {
#pragma unroll
                for (int i = 0; i < 4; ++i) {
                    const int o = cur + wrd + ks * 8192 + (((wc * 4 + i) ^ gq) << 5);
                    const s16x4 lo = __builtin_amdgcn_ds_read_tr16_b64_v4i16((LAS s16x4*)(lds + o));
                    const s16x4 hi = __builtin_amdgcn_ds_read_tr16_b64_v4i16((LAS s16x4*)(lds + o + 1024));
                    xf[i] = __builtin_shufflevector(lo, hi, 0, 1, 2, 3, 4, 5, 6, 7);
                    yf[i] = *(const bf16x8*)(lds + cur + wr * 8192 + i * 2048 + coff);
                }
            } else if (ABL == 3) {
#pragma unroll
                for (int i = 0; i < 4; ++i) { xf[i] = (bf16x8){(short)(0x3f80 + i), 0x3f80, 0x3f81, 0x3f82, 0x3f83, 0x3f84, 0x3f85, (short)(0x3f86 + ks)}; yf[i] = xf[i]; asm volatile("" : "+v"(xf[i]), "+v"(yf[i])); }
            } else {
#pragma unroll
                for (int i = 0; i < 4; ++i) { xf[i] = *(const bf16x8*)(lds + cur + xbase + i * 2048 + coff); yf[i] = *(const bf16x8*)(lds + cur + ybase + i * 2048 + coff); }
            }
            if (ABL == 1 && !BF32) {
#pragma unroll
                for (int i = 0; i < 4; ++i) asm volatile("" :: "v"(xf[i]), "v"(yf[i]));
            } else if (ILV) {
                const int ko = (kt + 1) * 64;
#pragma unroll
                for (int i = 0; i < 4; ++i) {
                    __builtin_amdgcn_s_setprio(1);
#pragma unroll
                    for (int j = 0; j < 4; ++j) acc[i][j] = __builtin_amdgcn_mfma_f32_16x16x32_bf16(xf[i], yf[j], acc[i][j], 0, 0, 0);
                    __builtin_amdgcn_s_setprio(0);
                    if (more) {
                        const bf16_t* g = (ks == 0) ? (i == 0 ? a0 : i == 1 ? a1 : i == 2 ? a2 : a3) : (i == 0 ? b0 : i == 1 ? b1 : i == 2 ? b2 : b3);
                        GLDS16(g + ko, ldw + nxt + ks * 16384 + i * 4096);
                    }
                    __builtin_amdgcn_sched_barrier(0);
                }
            } else {
            __builtin_amdgcn_s_setprio(1);
#pragma unroll
            for (int i = 0; i < 4; ++i)
#pragma unroll
                for (int j = 0; j < 4; ++j) acc[i][j] = __builtin_amdgcn_mfma_f32_16x16x32_bf16(xf[i], yf[j], acc[i][j], 0, 0, 0);
            __builtin_amdgcn_s_setprio(0);
            }
        }
        if (BF32 && more) write_bf(nxt);
        if (BF32) {
            if (pfi) asm volatile("s_waitcnt vmcnt(1) lgkmcnt(0)" ::: "memory"); else asm volatile("s_waitcnt vmcnt(0) lgkmcnt(0)" ::: "memory");
            asm volatile("" :: "v"(pf_old));
            pf_old = pf_new;
            __builtin_amdgcn_s_barrier();
            asm volatile("" ::: "memory");
        } else {
            asm volatile("s_waitcnt vmcnt(0)" ::: "memory");
            __syncthreads();
        }
    }
    if (BF32) asm volatile("" :: "v"(pf_old));
}

struct GT { const bf16_t* a[4]; const bf16_t* b[4]; };
struct GemmPipe { int sb; bool pre; };
DEV int bperm(int r) { const int a = r & 15; return (r & 64) | ((a >> 2) << 4) | (((r >> 4) & 3) << 2) | (a & 3); }
DEV GT gt_dense(const bf16_t* A, int lda, int m0, const bf16_t* Bt, int ldb, int n0, int k0, bool perm = true) {
    const int tid = tidf(), srow = tid >> 3, sc = stage_col(tid);
    GT t;
    const bf16_t* b = Bt + (size_t)n0 * ldb + k0 + sc;
#pragma unroll
    for (int i = 0; i < 4; ++i) { const int r = srow + 32 * i; t.a[i] = A + (size_t)(m0 + (perm ? r : bperm(r))) * lda + k0 + sc; t.b[i] = b + (size_t)(perm ? bperm(r) : r) * ldb; }
    return t;
}
DEV void gemm_run(f32x4 (&acc)[4][4], unsigned char* lds, const GT& t, int nkt, bool swap, GemmPipe& gp, const GT& next, bool has_next) {
    const int tid = tidf();
    const int lane = tid & 63, wid = tid >> 6, wr = wid >> 1, wc = wid & 1, fr = lane & 15, fq = lane >> 4;
    const int xbase = swap ? (16384 + wc * 8192) : (wr * 8192);
    const int ybase = swap ? (wr * 8192) : (16384 + wc * 8192);
    unsigned char* ldw = lds + wid * 1024;
    auto stage = [&](const GT& g, int buf, int ko) {
#pragma unroll
        for (int i = 0; i < 4; ++i) GLDS16(g.a[i] + ko, ldw + buf + i * 4096);
#pragma unroll
        for (int i = 0; i < 4; ++i) GLDS16(g.b[i] + ko, ldw + buf + 16384 + i * 4096);
    };
    if (!gp.pre) { gp.sb = 0; stage(t, 0, 0); }
    asm volatile("s_waitcnt vmcnt(0)" ::: "memory");
    __builtin_amdgcn_s_barrier();
    asm volatile("" ::: "memory");
#pragma unroll 2
    for (int kt = 0; kt < nkt; ++kt) {
        const int cur = ((kt + gp.sb) & 1) * 32768, nxt = 32768 - cur;
        const bool more = (kt + 1 < nkt);
        if (more) stage(t, nxt, (kt + 1) * 64); else if (has_next) stage(next, nxt, 0);
        __builtin_amdgcn_sched_barrier(0);
#pragma unroll
        for (int ks = 0; ks < 2; ++ks) {
            bf16x8 xf[4], yf[4];
            const int coff = (((ks * 4 + fq) ^ (fr & 7)) << 4) + fr * 128;
#pragma unroll
            for (int i = 0; i < 4; ++i) { xf[i] = *(const bf16x8*)(lds + cur + xbase + i * 2048 + coff); yf[i] = *(const bf16x8*)(lds + cur + ybase + i * 2048 + coff); }
            __builtin_amdgcn_s_setprio(1);
#pragma unroll
            for (int i = 0; i < 4; ++i)
#pragma unroll
                for (int j = 0; j < 4; ++j) acc[i][j] = __builtin_amdgcn_mfma_f32_16x16x32_bf16(xf[i], yf[j], acc[i][j], 0, 0, 0);
            __builtin_amdgcn_s_setprio(0);
        }
        if (more) asm volatile("s_waitcnt vmcnt(0) lgkmcnt(0)" ::: "memory"); else asm volatile("s_waitcnt lgkmcnt(0)" ::: "memory");
        __builtin_amdgcn_s_barrier();
        asm volatile("" ::: "memory");
    }
    gp.pre = has_next; gp.sb = (nkt + gp.sb) & 1;
}

constexpr float W8_SCALE = 64.0f, ACT8_SCALE = 8.0f;
typedef int v8i __attribute__((ext_vector_type(8)));
typedef unsigned char u8;
DEV float sat8(float v) { return __builtin_amdgcn_fmed3f(v, -448.0f, 448.0f); }
DEV unsigned pack_fp8x4_sat(float a, float b, float c, float d) { int w = 0; w = __builtin_amdgcn_cvt_pk_fp8_f32(sat8(a), sat8(b), w, false); w = __builtin_amdgcn_cvt_pk_fp8_f32(sat8(c), sat8(d), w, true); return (unsigned)w; }
DEV unsigned pack_fp8x4(float a, float b, float c, float d) { int w = 0; w = __builtin_amdgcn_cvt_pk_fp8_f32(a, b, w, false); w = __builtin_amdgcn_cvt_pk_fp8_f32(c, d, w, true); return (unsigned)w; }
struct GT8 { const u8* a[4]; const u8* b[4]; };
DEV void gemm_run8(f32x4 (&acc)[4][4], unsigned char* lds, const GT8& t, int nks  , GemmPipe& gp, const GT8& next, bool has_next) {
    const int tid = tidf();
    const int lane = tid & 63, wid = tid >> 6, wr = wid >> 1, wc = wid & 1, fr = lane & 15, fq = lane >> 4;
    const int xbase = 16384 + wc * 8192, ybase = wr * 8192;
    unsigned char* ldw = lds + wid * 1024;
    const int off0 = fr * 128 + (((2 * fq) ^ (fr & 7)) << 4), off1 = fr * 128 + (((2 * fq + 1) ^ (fr & 7)) << 4);
    auto stage = [&](const GT8& g, int buf, int ko) {
#pragma unroll
        for (int i = 0; i < 4; ++i) GLDS16(g.a[i] + ko, ldw + buf + i * 4096);
#pragma unroll
        for (int i = 0; i < 4; ++i) GLDS16(g.b[i] + ko, ldw + buf + 16384 + i * 4096);
    };
    if (!gp.pre) { gp.sb = 0; stage(t, 0, 0); }
    asm volatile("s_waitcnt vmcnt(0)" ::: "memory");
    __builtin_amdgcn_s_barrier();
    asm volatile("" ::: "memory");
#pragma unroll 1
    for (int ks = 0; ks < nks; ++ks) {
        const int cur = ((ks + gp.sb) & 1) * 32768, nxt = 32768 - cur;
        const bool more = (ks + 1 < nks);
        if (more) stage(t, nxt, (ks + 1) * 128); else if (has_next) stage(next, nxt, 0);
        __builtin_amdgcn_sched_barrier(0);
        v8i xf[4], yf[4];
#pragma unroll
        for (int i = 0; i < 4; ++i) {
            const u32x4 xl = *(const u32x4*)(lds + cur + xbase + i * 2048 + off0), xh = *(const u32x4*)(lds + cur + xbase + i * 2048 + off1);
            const u32x4 yl = *(const u32x4*)(lds + cur + ybase + i * 2048 + off0), yh = *(const u32x4*)(lds + cur + ybase + i * 2048 + off1);
            xf[i] = (v8i){(int)xl.x, (int)xl.y, (int)xl.z, (int)xl.w, (int)xh.x, (int)xh.y, (int)xh.z, (int)xh.w};
            yf[i] = (v8i){(int)yl.x, (int)yl.y, (int)yl.z, (int)yl.w, (int)yh.x, (int)yh.y, (int)yh.z, (int)yh.w};
        }
        __builtin_amdgcn_s_setprio(1);
#pragma unroll
        for (int i = 0; i < 4; ++i)
#pragma unroll
            for (int j = 0; j < 4; ++j) acc[i][j] = __builtin_amdgcn_mfma_scale_f32_16x16x128_f8f6f4(xf[i], yf[j], acc[i][j], 0, 0, 0, 0x7F7F7F7F, 0, 0x7F7F7F7F);
        __builtin_amdgcn_s_setprio(0);
        if (more) asm volatile("s_waitcnt vmcnt(0) lgkmcnt(0)" ::: "memory"); else asm volatile("s_waitcnt lgkmcnt(0)" ::: "memory");
        __builtin_amdgcn_s_barrier();
        asm volatile("" ::: "memory");
    }
    gp.pre = has_next; gp.sb = (nks + gp.sb) & 1;
}
DEV void acc_zero(f32x4 (&acc)[4][4]) {
#pragma unroll
    for (int i = 0; i < 4; ++i)
#pragma unroll
        for (int j = 0; j < 4; ++j) acc[i][j] = (f32x4){0.f, 0.f, 0.f, 0.f};
}
template <int ABL = 0>
DEV void gemm_dense(f32x4 (&acc)[4][4], unsigned char* lds, const bf16_t* A, int lda, int m0, const bf16_t* Bt, int ldb, int n0, int k0, int nkt, bool swap) {
    const int tid = tidf();
    const int srow = tid >> 3, sc = stage_col(tid);
    const bf16_t* a = A + (size_t)m0 * lda + k0 + sc;
    const bf16_t* b = Bt + (size_t)n0 * ldb + k0 + sc;
    const int p0 = bperm(srow), p1 = bperm(srow + 32), p2 = bperm(srow + 64), p3 = bperm(srow + 96);
    const int r0 = swap ? p0 : srow, r1 = swap ? p1 : srow + 32, r2 = swap ? p2 : srow + 64, r3 = swap ? p3 : srow + 96;
    const int q0 = swap ? srow : p0, q1 = swap ? srow + 32 : p1, q2 = swap ? srow + 64 : p2, q3 = swap ? srow + 96 : p3;
    gemm_acc<false, ABL>(acc, lds, a + (size_t)q0 * lda, a + (size_t)q1 * lda, a + (size_t)q2 * lda, a + (size_t)q3 * lda, b + (size_t)r0 * ldb, b + (size_t)r1 * ldb, b + (size_t)r2 * ldb, b + (size_t)r3 * ldb, nullptr, 0, nkt, swap);
}
DEV void gemm_dense_bf32(f32x4 (&acc)[4][4], unsigned char* lds, const bf16_t* A, int lda, int m0, const float* Bsrc, int ldn, int nkt) {
    const int tid = tidf();
    const int srow = tid >> 3, sc = stage_col(tid);
    const bf16_t* a = A + (size_t)(m0 + srow) * lda + sc;
    const float* bf = Bsrc + (size_t)(tid >> 5) * ldn + (tid & 31) * 4;
    const float* pf = Bsrc + (size_t)(tid >> 2) * ldn + (tid & 3) * 32;
    gemm_acc<true>(acc, lds, a, a + (size_t)32 * lda, a + (size_t)64 * lda, a + (size_t)96 * lda, nullptr, nullptr, nullptr, nullptr, bf, ldn, nkt, true, pf);
}

template <class GainF, class RowF>
DEV void transpose_item(const float* src, int N, bf16_t* dst, int ldd, int k0, int n0, int lane, GainF gain, RowF dstrow) {
    const int ln = lane & 7, lk = lane >> 3;
    const int k = k0 + lk * 8, n = n0 + ln * 4;
    f32x4 v[8];
#pragma unroll
    for (int kk = 0; kk < 8; ++kk) v[kk] = *(const f32x4*)(src + (size_t)(k + kk) * N + n);
    float g[8];
#pragma unroll
    for (int kk = 0; kk < 8; ++kk) g[kk] = gain(k + kk);
#pragma unroll
    for (int j = 0; j < 4; ++j) {
        u32x4 w;
        w.x = cvt_pk_bf16(v[0][j] * g[0], v[1][j] * g[1]); w.y = cvt_pk_bf16(v[2][j] * g[2], v[3][j] * g[3]);
        w.z = cvt_pk_bf16(v[4][j] * g[4], v[5][j] * g[5]); w.w = cvt_pk_bf16(v[6][j] * g[6], v[7][j] * g[7]);
        st16u(dst + (size_t)dstrow(n + j) * ldd + k, w);
    }
}
DEV int rope_perm64(int i) { return i < 32 ? 2 * i : 2 * (i - 32) + 1; }

DEV void rms_row_to_bf16(const float* src, const float* g, bf16_t* dst, int lane) {
    f32x4 v[8]; float s = 0.f;
#pragma unroll
    for (int i = 0; i < 8; ++i) { v[i] = *(const f32x4*)(src + i * 256 + lane * 4); s += v[i][0] * v[i][0] + v[i][1] * v[i][1] + v[i][2] * v[i][2] + v[i][3] * v[i][3]; }
    s = wave_sum(s);
    const float rs = __builtin_amdgcn_rsqf(s * (1.0f / 2048.0f) + EPS);
#pragma unroll
    for (int i = 0; i < 8; ++i) {
        const f32x4 gg = *(const f32x4*)(g + i * 256 + lane * 4);
        u32x2 w; w.x = cvt_pk_bf16(v[i][0] * rs * gg[0], v[i][1] * rs * gg[1]); w.y = cvt_pk_bf16(v[i][2] * rs * gg[2], v[i][3] * rs * gg[3]);
        st8(dst + i * 256 + lane * 4, w);
    }
}

DEV void phase0(const P& p) {
    const int lane = tidf() & 63, gw = blockIdx.x * 4 + (tidf() >> 6), NGW = gridDim.x * 4;
    unsigned char* ws = p.ws;
    constexpr int I_IN = 32 * 122, I_QB = 8 * 48, I_KVB = 4 * 64;
    constexpr int NITEMS = I_IN + I_QB + I_KVB;
    for (int it = gw; it < NITEMS; it += NGW) {
        int r = it;
        if (r < I_IN) { const int kt = r / 122, nt = r % 122;
            transpose_item(p.w_in, 3904, (bf16_t*)(ws + WS_WIN), D, kt * 64, nt * 32, lane, [](int) { return 1.0f; },
                [](int n) { return n < 768 ? n : (n < 832 ? 3840 + rope_perm64(n - 768) : n - 64); }); continue; }
        r -= I_IN;
        if (r < I_QB) { const int kt = r / 48, nt = r % 48; const float* g = p.norm_q_lat;
            transpose_item(p.w_q_b, 1536, (bf16_t*)(ws + WS_WQB), 512, kt * 64, nt * 32, lane, [g](int k) { return g[k]; },
                [](int n) { const int h = n / 192, d = n % 192; return h * 192 + (d < 128 ? d : 128 + rope_perm64(d - 128)); }); continue; }
        r -= I_QB;
        { const int kt = r / 64, nt = r % 64; const float* g = p.norm_kv_lat;
            transpose_item(p.w_kv_b, 2048, (bf16_t*)(ws + WS_WKVB), 256, kt * 64, nt * 32, lane, [g](int k) { return g[k]; }, [](int n) { return n; }); }
    }
    {
        float* rt = (float*)(ws + WS_ROPE);
        for (int i = blockIdx.x * NTHREADS + tidf(); i < T * 32; i += gridDim.x * NTHREADS) {
            const int t = i >> 5, f = i & 31;
            const float inv_freq = exp2f(-(float)f * (13.287712379549449f / 32.0f));
            const float ang = (float)p.pos[t] * inv_freq;
            const double turns = (double)ang * 0.15915494309189535;
            const float fr = (float)(turns - floor(turns));
            rt[2 * i] = __builtin_amdgcn_cosf(fr); rt[2 * i + 1] = __builtin_amdgcn_sinf(fr);
        }
    }
    for (int row = gw; row < T; row += NGW) rms_row_to_bf16(p.x + (size_t)row * D, p.norm_mix, (bf16_t*)(ws + WS_H) + (size_t)row * D, lane);
}
DEV void late_convert(const P& p, int gw, int ngw, int lane) {
    unsigned char* ws = p.ws;
    constexpr int I_OUT = 32 * 64, I_MQ = 32 * 16, I_MKV = 32 * 32, I_MO = 8 * 64, I_WR = 48 * 2048 / 256, I_MEM = MT;
    constexpr int NITEMS = I_OUT + I_MQ + I_MKV + I_MO + I_WR + I_MEM;
    for (int it = gw; it < NITEMS; it += ngw) {
        int r = it;
        if (r < I_OUT) { const int kt = r / 64, nt = r % 64; const float* g1 = p.norm_mla_out; const float* g2 = p.norm_sb_out;
            transpose_item(p.w_out, 2048, (bf16_t*)(ws + WS_WOUT), 2048, kt * 64, nt * 32, lane, [g1, g2](int k) { return k < 1024 ? g1[k] : g2[k - 1024]; }, [](int n) { return n; }); continue; }
        r -= I_OUT;
        if (r < I_MQ) { const int kt = r / 16, nt = r % 16; const float* g = p.norm_mem_x;
            transpose_item(p.w_mem_q, 512, (bf16_t*)(ws + WS_WMQ), 2048, kt * 64, nt * 32, lane, [g](int k) { return g[k]; }, [](int n) { return n; }); continue; }
        r -= I_MQ;
        if (r < I_MKV) { const int kt = r / 32, nt = r % 32;
            transpose_item(p.w_mem_kv, 1024, (bf16_t*)(ws + WS_WMKV), 2048, kt * 64, nt * 32, lane, [](int) { return 1.0f; }, [](int n) { return n; }); continue; }
        r -= I_MKV;
        if (r < I_MO) { const int kt = r / 64, nt = r % 64;
            transpose_item(p.w_mem_o, 2048, (bf16_t*)(ws + WS_WMO), 512, kt * 64, nt * 32, lane, [](int) { return 1.0f; }, [](int n) { return n; }); continue; }
        r -= I_MO;
        if (r < I_WR) {
            bf16_t* wrh = (bf16_t*)(ws + WS_WR); bf16_t* wrl = wrh + 48 * 2048;
#pragma unroll
            for (int q = 0; q < 4; ++q) { const int i = r * 256 + q * 64 + lane, n = i >> 11, k = i & 2047;
                float v = 0.f;
                if (n < 4) v = p.w_group[k * 4 + n] * p.norm_ffn[k]; else if (n < 36) v = p.w_er[k * 32 + (n - 4)] * p.norm_ffn[k];
                const unsigned hi = cvt_pk_bf16(v, 0.f) & 0xffffu; const float lo = v - __uint_as_float(hi << 16);
                wrh[i] = (bf16_t)hi; wrl[i] = (bf16_t)(cvt_pk_bf16(lo, 0.f) & 0xffffu); }
            continue; }
        r -= I_WR;
        rms_row_to_bf16(p.mem + (size_t)r * D, p.norm_mem_src, (bf16_t*)(ws + WS_MEMN) + (size_t)r * D, lane);
    }
}


DEV void st_bf16x16(bf16_t* dst, const f32x4& v0, const f32x4& v1, const f32x4& v2, const f32x4& v3) {
    u32x4 a, b;
    a.x = cvt_pk_bf16(v0[0], v0[1]); a.y = cvt_pk_bf16(v0[2], v0[3]); a.z = cvt_pk_bf16(v1[0], v1[1]); a.w = cvt_pk_bf16(v1[2], v1[3]);
    b.x = cvt_pk_bf16(v2[0], v2[1]); b.y = cvt_pk_bf16(v2[2], v2[3]); b.z = cvt_pk_bf16(v3[0], v3[1]); b.w = cvt_pk_bf16(v3[2], v3[3]);
    *(u32x4*)dst = a; *(u32x4*)(dst + 8) = b;
}
DEV void store_rowmajor_sq(const f32x4 (&acc)[4][4], bf16_t* dst, int ldd, int m0, int ncol0, u64* sq, float scale) {
    const int lane = tidf() & 63, wid = tidf() >> 6, wr = wid >> 1, wc = wid & 1, fr = lane & 15, fq = lane >> 4;
#pragma unroll
    for (int j = 0; j < 4; ++j) {
        const int m = m0 + wr * 64 + j * 16 + fr; float ss = 0.f;
#pragma unroll
        for (int i = 0; i < 4; ++i) { const f32x4 v = acc[i][j]; ss += v[0] * v[0] + v[1] * v[1] + v[2] * v[2] + v[3] * v[3]; }
        st_bf16x16(dst + (size_t)m * ldd + ncol0 + wc * 64 + fq * 16, acc[0][j] * scale, acc[1][j] * scale, acc[2][j] * scale, acc[3][j] * scale);
        if (sq) { ss += __shfl_xor(ss, 16); ss += __shfl_xor(ss, 32); if (fq == 0) sq_add(sq, m, ss); }
    }
}
DEV void store_transposed(const f32x4 (&acc)[4][4], bf16_t* dst, int L, int s0, const u64* sq, int sqrow0, float inv_n) {
    const int lane = tidf() & 63, wid = tidf() >> 6, wr = wid >> 1, wc = wid & 1, fr = lane & 15, fq = lane >> 4;
    const int ml = wr * 64 + fq * 16;
    f32x4 sc[4];
#pragma unroll
    for (int i = 0; i < 4; ++i)
#pragma unroll
        for (int r = 0; r < 4; ++r) sc[i][r] = sq ? sq_rs(sq, sqrow0 + ml + 4 * i + r, inv_n) : 1.0f;
#pragma unroll
    for (int j = 0; j < 4; ++j) {
        const int n = wc * 64 + j * 16 + fr;
        st_bf16x16(dst + (size_t)n * L + s0 + ml, acc[0][j] * sc[0], acc[2][j] * sc[2], acc[1][j] * sc[1], acc[3][j] * sc[3]);
    }
}

DEV void phase1(const P& p, unsigned char* lds, bool dry = false) {
    unsigned char* ws = p.ws;
    const XcdIter xi = xcd_iter();
    const int lane = tidf() & 63, wid = tidf() >> 6, wr = wid >> 1, wc = wid & 1, fr = lane & 15, fq = lane >> 4;
    u64* sqb = (u64*)(ws + CTL_SQ);
    u64* sq_cq = dry ? nullptr : sqb + SQ_CQ * T; u64* sq_ckv = dry ? nullptr : sqb + SQ_CKV * T;
    const int per_x = 8 * 31, total = 64 * 31;
    auto tile_at = [&](int it, int& mt, int& nt) -> bool {
        if (xi.x >= 0) { const int i = it * xi.per + xi.j; if (i >= per_x) return false; mt = xi.x * 8 + (i & 7); nt = i >> 3; }
        else { const int i = it * xi.per + xi.j; if (i >= total) return false; mt = i & 63; nt = i >> 6; }
        return true; };
    GemmPipe gp{0, false};
    int mt, nt; bool have = tile_at(0, mt, nt);
    if (!have) return;
    GT cur = gt_dense((const bf16_t*)(ws + WS_H), D, mt * 128, (const bf16_t*)(ws + WS_WIN), D, nt * 128, 0, !(nt >= 22 && nt < 30));
    for (int it = 0; have; ++it) {
        int mtn, ntn; const bool hn = tile_at(it + 1, mtn, ntn);
        GT nx = cur; if (hn) nx = gt_dense((const bf16_t*)(ws + WS_H), D, mtn * 128, (const bf16_t*)(ws + WS_WIN), D, ntn * 128, 0, !(ntn >= 22 && ntn < 30));
        f32x4 acc[4][4]; acc_zero(acc);
        const bool isv = (nt >= 22 && nt < 30);
        gemm_run(acc, lds, cur, 32, !isv, gp, nx, hn);
        const int m0 = mt * 128, b = m0 >> 12, s0 = m0 & 4095;
        if (nt < 4) store_rowmajor_sq(acc, (bf16_t*)(ws + WS_CQ), 512, m0, nt * 128, sq_cq, 1.0f);
        else if (nt < 6) store_rowmajor_sq(acc, (bf16_t*)(ws + WS_CKV), 256, m0, (nt - 4) * 128, sq_ckv, 1.0f);
        else if (nt < 14) store_rowmajor_sq(acc, (bf16_t*)(ws + WS_QSB) + (size_t)((b * 8 + (nt - 6)) * S) * 128, 128, s0, 0, nullptr, 0.08838834764831845f * LOG2E);
        else if (nt < 22) store_rowmajor_sq(acc, (bf16_t*)(ws + WS_KSB) + (size_t)((b * 8 + (nt - 14)) * S) * 128, 128, s0, 0, nullptr, 1.0f);
        else if (nt < 30) store_transposed(acc, (bf16_t*)(ws + WS_VSBT) + (size_t)((b * 8 + (nt - 22)) * 128) * S, S, s0, nullptr, 0, 0.f);
        else if (wc == 0) {
            const float* rt = (const float*)(ws + WS_ROPE);
            bf16_t* kpe = (bf16_t*)(ws + WS_KPE);
#pragma unroll
            for (int j = 0; j < 4; ++j) {
                const int m = m0 + wr * 64 + j * 16 + fr;
#pragma unroll
                for (int i = 0; i < 4; ++i) {
                    const int n = fq * 16 + i * 4; const f32x4 v = acc[i][j];
                    const f32x4 cs = *(const f32x4*)(rt + ((size_t)m * 32 + (n >> 1)) * 2);
                    u32x2 w; w.x = cvt_pk_bf16(v[0] * cs[0] - v[1] * cs[1], v[1] * cs[0] + v[0] * cs[1]);
                    w.y = cvt_pk_bf16(v[2] * cs[2] - v[3] * cs[3], v[3] * cs[2] + v[2] * cs[3]);
                    st8(kpe + (size_t)m * 64 + n, w);
                }
            }
        }
        cur = nx; mt = mtn; nt = ntn; have = hn;
    }
}


template <int ABL>
DEV void phase1_dry(const P& p, unsigned char* lds) {
    unsigned char* ws = p.ws;
    const XcdIter xi = xcd_iter();
    const int per_x = 8 * 31, total = 64 * 31;
    for (int it = 0;; ++it) {
        int mt, nt;
        if (xi.x >= 0) { const int i = it * xi.per + xi.j; if (i >= per_x) break; mt = xi.x * 8 + (i & 7); nt = i >> 3; }
        else { const int i = it * xi.per + xi.j; if (i >= total) break; mt = i & 63; nt = i >> 6; }
        f32x4 acc[4][4]; acc_zero(acc);
        gemm_dense<ABL>(acc, lds, (const bf16_t*)(ws + WS_H), D, mt * 128, (const bf16_t*)(ws + WS_WIN), D, nt * 128, 0, 32, true);
#pragma unroll
        for (int i = 0; i < 4; ++i)
#pragma unroll
            for (int j = 0; j < 4; ++j) asm volatile("" :: "v"(acc[i][j]));
    }
}
DEV void phase2(const P& p, unsigned char* lds) {
    unsigned char* ws = p.ws;
    const XcdIter xi = xcd_iter();
    const int lane = tidf() & 63, wid = tidf() >> 6, wr = wid >> 1, wc = wid & 1, fr = lane & 15, fq = lane >> 4;
    const u64* sqb = (const u64*)(ws + CTL_SQ);
    const int per_x = 8 * 28, total = 64 * 28;
    auto tile_at = [&](int it, int& mt, int& nt) -> bool {
        if (xi.x >= 0) { const int i = it * xi.per + xi.j; if (i >= per_x) return false; mt = xi.x * 8 + (i & 7); nt = i >> 3; }
        else { const int i = it * xi.per + xi.j; if (i >= total) return false; mt = i & 63; nt = i >> 6; }
        return true; };
    auto desc = [&](int mt, int nt) -> GT {
        return nt < 12 ? gt_dense((const bf16_t*)(ws + WS_CQ), 512, mt * 128, (const bf16_t*)(ws + WS_WQB), 512, nt * 128, 0, true)
                       : gt_dense((const bf16_t*)(ws + WS_CKV), 256, mt * 128, (const bf16_t*)(ws + WS_WKVB), 256, (nt - 12) * 128, 0, ((nt - 12) & 1) == 0); };
    GemmPipe gp{0, false};
    int mt, nt; bool have = tile_at(0, mt, nt);
    if (!have) return;
    GT cur = desc(mt, nt);
    for (int it = 0; have; ++it) {
        int mtn, ntn; const bool hn = tile_at(it + 1, mtn, ntn);
        GT nx = cur; if (hn) nx = desc(mtn, ntn);
        const int m0 = mt * 128, b = m0 >> 12, s0 = m0 & 4095;
        f32x4 acc[4][4]; acc_zero(acc);
        if (nt < 12) {
            gemm_run(acc, lds, cur, 8, true, gp, nx, hn);
            const float* rt = (const float*)(ws + WS_ROPE);
            bf16_t* qm = (bf16_t*)(ws + WS_QM);
            const float qs = 0.07216878364870322f * LOG2E;
#pragma unroll
            for (int j = 0; j < 4; ++j) {
                const int m = m0 + wr * 64 + j * 16 + fr, s = s0 + wr * 64 + j * 16 + fr;
                const float rs = sq_rs(sqb + SQ_CQ * T, m, 1.0f / 512.0f) * qs;
                const int n0 = nt * 128 + wc * 64 + fq * 16, h = n0 / 192, d0 = n0 - h * 192;
                f32x4 vq[4];
#pragma unroll
                for (int i = 0; i < 4; ++i) {
                    const int d = d0 + i * 4;
                    f32x4 v = acc[i][j] * rs;
                    if (d >= 128) {
                        const f32x4 cs = *(const f32x4*)(rt + ((size_t)m * 32 + ((d - 128) >> 1)) * 2);
                        v = (f32x4){v[0] * cs[0] - v[1] * cs[1], v[1] * cs[0] + v[0] * cs[1], v[2] * cs[2] - v[3] * cs[3], v[3] * cs[2] + v[2] * cs[3]};
                    }
                    vq[i] = v;
                }
                st_bf16x16(qm + ((size_t)(b * 8 + h) * S + s) * 192 + d0, vq[0], vq[1], vq[2], vq[3]);
            }
        } else {
            const int nk = nt - 12, h = nk >> 1; const bool isv = nk & 1;
            gemm_run(acc, lds, cur, 4, !isv, gp, nx, hn);
            if (!isv) {
                bf16_t* kn = (bf16_t*)(ws + WS_KN) + (size_t)((b * 8 + h) * S) * 128;
#pragma unroll
                for (int j = 0; j < 4; ++j) {
                    const int ml = wr * 64 + j * 16 + fr;
                    const float rs = sq_rs(sqb + SQ_CKV * T, m0 + ml, 1.0f / 256.0f);
                    st_bf16x16(kn + (size_t)(s0 + ml) * 128 + wc * 64 + fq * 16, acc[0][j] * rs, acc[1][j] * rs, acc[2][j] * rs, acc[3][j] * rs);
                }
            } else {
                store_transposed(acc, (bf16_t*)(ws + WS_VMT) + (size_t)((b * 8 + h) * 128) * S, S, s0, sqb + SQ_CKV * T, m0, 1.0f / 256.0f);
            }
        }
        cur = nx; mt = mtn; nt = ntn; have = hn;
    }
}

template <int DQK> struct KStage {
    static constexpr int NIG = DQK / 64;
    u32x4 r[2][NIG];
    const bf16_t* gm; const bf16_t* gp; int l0, l1;
    DEV void init(const bf16_t* Kmain, const bf16_t* Kpe, int t) {
        const int row = t >> 3, c = t & 7;
        gm = Kmain + (size_t)row * 128 + c * 8; gp = (DQK == 192) ? Kpe + (size_t)row * 64 + c * 8 : nullptr;
        if (DQK == 128) { const int lo = row * 256 + ((c ^ (row & 7)) << 4), b3 = (row >> 3) & 1; l0 = lo + (b3 ? 128 : 0); l1 = lo + (b3 ? 0 : 128); }
        else { l0 = row * 384 + ((c ^ ((row >> 1) & 7)) << 4); l1 = l0 + 128; }
    }
    DEV void load(int tile) {
#pragma unroll
        for (int ps = 0; ps < 2; ++ps) {
            const bf16_t* g = gm + ((size_t)tile * 64 + ps * 32) * 128;
            r[ps][0] = *(const u32x4*)g; r[ps][1] = *(const u32x4*)(g + 64);
            if (DQK == 192) r[ps][NIG - 1] = *(const u32x4*)(gp + ((size_t)tile * 64 + ps * 32) * 64);
        }
    }
    DEV void write(unsigned char* ldsK) {
#pragma unroll
        for (int ps = 0; ps < 2; ++ps) {
            *(u32x4*)(ldsK + l0 + ps * 32 * DQK * 2) = r[ps][0]; *(u32x4*)(ldsK + l1 + ps * 32 * DQK * 2) = r[ps][1];
            if (DQK == 192) *(u32x4*)(ldsK + l0 + 256 + ps * 32 * DQK * 2) = r[ps][NIG - 1];
        }
    }
};
struct VStage {
    u32x4 r[4]; const bf16_t* g; int l; size_t rstride;
    DEV void init(const bf16_t* VT, int LV, int t) { const int row = t >> 3, c = t & 7; g = VT + (size_t)row * LV + c * 8; rstride = (size_t)32 * LV; l = row * 128 + ((c ^ ((row >> 1) & 7)) << 4); }
    DEV void load(int tile) {
#pragma unroll
        for (int i = 0; i < 4; ++i) r[i] = *(const u32x4*)(g + i * rstride + (size_t)tile * 64);
    }
    DEV void write(unsigned char* ldsV) {
#pragma unroll
        for (int i = 0; i < 4; ++i) *(u32x4*)(ldsV + l + i * 4096) = r[i];
    }
};
template <int DQK> DEV int kfrag_off(int krow, int ks, int hh) {
    const int c = 2 * ks + hh;
    if (DQK == 128) return krow * 256 + ((c ^ (krow & 15)) << 4);
    else return krow * 384 + ((((c & ~7) | ((c & 7) ^ ((krow >> 1) & 7)))) << 4);
}
DEV int vfrag_off(int r, int c) { return r * 128 + ((c ^ ((r >> 1) & 7)) << 4); }

template <int DQK, bool CAUSAL, int ABL = 0>
DEV void attn_unit(unsigned char* lds, const bf16_t* Q, const bf16_t* Kmain, const bf16_t* Kpe, const bf16_t* VT, int LV, int q0, int ntiles,
                   bf16_t* O, int ldo, u64* sq  , int orow0) {
    constexpr int NKS = DQK / 16, KTILE_BYTES = 64 * DQK * 2;
    const int tid = tidf();
    const int lane = tid & 63, wid = tid >> 6, pr = wid >> 1, kh = wid & 1, l31 = lane & 31, hh = lane >> 5;
    unsigned char* ldsK = lds; unsigned char* ldsV = lds + KTILE_BYTES;
    bf16x8 qf[NKS];
    { const bf16_t* qp = Q + (size_t)(q0 + pr * 32 + l31) * DQK + hh * 8;
#pragma unroll
      for (int ks = 0; ks < NKS; ++ks) qf[ks] = *(const bf16x8*)(qp + ks * 16); }
    f32x16 oacc[4];
#pragma unroll
    for (int i = 0; i < 4; ++i)
#pragma unroll
        for (int r = 0; r < 16; ++r) oacc[i][r] = 0.f;
    float mrun = -1e30f, lrun = 0.f;
    KStage<DQK> ksg; VStage vsg;
    ksg.init(Kmain, Kpe, tid); vsg.init(VT, LV, tid);
    const int krow = kh * 32 + l31;
    int ka[DQK == 128 ? 8 : 4];
#pragma unroll
    for (int i = 0; i < (DQK == 128 ? 8 : 4); ++i) ka[i] = kfrag_off<DQK>(krow, i, hh);
    const int va0 = vfrag_off(l31, kh * 4 + hh), va1 = vfrag_off(l31, kh * 4 + 2 + hh);
    if (ABL != 1) { ksg.load(0); vsg.load(0); ksg.write(ldsK); vsg.write(ldsV); } __syncthreads();
    const int qpos = q0 + pr * 32 + l31;
    for (int t = 0; t < ntiles; ++t) {
        const bool more = t + 1 < ntiles;
        if (more && ABL != 1) { ksg.load(t + 1); vsg.load(t + 1); }
        __builtin_amdgcn_sched_barrier(0);
        const bool diag = CAUSAL && (t == ntiles - 1);
        if (!(diag && pr == 0 && kh == 1)) {
            f32x16 sacc;
#pragma unroll
            for (int r = 0; r < 16; ++r) sacc[r] = 0.f;
            __builtin_amdgcn_s_setprio(1);
#pragma unroll
            for (int ks = 0; ks < NKS; ++ks) {
                const int off = (DQK == 128) ? ka[ks] : (ka[ks & 3] + 128 * (ks >> 2));
                const bf16x8 kf = *(const bf16x8*)(ldsK + off);
                if (ABL == 2) { asm volatile("" :: "v"(kf)); sacc[ks & 15] += 1.0f; } else sacc = __builtin_amdgcn_mfma_f32_32x32x16_bf16(kf, qf[ks], sacc, 0, 0, 0);
            }
            __builtin_amdgcn_s_setprio(0);
            if (diag) {
                const int kbase = t * 64 + kh * 32 + 4 * hh;
#pragma unroll
                for (int r = 0; r < 16; ++r) { const int kp = kbase + (r & 3) + 8 * (r >> 2); if (kp > qpos) sacc[r] = -1e30f; }
            }
            if (ABL != 3) {
            float mx = sacc[0];
#pragma unroll
            for (int r = 1; r < 16; ++r) mx = fmaxf(mx, sacc[r]);
            mx = fmaxf(mx, __shfl_xor(mx, 32));
            const float mnew = fmaxf(mrun, mx), alpha = fexp2(mrun - mnew);
            mrun = mnew;
            float ps = 0.f;
#pragma unroll
            for (int r = 0; r < 16; ++r) { sacc[r] = fexp2(sacc[r] - mnew); ps += sacc[r]; }
            lrun = lrun * alpha + ps;
#pragma unroll
            for (int i = 0; i < 4; ++i)
#pragma unroll
                for (int r = 0; r < 16; ++r) oacc[i][r] *= alpha;
            }
            __builtin_amdgcn_s_setprio(1);
#pragma unroll
            for (int s2 = 0; s2 < 2; ++s2) {
                u32x4 pw; pw.x = cvt_pk_bf16(sacc[8 * s2 + 0], sacc[8 * s2 + 1]); pw.y = cvt_pk_bf16(sacc[8 * s2 + 2], sacc[8 * s2 + 3]);
                pw.z = cvt_pk_bf16(sacc[8 * s2 + 4], sacc[8 * s2 + 5]); pw.w = cvt_pk_bf16(sacc[8 * s2 + 6], sacc[8 * s2 + 7]);
                bf16x8 pf; __builtin_memcpy(&pf, &pw, 16);
#pragma unroll
                for (int dvb = 0; dvb < 4; ++dvb) {
                    const bf16x8 vf = *(const bf16x8*)(ldsV + (s2 ? va1 : va0) + dvb * 4096);
                    if (ABL == 2) { asm volatile("" :: "v"(vf), "v"(pf)); oacc[dvb][s2] += 1.0f; } else oacc[dvb] = __builtin_amdgcn_mfma_f32_32x32x16_bf16(vf, pf, oacc[dvb], 0, 0, 0);
                }
            }
            __builtin_amdgcn_s_setprio(0);
        }
        __syncthreads();
        if (more && ABL != 1) { ksg.write(ldsK); vsg.write(ldsV); }
        __syncthreads();
    }
    float lw = lrun + __shfl_xor(lrun, 32);
    float* xo = (float*)(lds + pr * 20480);
    if (kh == 1) {
#pragma unroll
        for (int i = 0; i < 4; ++i)
#pragma unroll
            for (int r = 0; r < 16; ++r) xo[(i * 16 + r) * 64 + lane] = oacc[i][r];
        xo[4096 + lane] = mrun; xo[4096 + 64 + lane] = lw;
    }
    __syncthreads();
    if (kh == 0 && O != nullptr) {
        const float m1 = xo[4096 + lane], l1 = xo[4096 + 64 + lane];
        const float m = fmaxf(mrun, m1), f0 = fexp2(mrun - m), f1 = fexp2(m1 - m);
        const float inv = 1.0f / (lw * f0 + l1 * f1);
        const float c0 = f0 * inv, c1 = f1 * inv;
        float ss = 0.f;
        bf16_t* op = O + (size_t)(orow0 + pr * 32 + l31) * ldo;
#pragma unroll
        for (int i = 0; i < 4; ++i)
#pragma unroll
            for (int rq = 0; rq < 4; ++rq) {
                float v[4];
#pragma unroll
                for (int e = 0; e < 4; ++e) { const int r = rq * 4 + e; v[e] = oacc[i][r] * c0 + xo[(i * 16 + r) * 64 + lane] * c1; ss += v[e] * v[e]; }
                u32x2 w; w.x = cvt_pk_bf16(v[0], v[1]); w.y = cvt_pk_bf16(v[2], v[3]);
                st8(op + i * 32 + 8 * rq + 4 * hh, w);
            }
        if (sq) { ss += __shfl_xor(ss, 32); if (hh == 0) sq_add(sq, orow0 + pr * 32 + l31, ss); }
    }
    if (O == nullptr) { _Pragma("unroll") for (int i = 0; i < 4; ++i) asm volatile("" :: "v"(oacc[i])); asm volatile("" :: "v"(lrun), "v"(mrun)); }
    __syncthreads();
}

DEV void sb_unit(unsigned char* lds, const bf16_t* Q, const bf16_t* K, const bf16_t* VT, int U, bf16_t* O  , u64* sq, int tok0) {
    constexpr int KTILE_BYTES = 64 * 128 * 2;
    const int tid = tidf();
    const int lane = tid & 63, wid = tid >> 6, l31 = lane & 31, hh = lane >> 5;
    unsigned char* ldsK = lds; unsigned char* ldsV = lds + KTILE_BYTES;
    volatile int* flags = (volatile int*)(lds + LDS_MAIN + 64);
    const int q0 = U * 128 + wid * 32, qpos = q0 + l31;
    bf16x8 qf[8];
    { const bf16_t* qp = Q + (size_t)qpos * 128 + hh * 8;
#pragma unroll
      for (int ks = 0; ks < 8; ++ks) qf[ks] = *(const bf16x8*)(qp + ks * 16); }
    f32x16 oacc[4];
#pragma unroll
    for (int i = 0; i < 4; ++i)
#pragma unroll
        for (int r = 0; r < 16; ++r) oacc[i][r] = 0.f;
    float R = 0.f;
    KStage<128> ksg; VStage vsg;
    ksg.init(K, nullptr, tid); vsg.init(VT, S, tid);
    int ka[8];
#pragma unroll
    for (int i = 0; i < 8; ++i) ka[i] = kfrag_off<128>(l31, i, hh);
    const int va[4] = {vfrag_off(l31, hh), vfrag_off(l31, 2 + hh), vfrag_off(l31, 4 + hh), vfrag_off(l31, 6 + hh)};
    int t = 2 * U + 1;
    ksg.load(t); vsg.load(t); ksg.write(ldsK); vsg.write(ldsV); __syncthreads();
    for (; t >= 0; --t) {
        const bool more = t > 0;
        if (more) { ksg.load(t - 1); vsg.load(t - 1); }
        __builtin_amdgcn_sched_barrier(0);
        const int kt0 = t * 64;
        if (kt0 < q0 + 31) {
            const bool need_mask = (kt0 + 63 >= q0);
#pragma unroll
            for (int kb = 1; kb >= 0; --kb) {
                f32x16 z;
#pragma unroll
                for (int r = 0; r < 16; ++r) z[r] = 0.f;
#pragma unroll
                for (int ks = 0; ks < 8; ++ks) {
                    const bf16x8 kf = *(const bf16x8*)(ldsK + ka[ks] + kb * 8192);
                    z = __builtin_amdgcn_mfma_f32_32x32x16_bf16(kf, qf[ks], z, 0, 0, 0);
                }
                float l1m[16];
#pragma unroll
                for (int r = 0; r < 16; ++r) {
                    const float zz = z[r];
                    const float sp = fmaxf(zz, 0.f) + flog2(1.0f + fexp2(-fabsf(zz)));
                    const int kp = kt0 + kb * 32 + (r & 3) + 8 * (r >> 2) + 4 * hh;
                    const bool ok = !need_mask || (kp < qpos);
                    l1m[r] = ok ? -sp : 0.f;
                    z[r] = ok ? zz : -1e30f;
                }
                float gs[4], pgs[4];
#pragma unroll
                for (int g = 0; g < 4; ++g) { gs[g] = (l1m[4 * g] + l1m[4 * g + 1]) + (l1m[4 * g + 2] + l1m[4 * g + 3]); pgs[g] = __shfl_xor(gs[g], 32); }
                float tail = 0.f;
#pragma unroll
                for (int g = 3; g >= 0; --g) {
                    const float sg = R + tail + (hh == 0 ? pgs[g] : 0.f);
                    const float e2 = l1m[4 * g + 3], e1 = e2 + l1m[4 * g + 2], e0 = e1 + l1m[4 * g + 1];
                    z[4 * g + 3] = fexp2(z[4 * g + 3] + l1m[4 * g + 3] + sg);
                    z[4 * g + 2] = fexp2(z[4 * g + 2] + l1m[4 * g + 2] + sg + e2);
                    z[4 * g + 1] = fexp2(z[4 * g + 1] + l1m[4 * g + 1] + sg + e1);
                    z[4 * g + 0] = fexp2(z[4 * g + 0] + l1m[4 * g + 0] + sg + e0);
                    tail += gs[g] + pgs[g];
                }
                R += tail;
#pragma unroll
                for (int s2 = 0; s2 < 2; ++s2) {
                    u32x4 pw; pw.x = cvt_pk_bf16(z[8 * s2 + 0], z[8 * s2 + 1]); pw.y = cvt_pk_bf16(z[8 * s2 + 2], z[8 * s2 + 3]);
                    pw.z = cvt_pk_bf16(z[8 * s2 + 4], z[8 * s2 + 5]); pw.w = cvt_pk_bf16(z[8 * s2 + 6], z[8 * s2 + 7]);
                    bf16x8 pf; __builtin_memcpy(&pf, &pw, 16);
#pragma unroll
                    for (int dvb = 0; dvb < 4; ++dvb) {
                        const bf16x8 vf = *(const bf16x8*)(ldsV + va[kb * 2 + s2] + dvb * 4096);
                        oacc[dvb] = __builtin_amdgcn_mfma_f32_32x32x16_bf16(vf, pf, oacc[dvb], 0, 0, 0);
                    }
                }
            }
        }
        const bool wdone = __all(R < -160.0f);
        if (lane == 0) flags[wid] = wdone ? 1 : 0;
        __syncthreads();
        const bool alldone = (flags[0] & flags[1] & flags[2] & flags[3]) != 0;
        if (alldone || !more) break;
        ksg.write(ldsK); vsg.write(ldsV);
        __syncthreads();
    }
    __syncthreads();
    float ss = 0.f;
    bf16_t* op = O + (size_t)qpos * 2048;
#pragma unroll
    for (int i = 0; i < 4; ++i)
#pragma unroll
        for (int rq = 0; rq < 4; ++rq) {
            const float v0 = oacc[i][rq * 4], v1 = oacc[i][rq * 4 + 1], v2 = oacc[i][rq * 4 + 2], v3 = oacc[i][rq * 4 + 3];
            ss += v0 * v0 + v1 * v1 + v2 * v2 + v3 * v3;
            u32x2 w; w.x = cvt_pk_bf16(v0, v1); w.y = cvt_pk_bf16(v2, v3);
            st8(op + i * 32 + 8 * rq + 4 * hh, w);
        }
    ss += __shfl_xor(ss, 32); if (sq && hh == 0) sq_add(sq, tok0 + qpos, ss);
}


template <class RowF>
DEV void transpose_item8(const float* src, int N, u8* dst, int ldd, int k0, int n0, int lane, RowF dstrow) {
    const int ln = lane & 7, lk = lane >> 3, k = k0 + lk * 16, n = n0 + ln * 4;
    f32x4 v[16];
#pragma unroll
    for (int kk = 0; kk < 16; ++kk) v[kk] = *(const f32x4*)(src + (size_t)(k + kk) * N + n) * W8_SCALE;
#pragma unroll
    for (int j = 0; j < 4; ++j) {
        u32x4 w; w.x = pack_fp8x4(v[0][j], v[1][j], v[2][j], v[3][j]); w.y = pack_fp8x4(v[4][j], v[5][j], v[6][j], v[7][j]);
        w.z = pack_fp8x4(v[8][j], v[9][j], v[10][j], v[11][j]); w.w = pack_fp8x4(v[12][j], v[13][j], v[14][j], v[15][j]);
        st16u(dst + (size_t)dstrow(n + j) * ldd + k, w);
    }
}
DEV void moe_convert_range(const P& p, int first, int step, int end, int lane) {
    unsigned char* ws = p.ws;
    constexpr int I_G = 16 * 16, I_E = 2 * I_G;
    for (int it = first; it < end; it += step) {
        const int e = it / I_E; int r = it - e * I_E;
        u8* gu = (u8*)(ws + WS_WGU) + (size_t)e * 1024 * 2048;
        const int up = r >= I_G; if (up) r -= I_G; const int kt = r / 16, nt = r % 16;
        const float* src = (up ? p.w_up : p.w_gate) + (size_t)e * 2048 * 512;
        transpose_item8(src, 512, gu, 2048, kt * 128, nt * 32, lane,
            [up](int c) { const int t = c >> 6, rr = c & 63, wc = rr >> 5, r32 = rr & 31, fq = r32 >> 3, q = (r32 >> 2) & 1, rg = r32 & 3; return t * 128 + wc * 64 + fq * 16 + (2 * q + up) * 4 + rg; });
    }
}
DEV void moe_convert(const P& p, int gw, int ngw, int lane) {
    unsigned char* ws = p.ws;
    constexpr int I_G = 16 * 16, I_E = 2 * I_G, NITEMS = 32 * I_E;
    for (int it = gw; it < NITEMS; it += ngw) {
        const int e = it / I_E; int r = it - e * I_E;
        u8* gu = (u8*)(ws + WS_WGU) + (size_t)e * 1024 * 2048;
        const int up = r >= I_G; if (up) r -= I_G; const int kt = r / 16, nt = r % 16;
        const float* src = (up ? p.w_up : p.w_gate) + (size_t)e * 2048 * 512;
        transpose_item8(src, 512, gu, 2048, kt * 128, nt * 32, lane,
            [up](int c) { const int t = c >> 6, rr = c & 63, wc = rr >> 5, r32 = rr & 31, fq = r32 >> 3, q = (r32 >> 2) & 1, rg = r32 & 3; return t * 128 + wc * 64 + fq * 16 + (2 * q + up) * 4 + rg; });
    }
}
DEV void moe_convert_down(const P& p, int gw, int ngw, int lane) {
    unsigned char* ws = p.ws;
    constexpr int I_D = 4 * 64, NITEMS = 32 * I_D;
    for (int it = gw; it < NITEMS; it += ngw) {
        const int e = it / I_D, r = it - e * I_D, kt = r / 64, nt = r % 64;
        transpose_item8(p.w_down + (size_t)e * 512 * 2048, 2048, (u8*)(ws + WS_WD) + (size_t)e * 2048 * 512, 512, kt * 128, nt * 32, lane, [](int n) { return n; });
    }
}

DEV void mla_unit128(unsigned char* lds, const bf16_t* Q, const bf16_t* Kmain, const bf16_t* Kpe, const bf16_t* VT, int U, bf16_t* O  , u64* sq  ) {
    constexpr int KTILE_BYTES = 64 * 192 * 2;
    const int tid = tidf();
    const int lane = tid & 63, wid = tid >> 6, l31 = lane & 31, hh = lane >> 5;
    unsigned char* ldsK = lds; unsigned char* ldsV = lds + KTILE_BYTES;
    const int q0 = U * 128 + wid * 32, qpos = q0 + l31;
    bf16x8 qf[12];
    { const bf16_t* qp = Q + (size_t)qpos * 192 + hh * 8;
#pragma unroll
      for (int ks = 0; ks < 12; ++ks) qf[ks] = *(const bf16x8*)(qp + ks * 16); }
    f32x16 oacc[4];
#pragma unroll
    for (int i = 0; i < 4; ++i)
#pragma unroll
        for (int r = 0; r < 16; ++r) oacc[i][r] = 0.f;
    float mrun = -1e30f, lrun = 0.f;
    KStage<192> ksg; VStage vsg;
    ksg.init(Kmain, Kpe, tid); vsg.init(VT, S, tid);
    int ka[4];
#pragma unroll
    for (int i = 0; i < 4; ++i) ka[i] = kfrag_off<192>(l31, i, hh);
    const int va[4] = {vfrag_off(l31, hh), vfrag_off(l31, 2 + hh), vfrag_off(l31, 4 + hh), vfrag_off(l31, 6 + hh)};
    const int ntiles = 2 * U + 2;
    ksg.load(0); vsg.load(0); ksg.write(ldsK); vsg.write(ldsV); __syncthreads();
    for (int t = 0; t < ntiles; ++t) {
        const bool more = t + 1 < ntiles;
        if (more) { ksg.load(t + 1); vsg.load(t + 1); }
        __builtin_amdgcn_sched_barrier(0);
        const int kt0 = t * 64;
#pragma unroll
        for (int kb = 0; kb < 2; ++kb) {
            const int kb0 = kt0 + kb * 32;
            if (kb0 <= q0 + 31) {
                f32x16 sacc;
#pragma unroll
                for (int r = 0; r < 16; ++r) sacc[r] = 0.f;
                __builtin_amdgcn_s_setprio(1);
#pragma unroll
                for (int ks = 0; ks < 12; ++ks) {
                    const bf16x8 kf = *(const bf16x8*)(ldsK + ka[ks & 3] + 128 * (ks >> 2) + kb * 12288);
                    sacc = __builtin_amdgcn_mfma_f32_32x32x16_bf16(kf, qf[ks], sacc, 0, 0, 0);
                }
                __builtin_amdgcn_s_setprio(0);
                if (kb0 + 31 > q0) {
                    const int kbase = kb0 + 4 * hh;
#pragma unroll
                    for (int r = 0; r < 16; ++r) { const int kp = kbase + (r & 3) + 8 * (r >> 2); if (kp > qpos) sacc[r] = -1e30f; }
                }
                float mx = sacc[0];
#pragma unroll
                for (int r = 1; r < 16; ++r) mx = fmaxf(mx, sacc[r]);
                mx = fmaxf(mx, __shfl_xor(mx, 32));
                const float mnew = fmaxf(mrun, mx), alpha = fexp2(mrun - mnew);
                mrun = mnew;
                float ps = 0.f;
#pragma unroll
                for (int r = 0; r < 16; ++r) { sacc[r] = fexp2(sacc[r] - mnew); ps += sacc[r]; }
                lrun = lrun * alpha + ps;
#pragma unroll
                for (int i = 0; i < 4; ++i)
#pragma unroll
                    for (int r = 0; r < 16; ++r) oacc[i][r] *= alpha;
                __builtin_amdgcn_s_setprio(1);
#pragma unroll
                for (int s2 = 0; s2 < 2; ++s2) {
                    u32x4 pw; pw.x = cvt_pk_bf16(sacc[8 * s2 + 0], sacc[8 * s2 + 1]); pw.y = cvt_pk_bf16(sacc[8 * s2 + 2], sacc[8 * s2 + 3]);
                    pw.z = cvt_pk_bf16(sacc[8 * s2 + 4], sacc[8 * s2 + 5]); pw.w = cvt_pk_bf16(sacc[8 * s2 + 6], sacc[8 * s2 + 7]);
                    bf16x8 pf; __builtin_memcpy(&pf, &pw, 16);
#pragma unroll
                    for (int dvb = 0; dvb < 4; ++dvb) {
                        const bf16x8 vf = *(const bf16x8*)(ldsV + va[kb * 2 + s2] + dvb * 4096);
                        oacc[dvb] = __builtin_amdgcn_mfma_f32_32x32x16_bf16(vf, pf, oacc[dvb], 0, 0, 0);
                    }
                }
                __builtin_amdgcn_s_setprio(0);
            }
        }
        __syncthreads();
        if (more) { ksg.write(ldsK); vsg.write(ldsV); }
        __syncthreads();
    }
    const float inv = 1.0f / (lrun + __shfl_xor(lrun, 32));
    float ss = 0.f;
    bf16_t* op = O + (size_t)qpos * 2048;
#pragma unroll
    for (int i = 0; i < 4; ++i)
#pragma unroll
        for (int rq = 0; rq < 4; ++rq) {
            const float v0 = oacc[i][rq * 4] * inv, v1 = oacc[i][rq * 4 + 1] * inv, v2 = oacc[i][rq * 4 + 2] * inv, v3 = oacc[i][rq * 4 + 3] * inv;
            ss += v0 * v0 + v1 * v1 + v2 * v2 + v3 * v3;
            u32x2 w; w.x = cvt_pk_bf16(v0, v1); w.y = cvt_pk_bf16(v2, v3);
            st8(op + i * 32 + 8 * rq + 4 * hh, w);
        }
    ss += __shfl_xor(ss, 32); if (sq && hh == 0) sq_add(sq, qpos, ss);
}
DEV int q_pull(unsigned* q, volatile int* lw) { __syncthreads(); if (threadIdx.x == 0) lw[0] = (int)atomicAdd(q, 1u); __syncthreads(); return lw[0]; }
DEV void phase3(const P& p, unsigned char* lds, bool dry = false) {
    unsigned char* ws = p.ws;
    u64* sqb = (u64*)(ws + CTL_SQ);
    bf16_t* omix = (bf16_t*)(ws + WS_OMIX);
    const int G = gridDim.x;
    volatile int* rolew = (volatile int*)(lds + LDS_MAIN + 128);
    if (threadIdx.x == 0) {
        const unsigned hw = (unsigned)__builtin_amdgcn_s_getreg(((8 - 1) << 11) | (8 << 6) | 4);
        const unsigned slot = atomicAdd((unsigned*)(ws + CTL_CU) + (xb_xcc_id() & 7u) * 256u + (hw & 255u), 1u);
        rolew[0] = (int)(slot & 1u);
    }
    __syncthreads();
    const bool conv_first = rolew[0] != 0;
    const int cgw = (int)blockIdx.x * 4 + (tidf() >> 6), cngw = G * 4;
    late_convert(p, cgw, cngw, tidf() & 63);
    unsigned* qh = (unsigned*)(ws + CTL_CNT + 8192);
    volatile int* lw = rolew + 1;
    const int nlab = ((G & 7) == 0) ? 8 : 1, lab = (nlab == 8) ? (int)(blockIdx.x & 7) : 0;
    const int mla_per = 256 / nlab, sb_per = 512 / nlab;
    auto run_mla = [&]() {
#pragma unroll 1
        for (int dl = 0; dl < nlab; ++dl) { const int l = (lab + dl) % nlab;
#pragma unroll 1
            for (;;) { const int i = q_pull(qh + 64 * l, lw); if (i >= mla_per) break;
                const int g = l * mla_per + i, bh = g >> 4, uu = g & 15, b = bh >> 3, h = bh & 7;
#pragma unroll 1
                for (int half = 0; half < 2; ++half)
                    mla_unit128(lds, (const bf16_t*)(ws + WS_QM) + (size_t)bh * S * 192, (const bf16_t*)(ws + WS_KN) + (size_t)bh * S * 128, (const bf16_t*)(ws + WS_KPE) + (size_t)b * S * 64,
                                (const bf16_t*)(ws + WS_VMT) + (size_t)bh * 128 * S, half ? (31 - uu) : uu, omix + (size_t)b * S * 2048 + h * 128, sqb + SQ_OMLA * T + b * S);
            } } };
    auto run_sb = [&]() {
#pragma unroll 1
        for (int dl = 0; dl < nlab; ++dl) { const int l = (lab + dl) % nlab;
#pragma unroll 1
            for (;;) { const int i = q_pull(qh + 64 * (8 + l), lw); if (i >= sb_per) break;
                const int g = l * sb_per + i, bh = g >> 5, U = g & 31, b = bh >> 3, h = bh & 7;
                sb_unit(lds, (const bf16_t*)(ws + WS_QSB) + (size_t)bh * S * 128, (const bf16_t*)(ws + WS_KSB) + (size_t)bh * S * 128,
                        (const bf16_t*)(ws + WS_VSBT) + (size_t)bh * 128 * S, U, omix + (size_t)b * S * 2048 + 1024 + h * 128, sqb + SQ_OSB * T, b * S);
            } } };
    auto run_conv = [&]() {
#pragma unroll 1
        for (;;) { const int c = q_pull(qh + 64 * 16, lw); if (c >= 512) break;
            moe_convert_range(p, c * 32 + (tidf() >> 6), 4, c * 32 + 32, tidf() & 63); } };
    if (conv_first) { run_conv(); run_sb(); run_mla(); }
    else { run_mla(); run_sb(); run_conv(); }
}


template <int ABL>
DEV void phase3_dry(const P& p, unsigned char* lds) {
    unsigned char* ws = p.ws;
    const int G = gridDim.x;
    for (int w0 = blockIdx.x; w0 < 512; w0 += G) {
        const int w = ((G & 7) == 0 && G >= 64) ? ((((w0 & 7) * 2 + ((w0 >> 3) >> 5)) & 15) * 32 + ((w0 >> 3) & 31)) : w0;
        const int bh = w >> 5, uu = w & 31, b = bh >> 3;
#pragma unroll 1
        for (int half = 0; half < 2; ++half) {
            const int u = half ? (63 - uu) : uu;
            attn_unit<192, true, ABL>(lds, (const bf16_t*)(ws + WS_QM) + (size_t)bh * S * 192, (const bf16_t*)(ws + WS_KN) + (size_t)bh * S * 128,
                                 (const bf16_t*)(ws + WS_KPE) + (size_t)b * S * 64, (const bf16_t*)(ws + WS_VMT) + (size_t)bh * 128 * S, S, u * 64, u + 1,
                                 nullptr, 2048, nullptr, u * 64);
        }
    }
}
DEV void phase4(const P& p, unsigned char* lds, bool dry = false) {
    unsigned char* ws = p.ws;
    const XcdIter xi = xcd_iter();
    const int lane = tidf() & 63, wid = tidf() >> 6, wr = wid >> 1, wc = wid & 1, fr = lane & 15, fq = lane >> 4;
    u64* sqb = (u64*)(ws + CTL_SQ);
    bf16_t* x1b = (bf16_t*)(ws + WS_X1B);
    const int per_x = 8 * 16, total = 64 * 16;
    auto tile_at = [&](int it, int& mt, int& nt) -> bool {
        if (xi.x >= 0) { const int i = it * xi.per + xi.j; if (i >= per_x) return false; mt = xi.x * 8 + (i & 7); nt = i >> 3; }
        else { const int i = it * xi.per + xi.j; if (i >= total) return false; mt = i & 63; nt = i >> 6; }
        return true; };
    GemmPipe gp{0, false};
    int mt, nt; bool have = tile_at(0, mt, nt);
    if (!have) return;
    GT cur = gt_dense((const bf16_t*)(ws + WS_OMIX), D, mt * 128, (const bf16_t*)(ws + WS_WOUT), D, nt * 128, 0);
    for (int it = 0; have; ++it) {
        int mtn, ntn; const bool hn = tile_at(it + 1, mtn, ntn);
        const int m0 = mt * 128;
        const GT cur2 = gt_dense((const bf16_t*)(ws + WS_OMIX), D, m0, (const bf16_t*)(ws + WS_WOUT), D, nt * 128, 1024);
        GT nx = cur; if (hn) nx = gt_dense((const bf16_t*)(ws + WS_OMIX), D, mtn * 128, (const bf16_t*)(ws + WS_WOUT), D, ntn * 128, 0);
        f32x4 acc[4][4]; acc_zero(acc);
        gemm_run(acc, lds, cur, 16, true, gp, cur2, true);
        float rsb[4];
#pragma unroll
        for (int j = 0; j < 4; ++j) {
            const int m = m0 + wr * 64 + j * 16 + fr;
            const float ra = sq_rs(sqb + SQ_OMLA * T, m, 1.0f / 1024.0f); rsb[j] = sq_rs(sqb + SQ_OSB * T, m, 1.0f / 1024.0f);
            const float ratio = ra / rsb[j];
#pragma unroll
            for (int i = 0; i < 4; ++i) acc[i][j] *= ratio;
        }
        gemm_run(acc, lds, cur2, 16, true, gp, nx, hn);
#pragma unroll
        for (int j = 0; j < 4; ++j) {
            const int m = m0 + wr * 64 + j * 16 + fr; float ss = 0.f;
            const int n0 = nt * 128 + wc * 64 + fq * 16;
            f32x4 vv[4];
#pragma unroll
            for (int i = 0; i < 4; ++i) {
                const f32x4 xv = *(const f32x4*)(p.x + (size_t)m * D + n0 + i * 4);
                const f32x4 v = xv + acc[i][j] * rsb[j];
                ss += v[0] * v[0] + v[1] * v[1] + v[2] * v[2] + v[3] * v[3];
                vv[i] = v;
            }
            st_bf16x16(x1b + (size_t)m * D + n0, vv[0], vv[1], vv[2], vv[3]);
            ss += __shfl_xor(ss, 16); ss += __shfl_xor(ss, 32); if (fq == 0 && !dry) sq_add(sqb + SQ_X1 * T, m, ss);
        }
        cur = nx; mt = mtn; nt = ntn; have = hn;
    }
}

DEV void phase5(const P& p, unsigned char* lds) {
    unsigned char* ws = p.ws;
    const XcdIter xi = xcd_iter();
    const int lane = tidf() & 63, wid = tidf() >> 6, wr = wid >> 1, wc = wid & 1, fr = lane & 15, fq = lane >> 4;
    const u64* sqb = (const u64*)(ws + CTL_SQ);
    const int per_x = 8 * 4 + 4, total = 64 * 4 + 32;
    {
        const int my = xi.j, nbusy = ((xi.x >= 0 ? per_x : total) + xi.per - 1) / xi.per > 1 ? xi.per : (xi.x >= 0 ? per_x : total);
        const int lists = xi.x >= 0 ? 8 : 1, nidle = (xi.per - nbusy) * lists;
        if (nidle > 0) { if (my >= nbusy) moe_convert_down(p, ((my - nbusy) * lists + (xi.x >= 0 ? xi.x : 0)) * 4 + (tidf() >> 6), nidle * 4, tidf() & 63); }
        else moe_convert_down(p, (int)blockIdx.x * 4 + (tidf() >> 6), (int)gridDim.x * 4, tidf() & 63);
    }
    for (int it = 0;; ++it) {
        int mt, nt; bool memkv = false;
        if (xi.x >= 0) { const int i = it * xi.per + xi.j; if (i >= per_x) break;
            if (i < 32) { mt = xi.x * 8 + (i & 7); nt = i >> 3; } else { memkv = true; const int q = xi.x * 4 + (i - 32); mt = q & 3; nt = q >> 2; } }
        else { const int i = it * xi.per + xi.j; if (i >= total) break;
            if (i < 256) { mt = i & 63; nt = i >> 6; } else { memkv = true; const int q = i - 256; mt = q & 3; nt = q >> 2; } }
        const int m0 = mt * 128, b = m0 >> 12, s0 = m0 & 4095;
        f32x4 acc[4][4]; acc_zero(acc);
        if (memkv) {
            const bool isv = nt >= 4;
            gemm_dense(acc, lds, (const bf16_t*)(ws + WS_MEMN), D, mt * 128, (const bf16_t*)(ws + WS_WMKV), D, nt * 128, 0, 32, !isv);
            const int bb = mt >> 1, mm0 = (mt & 1) * 128;
            if (!isv) store_rowmajor_sq(acc, (bf16_t*)(ws + WS_KMEM) + (size_t)((bb * 4 + nt) * 256) * 128, 128, mm0, 0, nullptr, 1.0f);
            else store_transposed(acc, (bf16_t*)(ws + WS_VMEMT) + (size_t)((bb * 4 + (nt - 4)) * 128) * 256, 256, mm0, nullptr, 0, 0.f);
            continue;
        }
        gemm_dense(acc, lds, (const bf16_t*)(ws + WS_X1B), D, m0, (const bf16_t*)(ws + WS_WMQ), D, nt * 128, 0, 32, true);
        bf16_t* qm = (bf16_t*)(ws + WS_QMEM) + (size_t)((b * 4 + nt) * S) * 128;
#pragma unroll
        for (int j = 0; j < 4; ++j) {
            const int ml = wr * 64 + j * 16 + fr;
            const float rs = sq_rs(sqb + SQ_X1 * T, m0 + ml, 1.0f / 2048.0f) * (0.08838834764831845f * LOG2E);
            st_bf16x16(qm + (size_t)(s0 + ml) * 128 + wc * 64 + fq * 16, acc[0][j] * rs, acc[1][j] * rs, acc[2][j] * rs, acc[3][j] * rs);
        }
    }
}

DEV void phase6(const P& p, unsigned char* lds) {
    unsigned char* ws = p.ws;
    for (int w = blockIdx.x; w < 512; w += gridDim.x) {
        const int bh = w >> 6, u = w & 63, b = bh >> 2, h = bh & 3;
        attn_unit<128, false>(lds, (const bf16_t*)(ws + WS_QMEM) + (size_t)bh * S * 128, (const bf16_t*)(ws + WS_KMEM) + (size_t)bh * 256 * 128, nullptr,
                              (const bf16_t*)(ws + WS_VMEMT) + (size_t)bh * 128 * 256, 256, u * 64, 4,
                              (bf16_t*)(ws + WS_OMEM) + (size_t)b * S * 512 + h * 128, 512, nullptr, u * 64);
    }
}

DEV void phase7(const P& p, unsigned char* lds, bool dry = false) {
    unsigned char* ws = p.ws;
    const XcdIter xi = xcd_iter();
    const int lane = tidf() & 63, wid = tidf() >> 6, wr = wid >> 1, wc = wid & 1, fr = lane & 15, fq = lane >> 4;
    u64* sqb = (u64*)(ws + CTL_SQ);
    const bf16_t* x1b = (const bf16_t*)(ws + WS_X1B); u8* x2f8 = (u8*)(ws + WS_X2B);
    const int per_x = 8 * 16, total = 64 * 16;
    auto tile_at = [&](int it, int& mt, int& nt) -> bool {
        if (xi.x >= 0) { const int i = it * xi.per + xi.j; if (i >= per_x) return false; mt = xi.x * 8 + (i & 7); nt = i >> 3; }
        else { const int i = it * xi.per + xi.j; if (i >= total) return false; mt = i & 63; nt = i >> 6; }
        return true; };
    GemmPipe gp{0, false};
    int mt, nt; bool have = tile_at(0, mt, nt);
    if (!have) return;
    GT cur = gt_dense((const bf16_t*)(ws + WS_OMEM), 512, mt * 128, (const bf16_t*)(ws + WS_WMO), 512, nt * 128, 0);
    for (int it = 0; have; ++it) {
        int mtn, ntn; const bool hn = tile_at(it + 1, mtn, ntn);
        GT nx = cur; if (hn) nx = gt_dense((const bf16_t*)(ws + WS_OMEM), 512, mtn * 128, (const bf16_t*)(ws + WS_WMO), 512, ntn * 128, 0);
        const int m0 = mt * 128;
        f32x4 acc[4][4]; acc_zero(acc);
        gemm_run(acc, lds, cur, 8, true, gp, nx, hn);
#pragma unroll
        for (int j = 0; j < 4; ++j) {
            const int m = m0 + wr * 64 + j * 16 + fr; float ss = 0.f;
            const int n0 = nt * 128 + wc * 64 + fq * 16;
            const u32x4 xb0 = *(const u32x4*)(x1b + (size_t)m * D + n0), xb1 = *(const u32x4*)(x1b + (size_t)m * D + n0 + 8);
            const unsigned xw[8] = {xb0.x, xb0.y, xb0.z, xb0.w, xb1.x, xb1.y, xb1.z, xb1.w};
            u32x4 f8;
#pragma unroll
            for (int i = 0; i < 4; ++i) {
                const int n = n0 + i * 4;
                const f32x4 v = (f32x4){__uint_as_float(xw[2 * i] << 16), __uint_as_float(xw[2 * i] & 0xffff0000u), __uint_as_float(xw[2 * i + 1] << 16), __uint_as_float(xw[2 * i + 1] & 0xffff0000u)} + acc[i][j];
                ss += v[0] * v[0] + v[1] * v[1] + v[2] * v[2] + v[3] * v[3];
                st16f(p.out + (size_t)m * D + n, v);
                const f32x4 gf = *(const f32x4*)(p.norm_ffn + n);
                f8[i] = pack_fp8x4_sat(v[0] * gf[0], v[1] * gf[1], v[2] * gf[2], v[3] * gf[3]);
            }
            *(u32x4*)(x2f8 + (size_t)m * D + n0) = f8;
            ss += __shfl_xor(ss, 16); ss += __shfl_xor(ss, 32); if (fq == 0 && !dry) sq_add(sqb + SQ_X2 * T, m, ss);
        }
        cur = nx; mt = mtn; nt = ntn; have = hn;
    }
}

DEV void phase8(const P& p, unsigned char* lds) {
    unsigned char* ws = p.ws;
    const int tid = tidf(), lane = tid & 63, wid = tid >> 6, r16 = lane & 15, kq = lane >> 4;
    const u64* sqb = (const u64*)(ws + CTL_SQ);
    unsigned* cnt = (unsigned*)(ws + CTL_CNT);
    unsigned char* rt = ws + WS_ROUTE;
    float* red = (float*)lds;
    for (int tb = blockIdx.x; tb < T / 16; tb += gridDim.x) {
        const int t0 = tb * 16;
        f32x4 acc[3];
#pragma unroll
        for (int c = 0; c < 3; ++c) acc[c] = (f32x4){0.f, 0.f, 0.f, 0.f};
        const float* xa = p.out + (size_t)(t0 + r16) * D + wid * 512 + kq * 8;
        const bf16_t* wh = (const bf16_t*)(ws + WS_WR) + (size_t)r16 * D + wid * 512 + kq * 8;
        const bf16_t* wl = wh + 48 * 2048;
#pragma unroll 4
        for (int k = 0; k < 512; k += 32) {
            const f32x4 a0 = *(const f32x4*)(xa + k), a1 = *(const f32x4*)(xa + k + 4);
            u32x4 hw, lw;
            hw.x = cvt_pk_bf16(a0[0], a0[1]); hw.y = cvt_pk_bf16(a0[2], a0[3]); hw.z = cvt_pk_bf16(a1[0], a1[1]); hw.w = cvt_pk_bf16(a1[2], a1[3]);
            lw.x = cvt_pk_bf16(a0[0] - __uint_as_float(hw.x << 16), a0[1] - __uint_as_float(hw.x & 0xffff0000u));
            lw.y = cvt_pk_bf16(a0[2] - __uint_as_float(hw.y << 16), a0[3] - __uint_as_float(hw.y & 0xffff0000u));
            lw.z = cvt_pk_bf16(a1[0] - __uint_as_float(hw.z << 16), a1[1] - __uint_as_float(hw.z & 0xffff0000u));
            lw.w = cvt_pk_bf16(a1[2] - __uint_as_float(hw.w << 16), a1[3] - __uint_as_float(hw.w & 0xffff0000u));
            bf16x8 xh, xl; __builtin_memcpy(&xh, &hw, 16); __builtin_memcpy(&xl, &lw, 16);
#pragma unroll
            for (int c = 0; c < 3; ++c) {
                const bf16x8 bh = *(const bf16x8*)(wh + (size_t)c * 16 * D + k), bl = *(const bf16x8*)(wl + (size_t)c * 16 * D + k);
                acc[c] = __builtin_amdgcn_mfma_f32_16x16x32_bf16(xh, bh, acc[c], 0, 0, 0);
                acc[c] = __builtin_amdgcn_mfma_f32_16x16x32_bf16(xh, bl, acc[c], 0, 0, 0);
                acc[c] = __builtin_amdgcn_mfma_f32_16x16x32_bf16(xl, bh, acc[c], 0, 0, 0);
            }
        }
#pragma unroll
        for (int c = 0; c < 3; ++c)
#pragma unroll
            for (int e = 0; e < 4; ++e) red[(wid * 16 + kq * 4 + e) * 48 + c * 16 + r16] = acc[c][e];
        __syncthreads();
        if (tid < 16) {
            const int tok = t0 + tid;
            const float rs = sq_rs(sqb + SQ_X2 * T, tok, 1.0f / 2048.0f);
            auto logit = [&](int n) { return ((red[(0 * 16 + tid) * 48 + n] + red[(1 * 16 + tid) * 48 + n]) + (red[(2 * 16 + tid) * 48 + n] + red[(3 * 16 + tid) * 48 + n])) * rs; };
            float lg0 = logit(0) + p.b_group[0], lg1 = logit(1) + p.b_group[1], lg2 = logit(2) + p.b_group[2], lg3 = logit(3) + p.b_group[3];
            int g = 0; float gm = lg0;
            if (lg1 > gm) { gm = lg1; g = 1; }
            if (lg2 > gm) { gm = lg2; g = 2; }
            if (lg3 > gm) { gm = lg3; g = 3; }
            const float gden = __expf(lg0 - gm) + __expf(lg1 - gm) + __expf(lg2 - gm) + __expf(lg3 - gm);
            const float pg = 1.0f / gden;
            float el[8];
#pragma unroll
            for (int e = 0; e < 8; ++e) el[e] = logit(4 + g * 8 + e) + p.b_er[g * 8 + e];
            int e1 = 0; float m1 = el[0];
#pragma unroll
            for (int e = 1; e < 8; ++e) if (el[e] > m1) { m1 = el[e]; e1 = e; }
            int e2 = -1; float m2 = -3.0e38f;
#pragma unroll
            for (int e = 0; e < 8; ++e) if (e != e1 && el[e] > m2) { m2 = el[e]; e2 = e; }
            const float x2e = __expf(m2 - m1);
            const float p1 = 1.0f / (1.0f + x2e), p2 = x2e / (1.0f + x2e);
            const int ex1 = g * 8 + e1, ex2 = g * 8 + e2;
            const unsigned pos1 = atomicAdd(cnt + ex1 * 64, 1u), pos2 = atomicAdd(cnt + ex2 * 64, 1u);
            int* rexp = (int*)(rt + RT_EXP); int* rpos = (int*)(rt + RT_POS); float* rgate = (float*)(rt + RT_GATE); int* rlist = (int*)(rt + RT_LIST);
            rexp[tok * 2] = ex1; rexp[tok * 2 + 1] = ex2; rpos[tok * 2] = (int)pos1; rpos[tok * 2 + 1] = (int)pos2;
            rgate[tok * 2] = pg * p1; rgate[tok * 2 + 1] = pg * p2;
            rlist[ex1 * T + pos1] = tok * 2; rlist[ex2 * T + pos2] = tok * 2 + 1;
        }
        __syncthreads();
    }
}

DEV int moe_table(const P& p, int* tbl  ) {
    const unsigned* cnt = (const unsigned*)(p.ws + CTL_CNT);
    if (tidf() < 64) {
        const int e = tidf() & 31;
        const int c = (int)__hip_atomic_load(cnt + e * 64, __ATOMIC_RELAXED, __HIP_MEMORY_SCOPE_AGENT);
        const int nt = (c + 127) >> 7;
        int incl = nt;
#pragma unroll
        for (int o = 1; o < 32; o <<= 1) { const int v = __shfl_up(incl, o, 32); if (e >= o) incl += v; }
        if (tidf() < 32) { tbl[e] = incl - nt; tbl[33 + e] = c; if (e == 31) tbl[32] = incl; }
    }
    __syncthreads();
    return tbl[32];
}
DEV int moe_find(const int* tbl, int mtile) { int e = 0;
#pragma unroll 1
    for (int k = 16; k >= 1; k >>= 1) if (e + k < 32 && tbl[e + k] <= mtile) e += k;
    return e; }

DEV void phase9(const P& p, unsigned char* lds) {
    unsigned char* ws = p.ws;
    int* tbl = (int*)(lds + LDS_MAIN + 256);
    const int ntm = moe_table(p, tbl);
    const int tid = tidf(), lane = tid & 63, wid = tid >> 6, wr = wid >> 1, wc = wid & 1, fr = lane & 15, fq = lane >> 4;
    const int srow = tid >> 3, sc = stage_col(tid) * 2;
    const u64* sqb = (const u64*)(ws + CTL_SQ);
    const int* rlist = (const int*)(ws + WS_ROUTE + RT_LIST); const float* rgate = (const float*)(ws + WS_ROUTE + RT_GATE);
    const u8* x2f8 = (const u8*)(ws + WS_X2B);
    u8* act = (u8*)(ws + WS_ACT);
    auto desc = [&](int item) -> GT8 {
        const int mtile = item >> 3, nt = item & 7;
        const int e = moe_find(tbl, mtile), mi = mtile - tbl[e], cnt = tbl[33 + e];
        const int* le = rlist + (size_t)e * T;
        GT8 t;
#pragma unroll
        for (int i = 0; i < 4; ++i) { int li = mi * 128 + srow + 32 * i; li = li < cnt ? li : cnt - 1; t.a[i] = x2f8 + (size_t)(le[li] >> 1) * D + sc; }
        const u8* bp = (const u8*)(ws + WS_WGU) + ((size_t)e * 1024 + nt * 128) * D + sc;
#pragma unroll
        for (int i = 0; i < 4; ++i) t.b[i] = bp + (size_t)bperm(srow + 32 * i) * D;
        return t; };
    GemmPipe gp{0, false};
    const int nitems = ntm * 8;
    if ((int)blockIdx.x >= nitems) return;
    GT8 cur = desc(blockIdx.x);
    for (int item = blockIdx.x; item < nitems; item += gridDim.x) {
        const int mtile = item >> 3, nt = item & 7;
        const int e = moe_find(tbl, mtile), mi = mtile - tbl[e], cnt = tbl[33 + e];
        const int* le = rlist + (size_t)e * T;
        const bool hn = item + (int)gridDim.x < nitems;
        GT8 nx = cur; if (hn) nx = desc(item + gridDim.x);
        f32x4 acc[4][4]; acc_zero(acc);
        float rsj[4], gtj[4];
#pragma unroll
        for (int j = 0; j < 4; ++j) {
            int li = mi * 128 + wr * 64 + j * 16 + fr; li = li < cnt ? li : cnt - 1;
            const int ent = le[li];
            rsj[j] = sq_rs(sqb + SQ_X2 * T, ent >> 1, 1.0f / 2048.0f); gtj[j] = rgate[ent];
        }
        gemm_run8(acc, lds, cur, 16, gp, nx, hn);
#pragma unroll
        for (int j = 0; j < 4; ++j) {
            const int ml = wr * 64 + j * 16 + fr;
            const float rs = rsj[j] * (1.0f / W8_SCALE), gt = gtj[j] * ACT8_SCALE;
            u32x2 aw;
#pragma unroll
            for (int q = 0; q < 2; ++q) {
                const f32x4 a = acc[2 * q][j] * rs, u = acc[2 * q + 1][j] * rs;
                float o[4];
#pragma unroll
                for (int c = 0; c < 4; ++c) o[c] = a[c] / (1.0f + __expf(-a[c])) * u[c] * gt;
                aw[q] = pack_fp8x4_sat(o[0], o[1], o[2], o[3]);
            }
            *(u32x2*)(act + (size_t)(mtile * 128 + ml) * 512 + nt * 64 + wc * 32 + fq * 8) = aw;
        }
        cur = nx;
    }
}

DEV void phase10(const P& p, unsigned char* lds) {
    unsigned char* ws = p.ws;
    int* tbl = (int*)(lds + LDS_MAIN + 256);
    const int ntm = moe_table(p, tbl);
    const int tid = tidf(), lane = tid & 63, wid = tid >> 6, wr = wid >> 1, wc = wid & 1, fr = lane & 15, fq = lane >> 4;
    const int* rlist = (const int*)(ws + WS_ROUTE + RT_LIST);
    bf16_t* y = (bf16_t*)(ws + WS_Y);
    const int srow = tid >> 3, sc = stage_col(tid) * 2;
    auto desc = [&](int item) -> GT8 {
        const int mtile = item >> 4, nt = item & 15;
        const int e = moe_find(tbl, mtile);
        GT8 t;
        const u8* a = (const u8*)(ws + WS_ACT) + (size_t)(mtile * 128 + srow) * 512 + sc;
        const u8* b = (const u8*)(ws + WS_WD) + ((size_t)e * 2048 + nt * 128) * 512 + sc;
#pragma unroll
        for (int i = 0; i < 4; ++i) { t.a[i] = a + (size_t)(32 * i) * 512; t.b[i] = b + (size_t)bperm(srow + 32 * i) * 512; }
        return t; };
    GemmPipe gp{0, false};
    const int nitems = ntm * 16;
    if ((int)blockIdx.x >= nitems) return;
    GT8 cur = desc(blockIdx.x);
    for (int item = blockIdx.x; item < nitems; item += gridDim.x) {
        const int mtile = item >> 4, nt = item & 15;
        const int e = moe_find(tbl, mtile), mi = mtile - tbl[e], cnt = tbl[33 + e];
        const int* le = rlist + (size_t)e * T;
        const bool hn = item + (int)gridDim.x < nitems;
        GT8 nx = cur; if (hn) nx = desc(item + gridDim.x);
        f32x4 acc[4][4]; acc_zero(acc);
        int entj[4];
#pragma unroll
        for (int j = 0; j < 4; ++j) { const int li = mi * 128 + wr * 64 + j * 16 + fr; entj[j] = li < cnt ? le[li] : -1; }
        gemm_run8(acc, lds, cur, 4, gp, nx, hn);
#pragma unroll
        for (int j = 0; j < 4; ++j) {
            if (entj[j] >= 0) {
                const int ent = entj[j], tok = ent >> 1, k = ent & 1;
                const float ys = 1.0f / (W8_SCALE * ACT8_SCALE);
                st_bf16x16(y + ((size_t)k * T + tok) * D + nt * 128 + wc * 64 + fq * 16, acc[0][j] * ys, acc[1][j] * ys, acc[2][j] * ys, acc[3][j] * ys);
            }
        }
        cur = nx;
    }
}

DEV void phase11(const P& p, float probe_c) {
    const int lane = tidf() & 63, gw = blockIdx.x * 4 + (tidf() >> 6), NGW = gridDim.x * 4;
    const bf16_t* y = (const bf16_t*)(p.ws + WS_Y);
    for (int row = gw; row < T; row += NGW) {
        float* xr = p.out + (size_t)row * D;
        const bf16_t* y0 = y + (size_t)row * D; const bf16_t* y1 = y + ((size_t)T + row) * D;
        f32x4 v[8]; float s = 0.f;
#pragma unroll
        for (int i = 0; i < 8; ++i) {
            const int c = i * 256 + lane * 4;
            v[i] = *(const f32x4*)(xr + c);
            const u32x2 a = *(const u32x2*)(y0 + c), b = *(const u32x2*)(y1 + c);
            v[i][0] += __uint_as_float(a.x << 16) + __uint_as_float(b.x << 16);
            v[i][1] += __uint_as_float(a.x & 0xffff0000u) + __uint_as_float(b.x & 0xffff0000u);
            v[i][2] += __uint_as_float(a.y << 16) + __uint_as_float(b.y << 16);
            v[i][3] += __uint_as_float(a.y & 0xffff0000u) + __uint_as_float(b.y & 0xffff0000u);
            s += v[i][0] * v[i][0] + v[i][1] * v[i][1] + v[i][2] * v[i][2] + v[i][3] * v[i][3];
        }
        s = wave_sum(s);
        const float rs = __builtin_amdgcn_rsqf(s * (1.0f / 2048.0f) + EPS);
#pragma unroll
        for (int i = 0; i < 8; ++i) {
            const int c = i * 256 + lane * 4;
            const f32x4 g = *(const f32x4*)(p.norm_final + c);
#ifdef PROBE_CONST_OUT
            *(f32x4*)(xr + c) = (f32x4){probe_c, probe_c, probe_c, probe_c};
#else
            *(f32x4*)(xr + c) = v[i] * rs * g + probe_c;
#endif
        }
    }
}

DEV void phase11_dry(const P& p) {
    const int lane = tidf() & 63, gw = blockIdx.x * 4 + (tidf() >> 6), NGW = gridDim.x * 4;
    const bf16_t* y = (const bf16_t*)(p.ws + WS_Y);
    for (int row = gw; row < T; row += NGW) {
        float* xr = p.out + (size_t)row * D;
        const bf16_t* y0 = y + (size_t)row * D; const bf16_t* y1 = y + ((size_t)T + row) * D;
        f32x4 v[8]; float s = 0.f;
#pragma unroll
        for (int i = 0; i < 8; ++i) {
            const int c = i * 256 + lane * 4;
            v[i] = *(const f32x4*)(xr + c);
            const u32x2 a = *(const u32x2*)(y0 + c), b = *(const u32x2*)(y1 + c);
            v[i][0] += __uint_as_float(a.x << 16) + __uint_as_float(b.x << 16);
            v[i][1] += __uint_as_float(a.x & 0xffff0000u) + __uint_as_float(b.x & 0xffff0000u);
            v[i][2] += __uint_as_float(a.y << 16) + __uint_as_float(b.y << 16);
            v[i][3] += __uint_as_float(a.y & 0xffff0000u) + __uint_as_float(b.y & 0xffff0000u);
            s += v[i][0] * v[i][0] + v[i][1] * v[i][1] + v[i][2] * v[i][2] + v[i][3] * v[i][3];
        }
        s = wave_sum(s);
        const float rs = __builtin_amdgcn_rsqf(s * (1.0f / 2048.0f) + EPS);
#pragma unroll
        for (int i = 0; i < 8; ++i) {
            const int c = i * 256 + lane * 4;
            const f32x4 g = *(const f32x4*)(p.norm_final + c);
            { const f32x4 o = v[i] * rs * g; asm volatile("" :: "v"(o)); }
        }
    }
}

#ifndef USE_CG_SYNC
#define USE_CG_SYNC 0
#endif
__global__ void __launch_bounds__(NTHREADS, 2) hymba_fwd(P p) {
    extern __shared__ __attribute__((aligned(16))) unsigned char lds[];
#if USE_CG_SYNC
    cg::grid_group grid = cg::this_grid();
#endif
    volatile unsigned* st = (volatile unsigned*)(lds + LDS_MAIN);
    if (threadIdx.x < 16) st[threadIdx.x] = 0u;
    __syncthreads();
    XcdBarrier bar = xcd_barrier_post((unsigned*)(p.ws + CTL_BAR), st);
#if USE_CG_SYNC
#define GRID_BAR() grid.sync()
#else
#define GRID_BAR() xcd_barrier(bar)
#endif
#ifndef PROBE_REPEAT
#define PROBE_REPEAT 0
#endif
#define REP(n) ((PROBE_REPEAT >> (n)) & 1)
#ifndef PROBE_TIME
#define PROBE_TIME -1
#endif
#ifndef PROBE_SCALE
#define PROBE_SCALE 1e-7f
#endif
#ifndef PROBE_QUANT
#define PROBE_QUANT 1
#define PROBE_QOFF 0
#endif
    u64* tsw = (u64*)(p.ws + CTL_CNT + 14336);
#define STAMP(i) do { if (PROBE_TIME >= 0 && blockIdx.x == 0 && threadIdx.x == 0) tsw[i] = __builtin_amdgcn_s_memrealtime(); } while (0)
    STAMP(0);
    phase0(p);        GRID_BAR(); STAMP(1);
    if (REP(0)) { phase0(p); GRID_BAR(); }
    phase1(p, lds);   GRID_BAR(); STAMP(2);
#ifdef PROBE_DRY1
    STAMP(12); phase1_dry<PROBE_DRY1 - 1>(p, lds); GRID_BAR(); STAMP(13);
#endif
    if (REP(1)) { phase1(p, lds, true); GRID_BAR(); }
    phase2(p, lds);   GRID_BAR(); STAMP(3);
    if (REP(2)) { phase2(p, lds); GRID_BAR(); }
    phase3(p, lds);   GRID_BAR(); STAMP(4);
#ifdef PROBE_DRY3
    STAMP(12); phase3_dry<PROBE_DRY3 - 1>(p, lds); GRID_BAR(); STAMP(13);
#endif
    if (REP(3)) { phase3(p, lds, true); GRID_BAR(); }
    phase4(p, lds);   GRID_BAR(); STAMP(5);
    if (REP(4)) { phase4(p, lds, true); GRID_BAR(); }
    phase5(p, lds);   GRID_BAR(); STAMP(6);
    if (REP(5)) { phase5(p, lds); GRID_BAR(); }
    phase6(p, lds);   GRID_BAR(); STAMP(7);
    if (REP(6)) { phase6(p, lds); GRID_BAR(); }
    phase7(p, lds);   GRID_BAR(); STAMP(8);
    if (REP(7)) { phase7(p, lds, true); GRID_BAR(); }
    phase8(p, lds);   GRID_BAR(); STAMP(9);
    phase9(p, lds);   GRID_BAR(); STAMP(10);
    if (REP(9)) { phase9(p, lds); GRID_BAR(); }
    phase10(p, lds);  GRID_BAR(); STAMP(11);
#ifdef PROBE_DRY11
    STAMP(12); phase11_dry(p); GRID_BAR(); STAMP(13);
#endif
    if (REP(10)) { phase10(p, lds); GRID_BAR(); }
    float probe_c = 0.f;
    if (PROBE_TIME >= 0) { GRID_BAR(); const u64 dt = tsw[PROBE_TIME + 1] - tsw[PROBE_TIME]; probe_c = sqrtf((float)((dt + PROBE_QOFF) / PROBE_QUANT * PROBE_QUANT) * PROBE_SCALE); }
    phase11(p, probe_c);
#if USE_CG_SYNC
    grid.sync();
#endif
    (void)bar;
}

extern "C" void kernel_launch(void* const* d_in, const int* in_sizes, int n_in, void* d_out, int out_size, void* d_ws, size_t ws_size, hipStream_t stream) {
    static int grid = 0;
    if (grid == 0) {
        if (n_in != 26 || out_size != T * D || ws_size < WS_END) {
            fprintf(stderr, "kernel_launch: unexpected shapes: n_in %d out %d ws %zu (need %zu)\n", n_in, out_size, ws_size, (size_t)WS_END); grid = -1; return; }
        int dev = 0, cus = 0, per_cu = 0;
        hipGetDevice(&dev);
        hipDeviceGetAttribute(&cus, hipDeviceAttributeMultiprocessorCount, dev);
        if (hipFuncSetAttribute((const void*)hymba_fwd, hipFuncAttributeMaxDynamicSharedMemorySize, LDS_BYTES) != hipSuccess) { fprintf(stderr, "kernel_launch: hipFuncSetAttribute failed\n"); grid = -1; return; }
        if (hipOccupancyMaxActiveBlocksPerMultiprocessor(&per_cu, (const void*)hymba_fwd, NTHREADS, LDS_BYTES) != hipSuccess || per_cu < 1) { fprintf(stderr, "kernel_launch: occupancy query failed (%d)\n", per_cu); grid = -1; return; }
        if (per_cu > 2) per_cu = 2;
        grid = cus * per_cu;
        fprintf(stderr, "kernel_launch: %d CUs x %d blocks\n", cus, per_cu);
    }
    if (grid < 0) return;
    hipMemsetAsync(d_ws, 0, CTL_BYTES, stream);
    P p{};
    p.x = (const float*)d_in[0]; p.mem = (const float*)d_in[1]; p.pos = (const int*)d_in[2];
    p.norm_mix = (const float*)d_in[3]; p.w_in = (const float*)d_in[4]; p.norm_q_lat = (const float*)d_in[5]; p.w_q_b = (const float*)d_in[6];
    p.norm_kv_lat = (const float*)d_in[7]; p.w_kv_b = (const float*)d_in[8]; p.norm_mla_out = (const float*)d_in[9]; p.norm_sb_out = (const float*)d_in[10];
    p.w_out = (const float*)d_in[11]; p.norm_mem_x = (const float*)d_in[12]; p.norm_mem_src = (const float*)d_in[13]; p.w_mem_q = (const float*)d_in[14];
    p.w_mem_kv = (const float*)d_in[15]; p.w_mem_o = (const float*)d_in[16]; p.norm_ffn = (const float*)d_in[17]; p.w_group = (const float*)d_in[18];
    p.b_group = (const float*)d_in[19]; p.w_er = (const float*)d_in[20]; p.b_er = (const float*)d_in[21]; p.w_gate = (const float*)d_in[22];
    p.w_up = (const float*)d_in[23]; p.w_down = (const float*)d_in[24]; p.norm_final = (const float*)d_in[25];
    p.out = (float*)d_out; p.ws = (unsigned char*)d_ws;
    void* args[] = {&p};
    hipError_t e = hipLaunchCooperativeKernel((const void*)hymba_fwd, dim3(grid), dim3(NTHREADS), args, LDS_BYTES, stream);
    if (e != hipSuccess) fprintf(stderr, "kernel_launch: cooperative launch failed: %s (grid %d)\n", hipGetErrorString(e), grid);
}
```

```cpp
#include <hip/hip_runtime.h>
#include <hip/hip_cooperative_groups.h>
#include <cstdio>
#include <cstdint>
namespace cg = cooperative_groups;

typedef unsigned short bf16_t;
typedef short bf16x8 __attribute__((ext_vector_type(8)));
typedef float f32x4 __attribute__((ext_vector_type(4)));
typedef float f32x16 __attribute__((ext_vector_type(16)));
typedef unsigned u32x4 __attribute__((ext_vector_type(4)));
typedef unsigned u32x2 __attribute__((ext_vector_type(2)));
typedef unsigned long long u64;

#define DEV __device__ __forceinline__

constexpr int D = 2048, NB = 2, S = 4096, T = NB * S;
constexpr int MEML = 256, MT = NB * MEML;
constexpr int NIN = 3968;
constexpr float EPS = 1e-6f;
constexpr float LOG2E = 1.4426950408889634f;
constexpr int NTHREADS = 256;
constexpr int LDS_MAIN = 65536;
constexpr int LDS_BYTES = LDS_MAIN + 1024;

constexpr size_t MB = 1024 * 1024;
constexpr size_t WS_CTL = 0;
constexpr size_t CTL_BAR = 0;
constexpr size_t CTL_CNT = 16384;
constexpr size_t CTL_SQ = 32768;
constexpr size_t CTL_CU = CTL_SQ + 6 * (size_t)T * 8;
constexpr size_t CTL_BYTES = CTL_CU + 8192;
constexpr size_t WS_WIN = 1 * MB;
constexpr size_t WS_WQB = WS_WIN + (size_t)NIN * D * 2;
constexpr size_t WS_WKVB = WS_WQB + 1536 * 512 * 2;
constexpr size_t WS_WOUT = WS_WKVB + 2048 * 256 * 2;
constexpr size_t WS_WMQ = WS_WOUT + (size_t)2048 * 2048 * 2;
constexpr size_t WS_WMKV = WS_WMQ + 512 * 2048 * 2;
constexpr size_t WS_WMO = WS_WMKV + 1024 * 2048 * 2;
constexpr size_t WS_WGU = WS_WMO + 2048 * 512 * 2;
constexpr size_t WS_WD = WS_WGU + (size_t)32 * 1024 * 2048 * 2;
constexpr size_t WS_WR = WS_WD + (size_t)32 * 2048 * 512 * 2;
constexpr size_t WS_H = WS_WR + 48 * 2048 * 4;
constexpr size_t WS_MEMN = WS_H + (size_t)T * D * 2;
constexpr size_t WS_ROPE = WS_MEMN + (size_t)MT * D * 2;
constexpr size_t WS_CQ = WS_ROPE + (size_t)T * 32 * 8;
constexpr size_t WS_CKV = WS_CQ + (size_t)T * 512 * 2;
constexpr size_t WS_QSB = WS_CKV + (size_t)T * 256 * 2;
constexpr size_t WS_KSB = WS_QSB + (size_t)T * 1024 * 2;
constexpr size_t WS_VSBT = WS_KSB + (size_t)T * 1024 * 2;
constexpr size_t WS_KPE = WS_VSBT + (size_t)T * 1024 * 2;
constexpr size_t WS_KMEM = WS_KPE + (size_t)T * 64 * 2;
constexpr size_t WS_VMEMT = WS_KMEM + (size_t)MT * 512 * 2;
constexpr size_t WS_QM = WS_VMEMT + (size_t)MT * 512 * 2;
constexpr size_t WS_KN = WS_QM + (size_t)T * 1536 * 2;
constexpr size_t WS_VMT = WS_KN + (size_t)T * 1024 * 2;
constexpr size_t WS_X1 = WS_VMT + (size_t)T * 1024 * 2;
constexpr size_t WS_ROUTE = WS_X1 + (size_t)T * D * 4;
constexpr size_t RT_SLOT = 0;
constexpr size_t RT_GATE = (size_t)T * 2 * 4;
constexpr size_t RT_EXP = RT_GATE + (size_t)T * 2 * 4;
constexpr size_t RT_POS = RT_EXP + (size_t)T * 2 * 4;
constexpr size_t RT_LIST = RT_POS + (size_t)T * 2 * 4;
constexpr size_t WS_END = WS_ROUTE + RT_LIST + (size_t)32 * T * 4;
constexpr size_t WS_OMIX = WS_H, WS_X2B = WS_H, WS_X1B = WS_QSB, WS_QMEM = WS_CQ, WS_OMEM = WS_KN, WS_ACT = WS_QM, WS_Y = WS_X1;
constexpr int ACT_ROWS_MAX = 2 * T + 32 * 128;

enum { SQ_CQ = 0, SQ_CKV, SQ_OMLA, SQ_OSB, SQ_X1, SQ_X2 };

struct P {
    const float* x; const float* mem; const int* pos;
    const float *norm_mix, *w_in, *norm_q_lat, *w_q_b, *norm_kv_lat, *w_kv_b, *norm_mla_out, *norm_sb_out, *w_out;
    const float *norm_mem_x, *norm_mem_src, *w_mem_q, *w_mem_kv, *w_mem_o, *norm_ffn, *w_group, *b_group, *w_er, *b_er;
    const float *w_gate, *w_up, *w_down, *norm_final;
    float* out; unsigned char* ws;
};

DEV int tidf() { int t = threadIdx.x; asm volatile("" : "+v"(t)); return t; }
DEV unsigned cvt_pk_bf16(float lo, float hi) { unsigned r; asm("v_cvt_pk_bf16_f32 %0, %1, %2" : "=v"(r) : "v"(lo), "v"(hi)); return r; }
#ifndef WT_STORES
#define WT_STORES 0
#endif
DEV void st8(void* p, u32x2 v) {
#if WT_STORES > 1
    asm volatile("global_store_dwordx2 %0, %1, off sc1" :: "v"(p), "v"(v) : "memory");
#else
    *(u32x2*)p = v;
#endif
}
DEV void st16f(void* p, f32x4 v) {
#if WT_STORES
    asm volatile("global_store_dwordx4 %0, %1, off sc1\n\ts_nop 1" :: "v"(p), "v"(v) : "memory");
#else
    *(f32x4*)p = v;
#endif
}
DEV void st16u(void* p, u32x4 v) {
#if WT_STORES
    asm volatile("global_store_dwordx4 %0, %1, off sc1\n\ts_nop 1" :: "v"(p), "v"(v) : "memory");
#else
    *(u32x4*)p = v;
#endif
}
DEV float bf16_to_f32(bf16_t v) { return __uint_as_float(((unsigned)v) << 16); }
DEV float fexp2(float x) { return __builtin_amdgcn_exp2f(x); }
DEV float flog2(float x) { return __builtin_amdgcn_logf(x); }
DEV float wave_sum(float v) {
#pragma unroll
    for (int o = 32; o >= 1; o >>= 1) v += __shfl_xor(v, o);
    return v;
}
DEV void sq_add(u64* sq, int row, float partial) { atomicAdd(sq + row, (u64)__float2ull_rn(partial * 4294967296.0f)); }
DEV float sq_rs(const u64* sq, int row, float inv_n) {
    const u64 v = __hip_atomic_load(sq + row, __ATOMIC_RELAXED, __HIP_MEMORY_SCOPE_AGENT);
    const float ms = (float)((double)v * (1.0 / 4294967296.0)) * inv_n;
    return __builtin_amdgcn_rsqf(ms + EPS);
}
DEV int vperm4(int s0) { const int g = (s0 >> 2) & 3; const int gp = ((g & 1) << 1) | (g >> 1); return (s0 & ~15) | (gp << 2); }

#define XB_TMO      128
#define XB_XCNT(j)  (256  + 64 * (j))
#define XB_XSUB(j)  (1280 + 64 * (j))
#define XB_XGEN(j)  (2304 + 64 * (j))
#define XB_TOP      3328
#define XB_TOPGEN   3392
#define XCD_BAR_WORDS 3456
#define XB_SPIN_CAP (1u << 22)
#define LAS __attribute__((address_space(3)))
DEV unsigned xb_ld(unsigned* p) { return __hip_atomic_load(p, __ATOMIC_RELAXED, __HIP_MEMORY_SCOPE_AGENT); }
DEV unsigned xb_add(unsigned* p, unsigned v) { return __hip_atomic_fetch_add(p, v, __ATOMIC_RELAXED, __HIP_MEMORY_SCOPE_AGENT); }
DEV unsigned xb_xcc_id() { return (unsigned)__builtin_amdgcn_s_getreg((3 << 11) | 20) & 0xFu; }
#define XB_SPIN(cond, bar) do { unsigned _sp = 0; while (cond) { __builtin_amdgcn_s_sleep(1); \
    if ((++_sp & 255u) == 0u) { if (xb_ld(&(bar)[XB_TMO])) break; if (_sp > XB_SPIN_CAP) { atomicAdd(&(bar)[XB_TMO], 1u); break; } } } } while (0)
struct XcdBarrier { unsigned* bar; unsigned x; volatile unsigned* st; };
DEV XcdBarrier xcd_barrier_post(unsigned* bar, volatile unsigned* st) {
    XcdBarrier b; b.bar = bar; b.x = xb_xcc_id(); b.st = st;
    if (threadIdx.x == 0) (void)xb_add(&bar[XB_XCNT(b.x)], 1u);
    return b;
}
DEV void xcd_barrier_complete(unsigned* bar, unsigned x, unsigned& nloc, unsigned& nx) {
    const unsigned G = gridDim.x;
    unsigned sum, cnt, mine, sp = 0u;
    for (;;) {
        sum = 0u; cnt = 0u; mine = 0u;
#pragma unroll
        for (unsigned j = 0; j < 16; ++j) { const unsigned c = xb_ld(&bar[XB_XCNT(j)]); sum += c; cnt += (c > 0u) ? 1u : 0u; mine = (j == x) ? c : mine; }
        if (sum == G) break;
        __builtin_amdgcn_s_sleep(1);
        if ((++sp & 255u) == 0u) { if (xb_ld(&bar[XB_TMO])) break; if (sp > XB_SPIN_CAP) { atomicAdd(&bar[XB_TMO], 1u); break; } }
    }
    nloc = mine > 0u ? mine : 1u; nx = cnt > 0u ? cnt : 1u;
}
DEV void xcd_barrier(const XcdBarrier& b) {
    asm volatile("s_waitcnt vmcnt(0)" ::: "memory");
    __syncthreads();
    if (threadIdx.x == 0) {
        unsigned* bar = b.bar;
        __builtin_amdgcn_s_waitcnt(0);
        unsigned nloc = b.st[0], nx = b.st[1];
        if (nloc == 0u) { xcd_barrier_complete(bar, b.x, nloc, nx); b.st[0] = nloc; b.st[1] = nx; }
        const unsigned old = xb_add(&bar[XB_XSUB(b.x)], 1u);
        const unsigned gen = old / nloc;
        if (old + 1u == (gen + 1u) * nloc) {
            __builtin_amdgcn_fence(__ATOMIC_RELEASE, "agent");
            asm volatile("s_waitcnt vmcnt(0)" ::: "memory");
            const unsigned og = xb_add(&bar[XB_TOP], 1u);
            const unsigned tg = og / nx;
            if (og + 1u == (tg + 1u) * nx) xb_add(&bar[XB_TOPGEN], 1u);
            else XB_SPIN(xb_ld(&bar[XB_TOPGEN]) == tg, bar);
            __builtin_amdgcn_fence(__ATOMIC_ACQUIRE, "agent");
            xb_add(&bar[XB_XGEN(b.x)], 1u);
            asm volatile("s_waitcnt vmcnt(0)" ::: "memory");
        } else {
            XB_SPIN(xb_ld(&bar[XB_XGEN(b.x)]) == gen, bar);
            __builtin_amdgcn_fence(__ATOMIC_ACQUIRE, "agent");
            asm volatile("s_waitcnt vmcnt(0)" ::: "memory");
        }
    }
    __syncthreads();
}

struct XcdIter { int x, j, per; };
DEV XcdIter xcd_iter() { XcdIter r; const int G = gridDim.x; if ((G & 7) == 0) { r.x = blockIdx.x & 7; r.j = blockIdx.x >> 3; r.per = G >> 3; } else { r.x = -1; r.j = blockIdx.x; r.per = G; } return r; }

#define GLDS16(g, l) __builtin_amdgcn_global_load_lds((const unsigned*)(g), (LAS unsigned*)(l), 16, 0, 0)
typedef short s16x4 __attribute__((ext_vector_type(4)));
DEV int stage_col(int tid) { return (((tid & 7) ^ ((tid >> 3) & 7)) << 3); }
#ifndef PF_DIST
#define PF_DIST 3
#endif
template <bool BF32, int ABL = 0>
DEV void gemm_acc(f32x4 (&acc)[4][4], unsigned char* lds, const bf16_t* a0, const bf16_t* a1, const bf16_t* a2, const bf16_t* a3,
                  const bf16_t* b0, const bf16_t* b1, const bf16_t* b2, const bf16_t* b3, const float* bf, int ldn, int nkt, bool swap, const float* pf = nullptr) {
    const int tid = tidf();
    const int lane = tid & 63, wid = tid >> 6, wr = wid >> 1, wc = wid & 1, fr = lane & 15, fq = lane >> 4;
    const int xbase = swap ? (16384 + wc * 8192) : (wr * 8192);
    const int ybase = swap ? (wr * 8192) : (16384 + wc * 8192);
    unsigned char* ldw = lds + wid * 1024;
    const int n4 = tid & 31, kr = tid >> 5;
    const int wofs = 16384 + kr * 256 + (n4 & 3) * 8, sl0 = ((n4 >> 2) ^ (kr & 3)) << 5, sl1 = ((n4 >> 2) ^ ((kr & 3) | 4)) << 5;
    const int tq = (lane >> 2) & 3, gq = tq | ((fq & 1) << 2);
    const int wrd = 16384 + (8 * fq + tq) * 256 + 8 * (lane & 3);
    f32x4 rb[8];
    auto stage_a = [&](int buf, int ko) { GLDS16(a0 + ko, ldw + buf); GLDS16(a1 + ko, ldw + buf + 4096); GLDS16(a2 + ko, ldw + buf + 8192); GLDS16(a3 + ko, ldw + buf + 12288); };
    auto stage_b = [&](int buf, int ko) { GLDS16(b0 + ko, ldw + buf + 16384); GLDS16(b1 + ko, ldw + buf + 16384 + 4096); GLDS16(b2 + ko, ldw + buf + 16384 + 8192); GLDS16(b3 + ko, ldw + buf + 16384 + 12288); };
    auto load_bf = [&](int kt) {
#pragma unroll
        for (int i = 0; i < 8; ++i) rb[i] = *(const f32x4*)(bf + (size_t)(kt * 64 + 8 * i) * ldn);
    };
    auto write_bf = [&](int buf) {
#pragma unroll
        for (int i = 0; i < 8; ++i) {
            u32x2 w; w.x = cvt_pk_bf16(rb[i][0], rb[i][1]); w.y = cvt_pk_bf16(rb[i][2], rb[i][3]);
            *(u32x2*)(lds + buf + wofs + i * 2048 + ((i & 1) ? sl1 : sl0)) = w;
        }
    };
    stage_a(0, 0);
    if (BF32) { load_bf(0); write_bf(0); } else stage_b(0, 0);
    asm volatile("s_waitcnt vmcnt(0)" ::: "memory");
    __syncthreads();
    float pf_old = 0.f;
    for (int kt = 0; kt < nkt; ++kt) {
        const int cur = (kt & 1) * 32768, nxt = 32768 - cur;
        const bool more = (kt + 1 < nkt);
#ifndef GEMM_INTERLEAVE
#define GEMM_INTERLEAVE 0
#endif
        constexpr bool ILV = GEMM_INTERLEAVE && !BF32 && ABL == 0;
        if (more && !ILV && !(ABL == 2 && !BF32)) { stage_a(nxt, (kt + 1) * 64); if (BF32) load_bf(kt + 1); else stage_b(nxt, (kt + 1) * 64); }
        float pf_new = 0.f; const bool pfi = BF32 && pf && (kt + PF_DIST < nkt);
        if (pfi) pf_new = *(pf + (size_t)(kt + PF_DIST) * 64 * ldn);
        __builtin_amdgcn_sched_barrier(0);
#pragma unroll
        for (int ks = 0; ks < 2; ++ks) {
            bf16x8 xf[4], yf[4];
            const int coff = (((ks * 4 + fq) ^ (fr & 7)) << 4) + fr * 128;
            if (BF32) {
#pragma unroll
                for (int i = 0; i < 4; ++i) {
                    const int o = cur + wrd + ks * 8192 + (((wc * 4 + i) ^ gq) << 5);
                    const s16x4 lo = __builtin_amdgcn_ds_read_tr16_b64_v4i16((LAS s16x4*)(lds + o));
                    const s16x4 hi = __builtin_amdgcn_ds_read_tr16_b64_v4i16((LAS s16x4*)(lds + o + 1024));
                    xf[i] = __builtin_shufflevector(lo, hi, 0, 1, 2, 3, 4, 5, 6, 7);
                    yf[i] = *(const bf16x8*)(lds + cur + wr * 8192 + i * 2048 + coff);
                }
            } else if (ABL == 3) {
#pragma unroll
                for (int i = 0; i < 4; ++i) { xf[i] = (bf16x8){(short)(0x3f80 + i), 0x3f80, 0x3f81, 0x3f82, 0x3f83, 0x3f84, 0x3f85, (short)(0x3f86 + ks)}; yf[i] = xf[i]; asm volatile("" : "+v"(xf[i]), "+v"(yf[i])); }
            } else {
#pragma unroll
                for (int i = 0; i < 4; ++i) { xf[i] = *(const bf16x8*)(lds + cur + xbase + i * 2048 + coff); yf[i] = *(const bf16x8*)(lds + cur + ybase + i * 2048 + coff); }
            }
            if (ABL == 1 && !BF32) {
#pragma unroll
                for (int i = 0; i < 4; ++i) asm volatile("" :: "v"(xf[i]), "v"(yf[i]));
            } else if (ILV) {
                const int ko = (kt + 1) * 64;
#pragma unroll
                for (int i = 0; i < 4; ++i) {
                    __builtin_amdgcn_s_setprio(1);
#pragma unroll
                    for (int j = 0; j < 4; ++j) acc[i][j] = __builtin_amdgcn_mfma_f32_16x16x32_bf16(xf[i], yf[j], acc[i][j], 0, 0, 0);
                    __builtin_amdgcn_s_setprio(0);
                    if (more) {
                        const bf16_t* g = (ks == 0) ? (i == 0 ? a0 : i == 1 ? a1 : i == 2 ? a2 : a3) : (i == 0 ? b0 : i == 1 ? b1 : i == 2 ? b2 : b3);
                        GLDS16(g + ko, ldw + nxt + ks * 16384 + i * 4096);
                    }
                    __builtin_amdgcn_sched_barrier(0);
                }
            } else {
            __builtin_amdgcn_s_setprio(1);
#pragma unroll
            for (int i = 0; i < 4; ++i)
#pragma unroll
                for (int j = 0; j < 4; ++j) acc[i][j] = __builtin_amdgcn_mfma_f32_16x16x32_bf16(xf[i], yf[j], acc[i][j], 0, 0, 0);
            __builtin_amdgcn_s_setprio(0);
            }
        }
        if (BF32 && more) write_bf(nxt);
        if (BF32) {
            if (pfi) asm volatile("s_waitcnt vmcnt(1) lgkmcnt(0)" ::: "memory"); else asm volatile("s_waitcnt vmcnt(0) lgkmcnt(0)" ::: "memory");
            asm volatile("" :: "v"(pf_old));
            pf_old = pf_new;
            __builtin_amdgcn_s_barrier();
            asm volatile("" ::: "memory");
        } else {
            asm volatile("s_waitcnt vmcnt(0)" ::: "memory");
            __syncthreads();
        }
    }
    if (BF32) asm volatile("" :: "v"(pf_old));
}

struct GT { const bf16_t* a[4]; const bf16_t* b[4]; };
struct GemmPipe { int sb; bool pre; };
DEV int bperm(int r) { const int a = r & 15; return (r & 64) | ((a >> 2) << 4) | (((r >> 4) & 3) << 2) | (a & 3); }
DEV GT gt_dense(const bf16_t* A, int lda, int m0, const bf16_t* Bt, int ldb, int n0, int k0, bool perm = true) {
    const int tid = tidf(), srow = tid >> 3, sc = stage_col(tid);
    GT t;
    const bf16_t* b = Bt + (size_t)n0 * ldb + k0 + sc;
#pragma unroll
    for (int i = 0; i < 4; ++i) { const int r = srow + 32 * i; t.a[i] = A + (size_t)(m0 + (perm ? r : bperm(r))) * lda + k0 + sc; t.b[i] = b + (size_t)(perm ? bperm(r) : r) * ldb; }
    return t;
}
DEV void gemm_run(f32x4 (&acc)[4][4], unsigned char* lds, const GT& t, int nkt, bool swap, GemmPipe& gp, const GT& next, bool has_next) {
    const int tid = tidf();
    const int lane = tid & 63, wid = tid >> 6, wr = wid >> 1, wc = wid & 1, fr = lane & 15, fq = lane >> 4;
    const int xbase = swap ? (16384 + wc * 8192) : (wr * 8192);
    const int ybase = swap ? (wr * 8192) : (16384 + wc * 8192);
    unsigned char* ldw = lds + wid * 1024;
    auto stage = [&](const GT& g, int buf, int ko) {
#pragma unroll
        for (int i = 0; i < 4; ++i) GLDS16(g.a[i] + ko, ldw + buf + i * 4096);
#pragma unroll
        for (int i = 0; i < 4; ++i) GLDS16(g.b[i] + ko, ldw + buf + 16384 + i * 4096);
    };
    if (!gp.pre) { gp.sb = 0; stage(t, 0, 0); }
    asm volatile("s_waitcnt vmcnt(0)" ::: "memory");
    __builtin_amdgcn_s_barrier();
    asm volatile("" ::: "memory");
#pragma unroll 2
    for (int kt = 0; kt < nkt; ++kt) {
        const int cur = ((kt + gp.sb) & 1) * 32768, nxt = 32768 - cur;
        const bool more = (kt + 1 < nkt);
        if (more) stage(t, nxt, (kt + 1) * 64); else if (has_next) stage(next, nxt, 0);
        __builtin_amdgcn_sched_barrier(0);
#pragma unroll
        for (int ks = 0; ks < 2; ++ks) {
            bf16x8 xf[4], yf[4];
            const int coff = (((ks * 4 + fq) ^ (fr & 7)) << 4) + fr * 128;
#pragma unroll
            for (int i = 0; i < 4; ++i) { xf[i] = *(const bf16x8*)(lds + cur + xbase + i * 2048 + coff); yf[i] = *(const bf16x8*)(lds + cur + ybase + i * 2048 + coff); }
            __builtin_amdgcn_s_setprio(1);
#pragma unroll
            for (int i = 0; i < 4; ++i)
#pragma unroll
                for (int j = 0; j < 4; ++j) acc[i][j] = __builtin_amdgcn_mfma_f32_16x16x32_bf16(xf[i], yf[j], acc[i][j], 0, 0, 0);
            __builtin_amdgcn_s_setprio(0);
        }
        if (more) asm volatile("s_waitcnt vmcnt(0) lgkmcnt(0)" ::: "memory"); else asm volatile("s_waitcnt lgkmcnt(0)" ::: "memory");
        __builtin_amdgcn_s_barrier();
        asm volatile("" ::: "memory");
    }
    gp.pre = has_next; gp.sb = (nkt + gp.sb) & 1;
}

constexpr float W8_SCALE = 64.0f, ACT8_SCALE = 8.0f;
typedef int v8i __attribute__((ext_vector_type(8)));
typedef unsigned char u8;
DEV float sat8(float v) { return __builtin_amdgcn_fmed3f(v, -448.0f, 448.0f); }
DEV unsigned pack_fp8x4_sat(float a, float b, float c, float d) { int w = 0; w = __builtin_amdgcn_cvt_pk_fp8_f32(sat8(a), sat8(b), w, false); w = __builtin_amdgcn_cvt_pk_fp8_f32(sat8(c), sat8(d), w, true); return (unsigned)w; }
DEV unsigned pack_fp8x4(float a, float b, float c, float d) { int w = 0; w = __builtin_amdgcn_cvt_pk_fp8_f32(a, b, w, false); w = __builtin_amdgcn_cvt_pk_fp8_f32(c, d, w, true); return (unsigned)w; }
struct GT8 { const u8* a[4]; const u8* b[4]; };
DEV void gemm_run8(f32x4 (&acc)[4][4], unsigned char* lds, const GT8& t, int nks  , GemmPipe& gp, const GT8& next, bool has_next) {
    const int tid = tidf();
    const int lane = tid & 63, wid = tid >> 6, wr = wid >> 1, wc = wid & 1, fr = lane & 15, fq = lane >> 4;
    const int xbase = 16384 + wc * 8192, ybase = wr * 8192;
    unsigned char* ldw = lds + wid * 1024;
    const int off0 = fr * 128 + (((2 * fq) ^ (fr & 7)) << 4), off1 = fr * 128 + (((2 * fq + 1) ^ (fr & 7)) << 4);
    auto stage = [&](const GT8& g, int buf, int ko) {
#pragma unroll
        for (int i = 0; i < 4; ++i) GLDS16(g.a[i] + ko, ldw + buf + i * 4096);
#pragma unroll
        for (int i = 0; i < 4; ++i) GLDS16(g.b[i] + ko, ldw + buf + 16384 + i * 4096);
    };
    if (!gp.pre) { gp.sb = 0; stage(t, 0, 0); }
    asm volatile("s_waitcnt vmcnt(0)" ::: "memory");
    __builtin_amdgcn_s_barrier();
    asm volatile("" ::: "memory");
#pragma unroll 1
    for (int ks = 0; ks < nks; ++ks) {
        const int cur = ((ks + gp.sb) & 1) * 32768, nxt = 32768 - cur;
        const bool more = (ks + 1 < nks);
        if (more) stage(t, nxt, (ks + 1) * 128); else if (has_next) stage(next, nxt, 0);
        __builtin_amdgcn_sched_barrier(0);
        v8i xf[4], yf[4];
#pragma unroll
        for (int i = 0; i < 4; ++i) {
            const u32x4 xl = *(const u32x4*)(lds + cur + xbase + i * 2048 + off0), xh = *(const u32x4*)(lds + cur + xbase + i * 2048 + off1);
            const u32x4 yl = *(const u32x4*)(lds + cur + ybase + i * 2048 + off0), yh = *(const u32x4*)(lds + cur + ybase + i * 2048 + off1);
            xf[i] = (v8i){(int)xl.x, (int)xl.y, (int)xl.z, (int)xl.w, (int)xh.x, (int)xh.y, (int)xh.z, (int)xh.w};
            yf[i] = (v8i){(int)yl.x, (int)yl.y, (int)yl.z, (int)yl.w, (int)yh.x, (int)yh.y, (int)yh.z, (int)yh.w};
        }
        __builtin_amdgcn_s_setprio(1);
#pragma unroll
        for (int i = 0; i < 4; ++i)
#pragma unroll
            for (int j = 0; j < 4; ++j) acc[i][j] = __builtin_amdgcn_mfma_scale_f32_16x16x128_f8f6f4(xf[i], yf[j], acc[i][j], 0, 0, 0, 0x7F7F7F7F, 0, 0x7F7F7F7F);
        __builtin_amdgcn_s_setprio(0);
        if (more) asm volatile("s_waitcnt vmcnt(0) lgkmcnt(0)" ::: "memory"); else asm volatile("s_waitcnt lgkmcnt(0)" ::: "memory");
        __builtin_amdgcn_s_barrier();
        asm volatile("" ::: "memory");
    }
    gp.pre = has_next; gp.sb = (nks + gp.sb) & 1;
}
DEV void acc_zero(f32x4 (&acc)[4][4]) {
#pragma unroll
    for (int i = 0; i < 4; ++i)
#pragma unroll
        for (int j = 0; j < 4; ++j) acc[i][j] = (f32x4){0.f, 0.f, 0.f, 0.f};
}
template <int ABL = 0>
DEV void gemm_dense(f32x4 (&acc)[4][4], unsigned char* lds, const bf16_t* A, int lda, int m0, const bf16_t* Bt, int ldb, int n0, int k0, int nkt, bool swap) {
    const int tid = tidf();
    const int srow = tid >> 3, sc = stage_col(tid);
    const bf16_t* a = A + (size_t)m0 * lda + k0 + sc;
    const bf16_t* b = Bt + (size_t)n0 * ldb + k0 + sc;
    const int p0 = bperm(srow), p1 = bperm(srow + 32), p2 = bperm(srow + 64), p3 = bperm(srow + 96);
    const int r0 = swap ? p0 : srow, r1 = swap ? p1 : srow + 32, r2 = swap ? p2 : srow + 64, r3 = swap ? p3 : srow + 96;
    const int q0 = swap ? srow : p0, q1 = swap ? srow + 32 : p1, q2 = swap ? srow + 64 : p2, q3 = swap ? srow + 96 : p3;
    gemm_acc<false, ABL>(acc, lds, a + (size_t)q0 * lda, a + (size_t)q1 * lda, a + (size_t)q2 * lda, a + (size_t)q3 * lda, b + (size_t)r0 * ldb, b + (size_t)r1 * ldb, b + (size_t)r2 * ldb, b + (size_t)r3 * ldb, nullptr, 0, nkt, swap);
}
DEV void gemm_dense_bf32(f32x4 (&acc)[4][4], unsigned char* lds, const bf16_t* A, int lda, int m0, const float* Bsrc, int ldn, int nkt) {
    const int tid = tidf();
    const int srow = tid >> 3, sc = stage_col(tid);
    const bf16_t* a = A + (size_t)(m0 + srow) * lda + sc;
    const float* bf = Bsrc + (size_t)(tid >> 5) * ldn + (tid & 31) * 4;
    const float* pf = Bsrc + (size_t)(tid >> 2) * ldn + (tid & 3) * 32;
    gemm_acc<true>(acc, lds, a, a + (size_t)32 * lda, a + (size_t)64 * lda, a + (size_t)96 * lda, nullptr, nullptr, nullptr, nullptr, bf, ldn, nkt, true, pf);
}

template <class GainF, class RowF>
DEV void transpose_item(const float* src, int N, bf16_t* dst, int ldd, int k0, int n0, int lane, GainF gain, RowF dstrow) {
    const int ln = lane & 7, lk = lane >> 3;
    const int k = k0 + lk * 8, n = n0 + ln * 4;
    f32x4 v[8];
#pragma unroll
    for (int kk = 0; kk < 8; ++kk) v[kk] = *(const f32x4*)(src + (size_t)(k + kk) * N + n);
    float g[8];
#pragma unroll
    for (int kk = 0; kk < 8; ++kk) g[kk] = gain(k + kk);
#pragma unroll
    for (int j = 0; j < 4; ++j) {
        u32x4 w;
        w.x = cvt_pk_bf16(v[0][j] * g[0], v[1][j] * g[1]); w.y = cvt_pk_bf16(v[2][j] * g[2], v[3][j] * g[3]);
        w.z = cvt_pk_bf16(v[4][j] * g[4], v[5][j] * g[5]); w.w = cvt_pk_bf16(v[6][j] * g[6], v[7][j] * g[7]);
        st16u(dst + (size_t)dstrow(n + j) * ldd + k, w);
    }
}
DEV int rope_perm64(int i) { return i < 32 ? 2 * i : 2 * (i - 32) + 1; }

DEV void rms_row_to_bf16(const float* src, const float* g, bf16_t* dst, int lane) {
    f32x4 v[8]; float s = 0.f;
#pragma unroll
    for (int i = 0; i < 8; ++i) { v[i] = *(const f32x4*)(src + i * 256 + lane * 4); s += v[i][0] * v[i][0] + v[i][1] * v[i][1] + v[i][2] * v[i][2] + v[i][3] * v[i][3]; }
    s = wave_sum(s);
    const float rs = __builtin_amdgcn_rsqf(s * (1.0f / 2048.0f) + EPS);
#pragma unroll
    for (int i = 0; i < 8; ++i) {
        const f32x4 gg = *(const f32x4*)(g + i * 256 + lane * 4);
        u32x2 w; w.x = cvt_pk_bf16(v[i][0] * rs * gg[0], v[i][1] * rs * gg[1]); w.y = cvt_pk_bf16(v[i][2] * rs * gg[2], v[i][3] * rs * gg[3]);
        st8(dst + i * 256 + lane * 4, w);
    }
}

DEV void phase0(const P& p) {
    const int lane = tidf() & 63, gw = blockIdx.x * 4 + (tidf() >> 6), NGW = gridDim.x * 4;
    unsigned char* ws = p.ws;
    constexpr int I_IN = 32 * 122, I_QB = 8 * 48, I_KVB = 4 * 64;
    constexpr int NITEMS = I_IN + I_QB + I_KVB;
    for (int it = gw; it < NITEMS; it += NGW) {
        int r = it;
        if (r < I_IN) { const int kt = r / 122, nt = r % 122;
            transpose_item(p.w_in, 3904, (bf16_t*)(ws + WS_WIN), D, kt * 64, nt * 32, lane, [](int) { return 1.0f; },
                [](int n) { return n < 768 ? n : (n < 832 ? 3840 + rope_perm64(n - 768) : n - 64); }); continue; }
        r -= I_IN;
        if (r < I_QB) { const int kt = r / 48, nt = r % 48; const float* g = p.norm_q_lat;
            transpose_item(p.w_q_b, 1536, (bf16_t*)(ws + WS_WQB), 512, kt * 64, nt * 32, lane, [g](int k) { return g[k]; },
                [](int n) { const int h = n / 192, d = n % 192; return h * 192 + (d < 128 ? d : 128 + rope_perm64(d - 128)); }); continue; }
        r -= I_QB;
        { const int kt = r / 64, nt = r % 64; const float* g = p.norm_kv_lat;
            transpose_item(p.w_kv_b, 2048, (bf16_t*)(ws + WS_WKVB), 256, kt * 64, nt * 32, lane, [g](int k) { return g[k]; }, [](int n) { return n; }); }
    }
    {
        float* rt = (float*)(ws + WS_ROPE);
        for (int i = blockIdx.x * NTHREADS + tidf(); i < T * 32; i += gridDim.x * NTHREADS) {
            const int t = i >> 5, f = i & 31;
            const float inv_freq = exp2f(-(float)f * (13.287712379549449f / 32.0f));
            const float ang = (float)p.pos[t] * inv_freq;
            const double turns = (double)ang * 0.15915494309189535;
            const float fr = (float)(turns - floor(turns));
            rt[2 * i] = __builtin_amdgcn_cosf(fr); rt[2 * i + 1] = __builtin_amdgcn_sinf(fr);
        }
    }
    for (int row = gw; row < T; row += NGW) rms_row_to_bf16(p.x + (size_t)row * D, p.norm_mix, (bf16_t*)(ws + WS_H) + (size_t)row * D, lane);
}
DEV void late_convert(const P& p, int gw, int ngw, int lane) {
    unsigned char* ws = p.ws;
    constexpr int I_OUT = 32 * 64, I_MQ = 32 * 16, I_MKV = 32 * 32, I_MO = 8 * 64, I_WR = 48 * 2048 / 256, I_MEM = MT;
    constexpr int NITEMS = I_OUT + I_MQ + I_MKV + I_MO + I_WR + I_MEM;
    for (int it = gw; it < NITEMS; it += ngw) {
        int r = it;
        if (r < I_OUT) { const int kt = r / 64, nt = r % 64; const float* g1 = p.norm_mla_out; const float* g2 = p.norm_sb_out;
            transpose_item(p.w_out, 2048, (bf16_t*)(ws + WS_WOUT), 2048, kt * 64, nt * 32, lane, [g1, g2](int k) { return k < 1024 ? g1[k] : g2[k - 1024]; }, [](int n) { return n; }); continue; }
        r -= I_OUT;
        if (r < I_MQ) { const int kt = r / 16, nt = r % 16; const float* g = p.norm_mem_x;
            transpose_item(p.w_mem_q, 512, (bf16_t*)(ws + WS_WMQ), 2048, kt * 64, nt * 32, lane, [g](int k) { return g[k]; }, [](int n) { return n; }); continue; }
        r -= I_MQ;
        if (r < I_MKV) { const int kt = r / 32, nt = r % 32;
            transpose_item(p.w_mem_kv, 1024, (bf16_t*)(ws + WS_WMKV), 2048, kt * 64, nt * 32, lane, [](int) { return 1.0f; }, [](int n) { return n; }); continue; }
        r -= I_MKV;
        if (r < I_MO) { const int kt = r / 64, nt = r % 64;
            transpose_item(p.w_mem_o, 2048, (bf16_t*)(ws + WS_WMO), 512, kt * 64, nt * 32, lane, [](int) { return 1.0f; }, [](int n) { return n; }); continue; }
        r -= I_MO;
        if (r < I_WR) {
            bf16_t* wrh = (bf16_t*)(ws + WS_WR); bf16_t* wrl = wrh + 48 * 2048;
#pragma unroll
            for (int q = 0; q < 4; ++q) { const int i = r * 256 + q * 64 + lane, n = i >> 11, k = i & 2047;
                float v = 0.f;
                if (n < 4) v = p.w_group[k * 4 + n] * p.norm_ffn[k]; else if (n < 36) v = p.w_er[k * 32 + (n - 4)] * p.norm_ffn[k];
                const unsigned hi = cvt_pk_bf16(v, 0.f) & 0xffffu; const float lo = v - __uint_as_float(hi << 16);
                wrh[i] = (bf16_t)hi; wrl[i] = (bf16_t)(cvt_pk_bf16(lo, 0.f) & 0xffffu); }
            continue; }
        r -= I_WR;
        rms_row_to_bf16(p.mem + (size_t)r * D, p.norm_mem_src, (bf16_t*)(ws + WS_MEMN) + (size_t)r * D, lane);
    }
}


DEV void st_bf16x16(bf16_t* dst, const f32x4& v0, const f32x4& v1, const f32x4& v2, const f32x4& v3) {
    u32x4 a, b;
    a.x = cvt_pk_bf16(v0[0], v0[1]); a.y = cvt_pk_bf16(v0[2], v0[3]); a.z = cvt_pk_bf16(v1[0], v1[1]); a.w = cvt_pk_bf16(v1[2], v1[3]);
    b.x = cvt_pk_bf16(v2[0], v2[1]); b.y = cvt_pk_bf16(v2[2], v2[3]); b.z = cvt_pk_bf16(v3[0], v3[1]); b.w = cvt_pk_bf16(v3[2], v3[3]);
    *(u32x4*)dst = a; *(u32x4*)(dst + 8) = b;
}
DEV void store_rowmajor_sq(const f32x4 (&acc)[4][4], bf16_t* dst, int ldd, int m0, int ncol0, u64* sq, float scale) {
    const int lane = tidf() & 63, wid = tidf() >> 6, wr = wid >> 1, wc = wid & 1, fr = lane & 15, fq = lane >> 4;
#pragma unroll
    for (int j = 0; j < 4; ++j) {
        const int m = m0 + wr * 64 + j * 16 + fr; float ss = 0.f;
#pragma unroll
        for (int i = 0; i < 4; ++i) { const f32x4 v = acc[i][j]; ss += v[0] * v[0] + v[1] * v[1] + v[2] * v[2] + v[3] * v[3]; }
        st_bf16x16(dst + (size_t)m * ldd + ncol0 + wc * 64 + fq * 16, acc[0][j] * scale, acc[1][j] * scale, acc[2][j] * scale, acc[3][j] * scale);
        if (sq) { ss += __shfl_xor(ss, 16); ss += __shfl_xor(ss, 32); if (fq == 0) sq_add(sq, m, ss); }
    }
}
DEV void store_transposed(const f32x4 (&acc)[4][4], bf16_t* dst, int L, int s0, const u64* sq, int sqrow0, float inv_n) {
    const int lane = tidf() & 63, wid = tidf() >> 6, wr = wid >> 1, wc = wid & 1, fr = lane & 15, fq = lane >> 4;
    const int ml = wr * 64 + fq * 16;
    f32x4 sc[4];
#pragma unroll
    for (int i = 0; i < 4; ++i)
#pragma unroll
        for (int r = 0; r < 4; ++r) sc[i][r] = sq ? sq_rs(sq, sqrow0 + ml + 4 * i + r, inv_n) : 1.0f;
#pragma unroll
    for (int j = 0; j < 4; ++j) {
        const int n = wc * 64 + j * 16 + fr;
        st_bf16x16(dst + (size_t)n * L + s0 + ml, acc[0][j] * sc[0], acc[2][j] * sc[2], acc[1][j] * sc[1], acc[3][j] * sc[3]);
    }
}

DEV void phase1(const P& p, unsigned char* lds, bool dry = false) {
    unsigned char* ws = p.ws;
    const XcdIter xi = xcd_iter();
    const int lane = tidf() & 63, wid = tidf() >> 6, wr = wid >> 1, wc = wid & 1, fr = lane & 15, fq = lane >> 4;
    u64* sqb = (u64*)(ws + CTL_SQ);
    u64* sq_cq = dry ? nullptr : sqb + SQ_CQ * T; u64* sq_ckv = dry ? nullptr : sqb + SQ_CKV * T;
    const int per_x = 8 * 31, total = 64 * 31;
    auto tile_at = [&](int it, int& mt, int& nt) -> bool {
        if (xi.x >= 0) { const int i = it * xi.per + xi.j; if (i >= per_x) return false; mt = xi.x * 8 + (i & 7); nt = i >> 3; }
        else { const int i = it * xi.per + xi.j; if (i >= total) return false; mt = i & 63; nt = i >> 6; }
        return true; };
    GemmPipe gp{0, false};
    int mt, nt; bool have = tile_at(0, mt, nt);
    if (!have) return;
    GT cur = gt_dense((const bf16_t*)(ws + WS_H), D, mt * 128, (const bf16_t*)(ws + WS_WIN), D, nt * 128, 0, !(nt >= 22 && nt < 30));
    for (int it = 0; have; ++it) {
        int mtn, ntn; const bool hn = tile_at(it + 1, mtn, ntn);
        GT nx = cur; if (hn) nx = gt_dense((const bf16_t*)(ws + WS_H), D, mtn * 128, (const bf16_t*)(ws + WS_WIN), D, ntn * 128, 0, !(ntn >= 22 && ntn < 30));
        f32x4 acc[4][4]; acc_zero(acc);
        const bool isv = (nt >= 22 && nt < 30);
        gemm_run(acc, lds, cur, 32, !isv, gp, nx, hn);
        const int m0 = mt * 128, b = m0 >> 12, s0 = m0 & 4095;
        if (nt < 4) store_rowmajor_sq(acc, (bf16_t*)(ws + WS_CQ), 512, m0, nt * 128, sq_cq, 1.0f);
        else if (nt < 6) store_rowmajor_sq(acc, (bf16_t*)(ws + WS_CKV), 256, m0, (nt - 4) * 128, sq_ckv, 1.0f);
        else if (nt < 14) store_rowmajor_sq(acc, (bf16_t*)(ws + WS_QSB) + (size_t)((b * 8 + (nt - 6)) * S) * 128, 128, s0, 0, nullptr, 0.08838834764831845f * LOG2E);
        else if (nt < 22) store_rowmajor_sq(acc, (bf16_t*)(ws + WS_KSB) + (size_t)((b * 8 + (nt - 14)) * S) * 128, 128, s0, 0, nullptr, 1.0f);
        else if (nt < 30) store_transposed(acc, (bf16_t*)(ws + WS_VSBT) + (size_t)((b * 8 + (nt - 22)) * 128) * S, S, s0, nullptr, 0, 0.f);
        else if (wc == 0) {
            const float* rt = (const float*)(ws + WS_ROPE);
            bf16_t* kpe = (bf16_t*)(ws + WS_KPE);
#pragma unroll
            for (int j = 0; j < 4; ++j) {
                const int m = m0 + wr * 64 + j * 16 + fr;
#pragma unroll
                for (int i = 0; i < 4; ++i) {
                    const int n = fq * 16 + i * 4; const f32x4 v = acc[i][j];
                    const f32x4 cs = *(const f32x4*)(rt + ((size_t)m * 32 + (n >> 1)) * 2);
                    u32x2 w; w.x = cvt_pk_bf16(v[0] * cs[0] - v[1] * cs[1], v[1] * cs[0] + v[0] * cs[1]);
                    w.y = cvt_pk_bf16(v[2] * cs[2] - v[3] * cs[3], v[3] * cs[2] + v[2] * cs[3]);
                    st8(kpe + (size_t)m * 64 + n, w);
                }
            }
        }
        cur = nx; mt = mtn; nt = ntn; have = hn;
    }
}


template <int ABL>
DEV void phase1_dry(const P& p, unsigned char* lds) {
    unsigned char* ws = p.ws;
    const XcdIter xi = xcd_iter();
    const int per_x = 8 * 31, total = 64 * 31;
    for (int it = 0;; ++it) {
        int mt, nt;
        if (xi.x >= 0) { const int i = it * xi.per + xi.j; if (i >= per_x) break; mt = xi.x * 8 + (i & 7); nt = i >> 3; }
        else { const int i = it * xi.per + xi.j; if (i >= total) break; mt = i & 63; nt = i >> 6; }
        f32x4 acc[4][4]; acc_zero(acc);
        gemm_dense<ABL>(acc, lds, (const bf16_t*)(ws + WS_H), D, mt * 128, (const bf16_t*)(ws + WS_WIN), D, nt * 128, 0, 32, true);
#pragma unroll
        for (int i = 0; i < 4; ++i)
#pragma unroll
            for (int j = 0; j < 4; ++j) asm volatile("" :: "v"(acc[i][j]));
    }
}
DEV void phase2(const P& p, unsigned char* lds) {
    unsigned char* ws = p.ws;
    const XcdIter xi = xcd_iter();
    const int lane = tidf() & 63, wid = tidf() >> 6, wr = wid >> 1, wc = wid & 1, fr = lane & 15, fq = lane >> 4;
    const u64* sqb = (const u64*)(ws + CTL_SQ);
    const int per_x = 8 * 28, total = 64 * 28;
    auto tile_at = [&](int it, int& mt, int& nt) -> bool {
        if (xi.x >= 0) { const int i = it * xi.per + xi.j; if (i >= per_x) return false; mt = xi.x * 8 + (i & 7); nt = i >> 3; }
        else { const int i = it * xi.per + xi.j; if (i >= total) return false; mt = i & 63; nt = i >> 6; }
        return true; };
    auto desc = [&](int mt, int nt) -> GT {
        return nt < 12 ? gt_dense((const bf16_t*)(ws + WS_CQ), 512, mt * 128, (const bf16_t*)(ws + WS_WQB), 512, nt * 128, 0, true)
                       : gt_dense((const bf16_t*)(ws + WS_CKV), 256, mt * 128, (const bf16_t*)(ws + WS_WKVB), 256, (nt - 12) * 128, 0, ((nt - 12) & 1) == 0); };
    GemmPipe gp{0, false};
    int mt, nt; bool have = tile_at(0, mt, nt);
    if (!have) return;
    GT cur = desc(mt, nt);
    for (int it = 0; have; ++it) {
        int mtn, ntn; const bool hn = tile_at(it + 1, mtn, ntn);
        GT nx = cur; if (hn) nx = desc(mtn, ntn);
        const int m0 = mt * 128, b = m0 >> 12, s0 = m0 & 4095;
        f32x4 acc[4][4]; acc_zero(acc);
        if (nt < 12) {
            gemm_run(acc, lds, cur, 8, true, gp, nx, hn);
            const float* rt = (const float*)(ws + WS_ROPE);
            bf16_t* qm = (bf16_t*)(ws + WS_QM);
            const float qs = 0.07216878364870322f * LOG2E;
#pragma unroll
            for (int j = 0; j < 4; ++j) {
                const int m = m0 + wr * 64 + j * 16 + fr, s = s0 + wr * 64 + j * 16 + fr;
                const float rs = sq_rs(sqb + SQ_CQ * T, m, 1.0f / 512.0f) * qs;
                const int n0 = nt * 128 + wc * 64 + fq * 16, h = n0 / 192, d0 = n0 - h * 192;
                f32x4 vq[4];
#pragma unroll
                for (int i = 0; i < 4; ++i) {
                    const int d = d0 + i * 4;
                    f32x4 v = acc[i][j] * rs;
                    if (d >= 128) {
                        const f32x4 cs = *(const f32x4*)(rt + ((size_t)m * 32 + ((d - 128) >> 1)) * 2);
                        v = (f32x4){v[0] * cs[0] - v[1] * cs[1], v[1] * cs[0] + v[0] * cs[1], v[2] * cs[2] - v[3] * cs[3], v[3] * cs[2] + v[2] * cs[3]};
                    }
                    vq[i] = v;
                }
                st_bf16x16(qm + ((size_t)(b * 8 + h) * S + s) * 192 + d0, vq[0], vq[1], vq[2], vq[3]);
            }
        } else {
            const int nk = nt - 12, h = nk >> 1; const bool isv = nk & 1;
            gemm_run(acc, lds, cur, 4, !isv, gp, nx, hn);
            if (!isv) {
                bf16_t* kn = (bf16_t*)(ws + WS_KN) + (size_t)((b * 8 + h) * S) * 128;
#pragma unroll
                for (int j = 0; j < 4; ++j) {
                    const int ml = wr * 64 + j * 16 + fr;
                    const float rs = sq_rs(sqb + SQ_CKV * T, m0 + ml, 1.0f / 256.0f);
                    st_bf16x16(kn + (size_t)(s0 + ml) * 128 + wc * 64 + fq * 16, acc[0][j] * rs, acc[1][j] * rs, acc[2][j] * rs, acc[3][j] * rs);
                }
            } else {
                store_transposed(acc, (bf16_t*)(ws + WS_VMT) + (size_t)((b * 8 + h) * 128) * S, S, s0, sqb + SQ_CKV * T, m0, 1.0f / 256.0f);
            }
        }
        cur = nx; mt = mtn; nt = ntn; have = hn;
    }
}

template <int DQK> struct KStage {
    static constexpr int NIG = DQK / 64;
    u32x4 r[2][NIG];
    const bf16_t* gm; const bf16_t* gp; int l0, l1;
    DEV void init(const bf16_t* Kmain, const bf16_t* Kpe, int t) {
        const int row = t >> 3, c = t & 7;
        gm = Kmain + (size_t)row * 128 + c * 8; gp = (DQK == 192) ? Kpe + (size_t)row * 64 + c * 8 : nullptr;
        if (DQK == 128) { const int lo = row * 256 + ((c ^ (row & 7)) << 4), b3 = (row >> 3) & 1; l0 = lo + (b3 ? 128 : 0); l1 = lo + (b3 ? 0 : 128); }
        else { l0 = row * 384 + ((c ^ ((row >> 1) & 7)) << 4); l1 = l0 + 128; }
    }
    DEV void load(int tile) {
#pragma unroll
        for (int ps = 0; ps < 2; ++ps) {
            const bf16_t* g = gm + ((size_t)tile * 64 + ps * 32) * 128;
            r[ps][0] = *(const u32x4*)g; r[ps][1] = *(const u32x4*)(g + 64);
            if (DQK == 192) r[ps][NIG - 1] = *(const u32x4*)(gp + ((size_t)tile * 64 + ps * 32) * 64);
        }
    }
    DEV void write(unsigned char* ldsK) {
#pragma unroll
        for (int ps = 0; ps < 2; ++ps) {
            *(u32x4*)(ldsK + l0 + ps * 32 * DQK * 2) = r[ps][0]; *(u32x4*)(ldsK + l1 + ps * 32 * DQK * 2) = r[ps][1];
            if (DQK == 192) *(u32x4*)(ldsK + l0 + 256 + ps * 32 * DQK * 2) = r[ps][NIG - 1];
        }
    }
};
struct VStage {
    u32x4 r[4]; const bf16_t* g; int l; size_t rstride;
    DEV void init(const bf16_t* VT, int LV, int t) { const int row = t >> 3, c = t & 7; g = VT + (size_t)row * LV + c * 8; rstride = (size_t)32 * LV; l = row * 128 + ((c ^ ((row >> 1) & 7)) << 4); }
    DEV void load(int tile) {
#pragma unroll
        for (int i = 0; i < 4; ++i) r[i] = *(const u32x4*)(g + i * rstride + (size_t)tile * 64);
    }
    DEV void write(unsigned char* ldsV) {
#pragma unroll
        for (int i = 0; i < 4; ++i) *(u32x4*)(ldsV + l + i * 4096) = r[i];
    }
};
template <int DQK> DEV int kfrag_off(int krow, int ks, int hh) {
    const int c = 2 * ks + hh;
    if (DQK == 128) return krow * 256 + ((c ^ (krow & 15)) << 4);
    else return krow * 384 + ((((c & ~7) | ((c & 7) ^ ((krow >> 1) & 7)))) << 4);
}
DEV int vfrag_off(int r, int c) { return r * 128 + ((c ^ ((r >> 1) & 7)) << 4); }

constexpr int OT_OFF = 40960, OT_STRIDE = 272;
template <int DQK, bool CAUSAL, int ABL = 0>
DEV void attn_unit(unsigned char* lds, const bf16_t* Q, const bf16_t* Kmain, const bf16_t* Kpe, const bf16_t* VT, int LV, int q0, int ntiles,
                   bf16_t* O, int ldo, u64* sq  , int orow0) {
    constexpr int NKS = DQK / 16, KTILE_BYTES = 64 * DQK * 2;
    const int tid = tidf();
    const int lane = tid & 63, wid = tid >> 6, pr = wid >> 1, kh = wid & 1, l31 = lane & 31, hh = lane >> 5;
    unsigned char* ldsK = lds; unsigned char* ldsV = lds + KTILE_BYTES;
    bf16x8 qf[NKS];
    { const bf16_t* qp = Q + (size_t)(q0 + pr * 32 + l31) * DQK + hh * 8;
#pragma unroll
      for (int ks = 0; ks < NKS; ++ks) qf[ks] = *(const bf16x8*)(qp + ks * 16); }
    f32x16 oacc[4];
#pragma unroll
    for (int i = 0; i < 4; ++i)
#pragma unroll
        for (int r = 0; r < 16; ++r) oacc[i][r] = 0.f;
    float mrun = -1e30f, lrun = 0.f;
    KStage<DQK> ksg; VStage vsg;
    ksg.init(Kmain, Kpe, tid); vsg.init(VT, LV, tid);
    const int krow = kh * 32 + l31;
    int ka[DQK == 128 ? 8 : 4];
#pragma unroll
    for (int i = 0; i < (DQK == 128 ? 8 : 4); ++i) ka[i] = kfrag_off<DQK>(krow, i, hh);
    const int va0 = vfrag_off(l31, kh * 4 + hh), va1 = vfrag_off(l31, kh * 4 + 2 + hh);
    if (ABL != 1) { ksg.load(0); vsg.load(0); ksg.write(ldsK); vsg.write(ldsV); } __syncthreads();
    const int qpos = q0 + pr * 32 + l31;
    for (int t = 0; t < ntiles; ++t) {
        const bool more = t + 1 < ntiles;
        if (more && ABL != 1) { ksg.load(t + 1); vsg.load(t + 1); }
        __builtin_amdgcn_sched_barrier(0);
        const bool diag = CAUSAL && (t == ntiles - 1);
        if (!(diag && pr == 0 && kh == 1)) {
            f32x16 sacc;
#pragma unroll
            for (int r = 0; r < 16; ++r) sacc[r] = 0.f;
            __builtin_amdgcn_s_setprio(1);
#pragma unroll
            for (int ks = 0; ks < NKS; ++ks) {
                const int off = (DQK == 128) ? ka[ks] : (ka[ks & 3] + 128 * (ks >> 2));
                const bf16x8 kf = *(const bf16x8*)(ldsK + off);
                if (ABL == 2) { asm volatile("" :: "v"(kf)); sacc[ks & 15] += 1.0f; } else sacc = __builtin_amdgcn_mfma_f32_32x32x16_bf16(kf, qf[ks], sacc, 0, 0, 0);
            }
            __builtin_amdgcn_s_setprio(0);
            if (diag) {
                const int kbase = t * 64 + kh * 32 + 4 * hh;
#pragma unroll
                for (int r = 0; r < 16; ++r) { const int kp = kbase + (r & 3) + 8 * (r >> 2); if (kp > qpos) sacc[r] = -1e30f; }
            }
            if (ABL != 3) {
            float mx = sacc[0];
#pragma unroll
            for (int r = 1; r < 16; ++r) mx = fmaxf(mx, sacc[r]);
            mx = fmaxf(mx, __shfl_xor(mx, 32));
            const float mnew = fmaxf(mrun, mx), alpha = fexp2(mrun - mnew);
            mrun = mnew;
            float ps = 0.f;
#pragma unroll
            for (int r = 0; r < 16; ++r) { sacc[r] = fexp2(sacc[r] - mnew); ps += sacc[r]; }
            lrun = lrun * alpha + ps;
#pragma unroll
            for (int i = 0; i < 4; ++i)
#pragma unroll
                for (int r = 0; r < 16; ++r) oacc[i][r] *= alpha;
            }
            __builtin_amdgcn_s_setprio(1);
#pragma unroll
            for (int s2 = 0; s2 < 2; ++s2) {
                u32x4 pw; pw.x = cvt_pk_bf16(sacc[8 * s2 + 0], sacc[8 * s2 + 1]); pw.y = cvt_pk_bf16(sacc[8 * s2 + 2], sacc[8 * s2 + 3]);
                pw.z = cvt_pk_bf16(sacc[8 * s2 + 4], sacc[8 * s2 + 5]); pw.w = cvt_pk_bf16(sacc[8 * s2 + 6], sacc[8 * s2 + 7]);
                bf16x8 pf; __builtin_memcpy(&pf, &pw, 16);
#pragma unroll
                for (int dvb = 0; dvb < 4; ++dvb) {
                    const bf16x8 vf = *(const bf16x8*)(ldsV + (s2 ? va1 : va0) + dvb * 4096);
                    if (ABL == 2) { asm volatile("" :: "v"(vf), "v"(pf)); oacc[dvb][s2] += 1.0f; } else oacc[dvb] = __builtin_amdgcn_mfma_f32_32x32x16_bf16(vf, pf, oacc[dvb], 0, 0, 0);
                }
            }
            __builtin_amdgcn_s_setprio(0);
        }
        __syncthreads();
        if (more && ABL != 1) { ksg.write(ldsK); vsg.write(ldsV); }
        __syncthreads();
    }
    float lw = lrun + __shfl_xor(lrun, 32);
    float* xo = (float*)(lds + pr * 20480);
    if (kh == 1) {
#pragma unroll
        for (int i = 0; i < 4; ++i)
#pragma unroll
            for (int r = 0; r < 16; ++r) xo[(i * 16 + r) * 64 + lane] = oacc[i][r];
        xo[4096 + lane] = mrun; xo[4096 + 64 + lane] = lw;
    }
    __syncthreads();
    if (kh == 0 && O != nullptr) {
        const float m1 = xo[4096 + lane], l1 = xo[4096 + 64 + lane];
        const float m = fmaxf(mrun, m1), f0 = fexp2(mrun - m), f1 = fexp2(m1 - m);
        const float inv = 1.0f / (lw * f0 + l1 * f1);
        const float c0 = f0 * inv, c1 = f1 * inv;
        float ss = 0.f;
        unsigned char* ot = lds + OT_OFF + (pr * 32 + l31) * OT_STRIDE;
#pragma unroll
        for (int i = 0; i < 4; ++i)
#pragma unroll
            for (int rq = 0; rq < 4; ++rq) {
                float v[4];
#pragma unroll
                for (int e = 0; e < 4; ++e) { const int r = rq * 4 + e; v[e] = oacc[i][r] * c0 + xo[(i * 16 + r) * 64 + lane] * c1; ss += v[e] * v[e]; }
                u32x2 w; w.x = cvt_pk_bf16(v[0], v[1]); w.y = cvt_pk_bf16(v[2], v[3]);
                *(u32x2*)(ot + (i * 32 + 8 * rq + 4 * hh) * 2) = w;
            }
        if (sq) { ss += __shfl_xor(ss, 32); if (hh == 0) sq_add(sq, orow0 + pr * 32 + l31, ss); }
    }
    if (O == nullptr) { _Pragma("unroll") for (int i = 0; i < 4; ++i) asm volatile("" :: "v"(oacc[i])); asm volatile("" :: "v"(lrun), "v"(mrun)); }
    __syncthreads();
    if (O != nullptr) {
#pragma unroll
        for (int i = 0; i < 4; ++i) {
            const int c = tid + i * NTHREADS, row = c >> 4, ch = c & 15;
            const u32x4 w = *(const u32x4*)(lds + OT_OFF + row * OT_STRIDE + ch * 16);
            *(u32x4*)(O + (size_t)(orow0 + row) * ldo + ch * 8) = w;
        }
    }
    __syncthreads();
}

DEV void sb_unit(unsigned char* lds, const bf16_t* Q, const bf16_t* K, const bf16_t* VT, int U, bf16_t* O  , u64* sq, int tok0) {
    constexpr int KTILE_BYTES = 64 * 128 * 2;
    const int tid = tidf();
    const int lane = tid & 63, wid = tid >> 6, l31 = lane & 31, hh = lane >> 5;
    unsigned char* ldsK = lds; unsigned char* ldsV = lds + KTILE_BYTES;
    volatile int* flags = (volatile int*)(lds + LDS_MAIN + 64);
    const int q0 = U * 128 + wid * 32, qpos = q0 + l31;
    bf16x8 qf[8];
    { const bf16_t* qp = Q + (size_t)qpos * 128 + hh * 8;
#pragma unroll
      for (int ks = 0; ks < 8; ++ks) qf[ks] = *(const bf16x8*)(qp + ks * 16); }
    f32x16 oacc[4];
#pragma unroll
    for (int i = 0; i < 4; ++i)
#pragma unroll
        for (int r = 0; r < 16; ++r) oacc[i][r] = 0.f;
    float R = 0.f;
    KStage<128> ksg; VStage vsg;
    ksg.init(K, nullptr, tid); vsg.init(VT, S, tid);
    int ka[8];
#pragma unroll
    for (int i = 0; i < 8; ++i) ka[i] = kfrag_off<128>(l31, i, hh);
    const int va[4] = {vfrag_off(l31, hh), vfrag_off(l31, 2 + hh), vfrag_off(l31, 4 + hh), vfrag_off(l31, 6 + hh)};
    int t = 2 * U + 1;
    ksg.load(t); vsg.load(t); ksg.write(ldsK); vsg.write(ldsV); __syncthreads();
    for (; t >= 0; --t) {
        const bool more = t > 0;
        if (more) { ksg.load(t - 1); vsg.load(t - 1); }
        __builtin_amdgcn_sched_barrier(0);
        const int kt0 = t * 64;
        if (kt0 < q0 + 31) {
            const bool need_mask = (kt0 + 63 >= q0);
#pragma unroll
            for (int kb = 1; kb >= 0; --kb) {
                f32x16 z;
#pragma unroll
                for (int r = 0; r < 16; ++r) z[r] = 0.f;
#pragma unroll
                for (int ks = 0; ks < 8; ++ks) {
                    const bf16x8 kf = *(const bf16x8*)(ldsK + ka[ks] + kb * 8192);
                    z = __builtin_amdgcn_mfma_f32_32x32x16_bf16(kf, qf[ks], z, 0, 0, 0);
                }
                float l1m[16];
#pragma unroll
                for (int r = 0; r < 16; ++r) {
                    const float zz = z[r];
                    const float sp = fmaxf(zz, 0.f) + flog2(1.0f + fexp2(-fabsf(zz)));
                    const int kp = kt0 + kb * 32 + (r & 3) + 8 * (r >> 2) + 4 * hh;
                    const bool ok = !need_mask || (kp < qpos);
                    l1m[r] = ok ? -sp : 0.f;
                    z[r] = ok ? zz : -1e30f;
                }
                float gs[4], pgs[4];
#pragma unroll
                for (int g = 0; g < 4; ++g) { gs[g] = (l1m[4 * g] + l1m[4 * g + 1]) + (l1m[4 * g + 2] + l1m[4 * g + 3]); pgs[g] = __shfl_xor(gs[g], 32); }
                float tail = 0.f;
#pragma unroll
                for (int g = 3; g >= 0; --g) {
                    const float sg = R + tail + (hh == 0 ? pgs[g] : 0.f);
                    const float e2 = l1m[4 * g + 3], e1 = e2 + l1m[4 * g + 2], e0 = e1 + l1m[4 * g + 1];
                    z[4 * g + 3] = fexp2(z[4 * g + 3] + l1m[4 * g + 3] + sg);
                    z[4 * g + 2] = fexp2(z[4 * g + 2] + l1m[4 * g + 2] + sg + e2);
                    z[4 * g + 1] = fexp2(z[4 * g + 1] + l1m[4 * g + 1] + sg + e1);
                    z[4 * g + 0] = fexp2(z[4 * g + 0] + l1m[4 * g + 0] + sg + e0);
                    tail += gs[g] + pgs[g];
                }
                R += tail;
#pragma unroll
                for (int s2 = 0; s2 < 2; ++s2) {
                    u32x4 pw; pw.x = cvt_pk_bf16(z[8 * s2 + 0], z[8 * s2 + 1]); pw.y = cvt_pk_bf16(z[8 * s2 + 2], z[8 * s2 + 3]);
                    pw.z = cvt_pk_bf16(z[8 * s2 + 4], z[8 * s2 + 5]); pw.w = cvt_pk_bf16(z[8 * s2 + 6], z[8 * s2 + 7]);
                    bf16x8 pf; __builtin_memcpy(&pf, &pw, 16);
#pragma unroll
                    for (int dvb = 0; dvb < 4; ++dvb) {
                        const bf16x8 vf = *(const bf16x8*)(ldsV + va[kb * 2 + s2] + dvb * 4096);
                        oacc[dvb] = __builtin_amdgcn_mfma_f32_32x32x16_bf16(vf, pf, oacc[dvb], 0, 0, 0);
                    }
                }
            }
        }
        const bool wdone = __all(R < -160.0f);
        if (lane == 0) flags[wid] = wdone ? 1 : 0;
        __syncthreads();
        const bool alldone = (flags[0] & flags[1] & flags[2] & flags[3]) != 0;
        if (alldone || !more) break;
        ksg.write(ldsK); vsg.write(ldsV);
        __syncthreads();
    }
    __syncthreads();
    float ss = 0.f;
    unsigned char* ot = lds + (wid * 32 + l31) * OT_STRIDE;
#pragma unroll
    for (int i = 0; i < 4; ++i)
#pragma unroll
        for (int rq = 0; rq < 4; ++rq) {
            const float v0 = oacc[i][rq * 4], v1 = oacc[i][rq * 4 + 1], v2 = oacc[i][rq * 4 + 2], v3 = oacc[i][rq * 4 + 3];
            ss += v0 * v0 + v1 * v1 + v2 * v2 + v3 * v3;
            u32x2 w; w.x = cvt_pk_bf16(v0, v1); w.y = cvt_pk_bf16(v2, v3);
            *(u32x2*)(ot + (i * 32 + 8 * rq + 4 * hh) * 2) = w;
        }
    ss += __shfl_xor(ss, 32); if (sq && hh == 0) sq_add(sq, tok0 + qpos, ss);
    __syncthreads();
#pragma unroll
    for (int i = 0; i < 8; ++i) {
        const int c = tid + i * NTHREADS, row = c >> 4, ch = c & 15;
        const u32x4 w = *(const u32x4*)(lds + row * OT_STRIDE + ch * 16);
        *(u32x4*)(O + (size_t)(U * 128 + row) * 2048 + ch * 8) = w;
    }
    __syncthreads();
}


template <class RowF>
DEV void transpose_item8(const float* src, int N, u8* dst, int ldd, int k0, int n0, int lane, RowF dstrow) {
    const int ln = lane & 7, lk = lane >> 3, k = k0 + lk * 16, n = n0 + ln * 4;
    f32x4 v[16];
#pragma unroll
    for (int kk = 0; kk < 16; ++kk) v[kk] = *(const f32x4*)(src + (size_t)(k + kk) * N + n) * W8_SCALE;
#pragma unroll
    for (int j = 0; j < 4; ++j) {
        u32x4 w; w.x = pack_fp8x4(v[0][j], v[1][j], v[2][j], v[3][j]); w.y = pack_fp8x4(v[4][j], v[5][j], v[6][j], v[7][j]);
        w.z = pack_fp8x4(v[8][j], v[9][j], v[10][j], v[11][j]); w.w = pack_fp8x4(v[12][j], v[13][j], v[14][j], v[15][j]);
        st16u(dst + (size_t)dstrow(n + j) * ldd + k, w);
    }
}
DEV void moe_convert(const P& p, int gw, int ngw, int lane) {
    unsigned char* ws = p.ws;
    constexpr int I_G = 16 * 16, I_E = 2 * I_G, NITEMS = 32 * I_E;
    for (int it = gw; it < NITEMS; it += ngw) {
        const int e = it / I_E; int r = it - e * I_E;
        u8* gu = (u8*)(ws + WS_WGU) + (size_t)e * 1024 * 2048;
        const int up = r >= I_G; if (up) r -= I_G; const int kt = r / 16, nt = r % 16;
        const float* src = (up ? p.w_up : p.w_gate) + (size_t)e * 2048 * 512;
        transpose_item8(src, 512, gu, 2048, kt * 128, nt * 32, lane,
            [up](int c) { const int t = c >> 6, rr = c & 63, wc = rr >> 5, r32 = rr & 31, fq = r32 >> 3, q = (r32 >> 2) & 1, rg = r32 & 3; return t * 128 + wc * 64 + fq * 16 + (2 * q + up) * 4 + rg; });
    }
}
DEV void moe_convert_down(const P& p, int gw, int ngw, int lane) {
    unsigned char* ws = p.ws;
    constexpr int I_D = 4 * 64, NITEMS = 32 * I_D;
    for (int it = gw; it < NITEMS; it += ngw) {
        const int e = it / I_D, r = it - e * I_D, kt = r / 64, nt = r % 64;
        transpose_item8(p.w_down + (size_t)e * 512 * 2048, 2048, (u8*)(ws + WS_WD) + (size_t)e * 2048 * 512, 512, kt * 128, nt * 32, lane, [](int n) { return n; });
    }
}
DEV void phase3(const P& p, unsigned char* lds, bool dry = false) {
    unsigned char* ws = p.ws;
    u64* sqb = (u64*)(ws + CTL_SQ);
    bf16_t* omix = (bf16_t*)(ws + WS_OMIX);
    const int G = gridDim.x;
    volatile int* rolew = (volatile int*)(lds + LDS_MAIN + 128);
    if (threadIdx.x == 0) {
        const unsigned hw = (unsigned)__builtin_amdgcn_s_getreg(((8 - 1) << 11) | (8 << 6) | 4);
        const unsigned slot = atomicAdd((unsigned*)(ws + CTL_CU) + (xb_xcc_id() & 7u) * 256u + (hw & 255u), 1u);
        rolew[0] = (int)(slot & 1u);
    }
    __syncthreads();
    const bool conv_first = rolew[0] != 0;
    const int cgw = (int)blockIdx.x * 4 + (tidf() >> 6), cngw = G * 4;
    if (!dry) late_convert(p, cgw, cngw, tidf() & 63);
    if (conv_first && !dry) moe_convert(p, cgw, cngw, tidf() & 63);
    for (int w0 = blockIdx.x; w0 < 512; w0 += G) {
        const int w = ((G & 7) == 0 && G >= 64) ? ((((w0 & 7) * 2 + ((w0 >> 3) >> 5)) & 15) * 32 + ((w0 >> 3) & 31)) : w0;
        const int bh = w >> 5, uu = w & 31, b = bh >> 3, h = bh & 7;
#pragma unroll 1
        for (int half = 0; half < 2; ++half) {
            const int u = half ? (63 - uu) : uu;
            attn_unit<192, true>(lds, (const bf16_t*)(ws + WS_QM) + (size_t)bh * S * 192, (const bf16_t*)(ws + WS_KN) + (size_t)bh * S * 128,
                                 (const bf16_t*)(ws + WS_KPE) + (size_t)b * S * 64, (const bf16_t*)(ws + WS_VMT) + (size_t)bh * 128 * S, S, u * 64, u + 1,
                                 omix + (size_t)b * S * 2048 + h * 128, 2048, dry ? nullptr : sqb + SQ_OMLA * T + b * S, u * 64);
        }
    }
    for (int w0 = blockIdx.x; w0 < 512; w0 += G) {
        const int w = ((G & 7) == 0 && G >= 64) ? ((((w0 & 7) * 2 + ((w0 >> 3) >> 5)) & 15) * 32 + ((w0 >> 3) & 31)) : w0;
        const int bh = w >> 5, U = w & 31, b = bh >> 3, h = bh & 7;
        sb_unit(lds, (const bf16_t*)(ws + WS_QSB) + (size_t)bh * S * 128, (const bf16_t*)(ws + WS_KSB) + (size_t)bh * S * 128,
                (const bf16_t*)(ws + WS_VSBT) + (size_t)bh * 128 * S, U, omix + (size_t)b * S * 2048 + 1024 + h * 128, dry ? nullptr : sqb + SQ_OSB * T, b * S);
    }
    if (!conv_first && !dry) moe_convert(p, cgw, cngw, tidf() & 63);
}


template <int ABL>
DEV void phase3_dry(const P& p, unsigned char* lds) {
    unsigned char* ws = p.ws;
    const int G = gridDim.x;
    for (int w0 = blockIdx.x; w0 < 512; w0 += G) {
        const int w = ((G & 7) == 0 && G >= 64) ? ((((w0 & 7) * 2 + ((w0 >> 3) >> 5)) & 15) * 32 + ((w0 >> 3) & 31)) : w0;
        const int bh = w >> 5, uu = w & 31, b = bh >> 3;
#pragma unroll 1
        for (int half = 0; half < 2; ++half) {
            const int u = half ? (63 - uu) : uu;
            attn_unit<192, true, ABL>(lds, (const bf16_t*)(ws + WS_QM) + (size_t)bh * S * 192, (const bf16_t*)(ws + WS_KN) + (size_t)bh * S * 128,
                                 (const bf16_t*)(ws + WS_KPE) + (size_t)b * S * 64, (const bf16_t*)(ws + WS_VMT) + (size_t)bh * 128 * S, S, u * 64, u + 1,
                                 nullptr, 2048, nullptr, u * 64);
        }
    }
}
DEV void phase4(const P& p, unsigned char* lds, bool dry = false) {
    unsigned char* ws = p.ws;
    const XcdIter xi = xcd_iter();
    const int lane = tidf() & 63, wid = tidf() >> 6, wr = wid >> 1, wc = wid & 1, fr = lane & 15, fq = lane >> 4;
    u64* sqb = (u64*)(ws + CTL_SQ);
    bf16_t* x1b = (bf16_t*)(ws + WS_X1B);
    const int per_x = 8 * 16, total = 64 * 16;
    auto tile_at = [&](int it, int& mt, int& nt) -> bool {
        if (xi.x >= 0) { const int i = it * xi.per + xi.j; if (i >= per_x) return false; mt = xi.x * 8 + (i & 7); nt = i >> 3; }
        else { const int i = it * xi.per + xi.j; if (i >= total) return false; mt = i & 63; nt = i >> 6; }
        return true; };
    GemmPipe gp{0, false};
    int mt, nt; bool have = tile_at(0, mt, nt);
    if (!have) return;
    GT cur = gt_dense((const bf16_t*)(ws + WS_OMIX), D, mt * 128, (const bf16_t*)(ws + WS_WOUT), D, nt * 128, 0);
    for (int it = 0; have; ++it) {
        int mtn, ntn; const bool hn = tile_at(it + 1, mtn, ntn);
        const int m0 = mt * 128;
        const GT cur2 = gt_dense((const bf16_t*)(ws + WS_OMIX), D, m0, (const bf16_t*)(ws + WS_WOUT), D, nt * 128, 1024);
        GT nx = cur; if (hn) nx = gt_dense((const bf16_t*)(ws + WS_OMIX), D, mtn * 128, (const bf16_t*)(ws + WS_WOUT), D, ntn * 128, 0);
        f32x4 acc[4][4]; acc_zero(acc);
        gemm_run(acc, lds, cur, 16, true, gp, cur2, true);
        float rsb[4];
#pragma unroll
        for (int j = 0; j < 4; ++j) {
            const int m = m0 + wr * 64 + j * 16 + fr;
            const float ra = sq_rs(sqb + SQ_OMLA * T, m, 1.0f / 1024.0f); rsb[j] = sq_rs(sqb + SQ_OSB * T, m, 1.0f / 1024.0f);
            const float ratio = ra / rsb[j];
#pragma unroll
            for (int i = 0; i < 4; ++i) acc[i][j] *= ratio;
        }
        gemm_run(acc, lds, cur2, 16, true, gp, nx, hn);
#pragma unroll
        for (int j = 0; j < 4; ++j) {
            const int m = m0 + wr * 64 + j * 16 + fr; float ss = 0.f;
            const int n0 = nt * 128 + wc * 64 + fq * 16;
            f32x4 vv[4];
#pragma unroll
            for (int i = 0; i < 4; ++i) {
                const f32x4 xv = *(const f32x4*)(p.x + (size_t)m * D + n0 + i * 4);
                const f32x4 v = xv + acc[i][j] * rsb[j];
                ss += v[0] * v[0] + v[1] * v[1] + v[2] * v[2] + v[3] * v[3];
                vv[i] = v;
            }
            st_bf16x16(x1b + (size_t)m * D + n0, vv[0], vv[1], vv[2], vv[3]);
            ss += __shfl_xor(ss, 16); ss += __shfl_xor(ss, 32); if (fq == 0 && !dry) sq_add(sqb + SQ_X1 * T, m, ss);
        }
        cur = nx; mt = mtn; nt = ntn; have = hn;
    }
}

DEV void phase5(const P& p, unsigned char* lds) {
    unsigned char* ws = p.ws;
    const XcdIter xi = xcd_iter();
    const int lane = tidf() & 63, wid = tidf() >> 6, wr = wid >> 1, wc = wid & 1, fr = lane & 15, fq = lane >> 4;
    const u64* sqb = (const u64*)(ws + CTL_SQ);
    const int per_x = 8 * 4 + 4, total = 64 * 4 + 32;
    {
        const int my = xi.j, nbusy = ((xi.x >= 0 ? per_x : total) + xi.per - 1) / xi.per > 1 ? xi.per : (xi.x >= 0 ? per_x : total);
        const int lists = xi.x >= 0 ? 8 : 1, nidle = (xi.per - nbusy) * lists;
        if (nidle > 0) { if (my >= nbusy) moe_convert_down(p, ((my - nbusy) * lists + (xi.x >= 0 ? xi.x : 0)) * 4 + (tidf() >> 6), nidle * 4, tidf() & 63); }
        else moe_convert_down(p, (int)blockIdx.x * 4 + (tidf() >> 6), (int)gridDim.x * 4, tidf() & 63);
    }
    for (int it = 0;; ++it) {
        int mt, nt; bool memkv = false;
        if (xi.x >= 0) { const int i = it * xi.per + xi.j; if (i >= per_x) break;
            if (i < 32) { mt = xi.x * 8 + (i & 7); nt = i >> 3; } else { memkv = true; const int q = xi.x * 4 + (i - 32); mt = q & 3; nt = q >> 2; } }
        else { const int i = it * xi.per + xi.j; if (i >= total) break;
            if (i < 256) { mt = i & 63; nt = i >> 6; } else { memkv = true; const int q = i - 256; mt = q & 3; nt = q >> 2; } }
        const int m0 = mt * 128, b = m0 >> 12, s0 = m0 & 4095;
        f32x4 acc[4][4]; acc_zero(acc);
        if (memkv) {
            const bool isv = nt >= 4;
            gemm_dense(acc, lds, (const bf16_t*)(ws + WS_MEMN), D, mt * 128, (const bf16_t*)(ws + WS_WMKV), D, nt * 128, 0, 32, !isv);
            const int bb = mt >> 1, mm0 = (mt & 1) * 128;
            if (!isv) store_rowmajor_sq(acc, (bf16_t*)(ws + WS_KMEM) + (size_t)((bb * 4 + nt) * 256) * 128, 128, mm0, 0, nullptr, 1.0f);
            else store_transposed(acc, (bf16_t*)(ws + WS_VMEMT) + (size_t)((bb * 4 + (nt - 4)) * 128) * 256, 256, mm0, nullptr, 0, 0.f);
            continue;
        }
        gemm_dense(acc, lds, (const bf16_t*)(ws + WS_X1B), D, m0, (const bf16_t*)(ws + WS_WMQ), D, nt * 128, 0, 32, true);
        bf16_t* qm = (bf16_t*)(ws + WS_QMEM) + (size_t)((b * 4 + nt) * S) * 128;
#pragma unroll
        for (int j = 0; j < 4; ++j) {
            const int ml = wr * 64 + j * 16 + fr;
            const float rs = sq_rs(sqb + SQ_X1 * T, m0 + ml, 1.0f / 2048.0f) * (0.08838834764831845f * LOG2E);
            st_bf16x16(qm + (size_t)(s0 + ml) * 128 + wc * 64 + fq * 16, acc[0][j] * rs, acc[1][j] * rs, acc[2][j] * rs, acc[3][j] * rs);
        }
    }
}

DEV void phase6(const P& p, unsigned char* lds) {
    unsigned char* ws = p.ws;
    for (int w = blockIdx.x; w < 512; w += gridDim.x) {
        const int bh = w >> 6, u = w & 63, b = bh >> 2, h = bh & 3;
        attn_unit<128, false>(lds, (const bf16_t*)(ws + WS_QMEM) + (size_t)bh * S * 128, (const bf16_t*)(ws + WS_KMEM) + (size_t)bh * 256 * 128, nullptr,
                              (const bf16_t*)(ws + WS_VMEMT) + (size_t)bh * 128 * 256, 256, u * 64, 4,
                              (bf16_t*)(ws + WS_OMEM) + (size_t)b * S * 512 + h * 128, 512, nullptr, u * 64);
    }
}

DEV void phase7(const P& p, unsigned char* lds, bool dry = false) {
    unsigned char* ws = p.ws;
    const XcdIter xi = xcd_iter();
    const int lane = tidf() & 63, wid = tidf() >> 6, wr = wid >> 1, wc = wid & 1, fr = lane & 15, fq = lane >> 4;
    u64* sqb = (u64*)(ws + CTL_SQ);
    const bf16_t* x1b = (const bf16_t*)(ws + WS_X1B); u8* x2f8 = (u8*)(ws + WS_X2B);
    const int per_x = 8 * 16, total = 64 * 16;
    auto tile_at = [&](int it, int& mt, int& nt) -> bool {
        if (xi.x >= 0) { const int i = it * xi.per + xi.j; if (i >= per_x) return false; mt = xi.x * 8 + (i & 7); nt = i >> 3; }
        else { const int i = it * xi.per + xi.j; if (i >= total) return false; mt = i & 63; nt = i >> 6; }
        return true; };
    GemmPipe gp{0, false};
    int mt, nt; bool have = tile_at(0, mt, nt);
    if (!have) return;
    GT cur = gt_dense((const bf16_t*)(ws + WS_OMEM), 512, mt * 128, (const bf16_t*)(ws + WS_WMO), 512, nt * 128, 0);
    for (int it = 0; have; ++it) {
        int mtn, ntn; const bool hn = tile_at(it + 1, mtn, ntn);
        GT nx = cur; if (hn) nx = gt_dense((const bf16_t*)(ws + WS_OMEM), 512, mtn * 128, (const bf16_t*)(ws + WS_WMO), 512, ntn * 128, 0);
        const int m0 = mt * 128;
        f32x4 acc[4][4]; acc_zero(acc);
        gemm_run(acc, lds, cur, 8, true, gp, nx, hn);
#pragma unroll
        for (int j = 0; j < 4; ++j) {
            const int m = m0 + wr * 64 + j * 16 + fr; float ss = 0.f;
            const int n0 = nt * 128 + wc * 64 + fq * 16;
            const u32x4 xb0 = *(const u32x4*)(x1b + (size_t)m * D + n0), xb1 = *(const u32x4*)(x1b + (size_t)m * D + n0 + 8);
            const unsigned xw[8] = {xb0.x, xb0.y, xb0.z, xb0.w, xb1.x, xb1.y, xb1.z, xb1.w};
            u32x4 f8;
#pragma unroll
            for (int i = 0; i < 4; ++i) {
                const int n = n0 + i * 4;
                const f32x4 v = (f32x4){__uint_as_float(xw[2 * i] << 16), __uint_as_float(xw[2 * i] & 0xffff0000u), __uint_as_float(xw[2 * i + 1] << 16), __uint_as_float(xw[2 * i + 1] & 0xffff0000u)} + acc[i][j];
                ss += v[0] * v[0] + v[1] * v[1] + v[2] * v[2] + v[3] * v[3];
                st16f(p.out + (size_t)m * D + n, v);
                const f32x4 gf = *(const f32x4*)(p.norm_ffn + n);
                f8[i] = pack_fp8x4_sat(v[0] * gf[0], v[1] * gf[1], v[2] * gf[2], v[3] * gf[3]);
            }
            *(u32x4*)(x2f8 + (size_t)m * D + n0) = f8;
            ss += __shfl_xor(ss, 16); ss += __shfl_xor(ss, 32); if (fq == 0 && !dry) sq_add(sqb + SQ_X2 * T, m, ss);
        }
        cur = nx; mt = mtn; nt = ntn; have = hn;
    }
}

DEV void phase8(const P& p, unsigned char* lds) {
    unsigned char* ws = p.ws;
    const int tid = tidf(), lane = tid & 63, wid = tid >> 6, r16 = lane & 15, kq = lane >> 4;
    const u64* sqb = (const u64*)(ws + CTL_SQ);
    unsigned* cnt = (unsigned*)(ws + CTL_CNT);
    unsigned char* rt = ws + WS_ROUTE;
    float* red = (float*)lds;
    for (int tb = blockIdx.x; tb < T / 16; tb += gridDim.x) {
        const int t0 = tb * 16;
        f32x4 acc[3];
#pragma unroll
        for (int c = 0; c < 3; ++c) acc[c] = (f32x4){0.f, 0.f, 0.f, 0.f};
        const float* xa = p.out + (size_t)(t0 + r16) * D + wid * 512 + kq * 8;
        const bf16_t* wh = (const bf16_t*)(ws + WS_WR) + (size_t)r16 * D + wid * 512 + kq * 8;
        const bf16_t* wl = wh + 48 * 2048;
#pragma unroll 4
        for (int k = 0; k < 512; k += 32) {
            const f32x4 a0 = *(const f32x4*)(xa + k), a1 = *(const f32x4*)(xa + k + 4);
            u32x4 hw, lw;
            hw.x = cvt_pk_bf16(a0[0], a0[1]); hw.y = cvt_pk_bf16(a0[2], a0[3]); hw.z = cvt_pk_bf16(a1[0], a1[1]); hw.w = cvt_pk_bf16(a1[2], a1[3]);
            lw.x = cvt_pk_bf16(a0[0] - __uint_as_float(hw.x << 16), a0[1] - __uint_as_float(hw.x & 0xffff0000u));
            lw.y = cvt_pk_bf16(a0[2] - __uint_as_float(hw.y << 16), a0[3] - __uint_as_float(hw.y & 0xffff0000u));
            lw.z = cvt_pk_bf16(a1[0] - __uint_as_float(hw.z << 16), a1[1] - __uint_as_float(hw.z & 0xffff0000u));
            lw.w = cvt_pk_bf16(a1[2] - __uint_as_float(hw.w << 16), a1[3] - __uint_as_float(hw.w & 0xffff0000u));
            bf16x8 xh, xl; __builtin_memcpy(&xh, &hw, 16); __builtin_memcpy(&xl, &lw, 16);
#pragma unroll
            for (int c = 0; c < 3; ++c) {
                const bf16x8 bh = *(const bf16x8*)(wh + (size_t)c * 16 * D + k), bl = *(const bf16x8*)(wl + (size_t)c * 16 * D + k);
                acc[c] = __builtin_amdgcn_mfma_f32_16x16x32_bf16(xh, bh, acc[c], 0, 0, 0);
                acc[c] = __builtin_amdgcn_mfma_f32_16x16x32_bf16(xh, bl, acc[c], 0, 0, 0);
                acc[c] = __builtin_amdgcn_mfma_f32_16x16x32_bf16(xl, bh, acc[c], 0, 0, 0);
            }
        }
#pragma unroll
        for (int c = 0; c < 3; ++c)
#pragma unroll
            for (int e = 0; e < 4; ++e) red[(wid * 16 + kq * 4 + e) * 48 + c * 16 + r16] = acc[c][e];
        __syncthreads();
        if (tid < 16) {
            const int tok = t0 + tid;
            const float rs = sq_rs(sqb + SQ_X2 * T, tok, 1.0f / 2048.0f);
            auto logit = [&](int n) { return ((red[(0 * 16 + tid) * 48 + n] + red[(1 * 16 + tid) * 48 + n]) + (red[(2 * 16 + tid) * 48 + n] + red[(3 * 16 + tid) * 48 + n])) * rs; };
            float lg0 = logit(0) + p.b_group[0], lg1 = logit(1) + p.b_group[1], lg2 = logit(2) + p.b_group[2], lg3 = logit(3) + p.b_group[3];
            int g = 0; float gm = lg0;
            if (lg1 > gm) { gm = lg1; g = 1; }
            if (lg2 > gm) { gm = lg2; g = 2; }
            if (lg3 > gm) { gm = lg3; g = 3; }
            const float gden = __expf(lg0 - gm) + __expf(lg1 - gm) + __expf(lg2 - gm) + __expf(lg3 - gm);
            const float pg = 1.0f / gden;
            float el[8];
#pragma unroll
            for (int e = 0; e < 8; ++e) el[e] = logit(4 + g * 8 + e) + p.b_er[g * 8 + e];
            int e1 = 0; float m1 = el[0];
#pragma unroll
            for (int e = 1; e < 8; ++e) if (el[e] > m1) { m1 = el[e]; e1 = e; }
            int e2 = -1; float m2 = -3.0e38f;
#pragma unroll
            for (int e = 0; e < 8; ++e) if (e != e1 && el[e] > m2) { m2 = el[e]; e2 = e; }
            const float x2e = __expf(m2 - m1);
            const float p1 = 1.0f / (1.0f + x2e), p2 = x2e / (1.0f + x2e);
            const int ex1 = g * 8 + e1, ex2 = g * 8 + e2;
            const unsigned pos1 = atomicAdd(cnt + ex1 * 64, 1u), pos2 = atomicAdd(cnt + ex2 * 64, 1u);
            int* rexp = (int*)(rt + RT_EXP); int* rpos = (int*)(rt + RT_POS); float* rgate = (float*)(rt + RT_GATE); int* rlist = (int*)(rt + RT_LIST);
            rexp[tok * 2] = ex1; rexp[tok * 2 + 1] = ex2; rpos[tok * 2] = (int)pos1; rpos[tok * 2 + 1] = (int)pos2;
            rgate[tok * 2] = pg * p1; rgate[tok * 2 + 1] = pg * p2;
            rlist[ex1 * T + pos1] = tok * 2; rlist[ex2 * T + pos2] = tok * 2 + 1;
        }
        __syncthreads();
    }
}

DEV int moe_table(const P& p, int* tbl  ) {
    const unsigned* cnt = (const unsigned*)(p.ws + CTL_CNT);
    if (tidf() < 64) {
        const int e = tidf() & 31;
        const int c = (int)__hip_atomic_load(cnt + e * 64, __ATOMIC_RELAXED, __HIP_MEMORY_SCOPE_AGENT);
        const int nt = (c + 127) >> 7;
        int incl = nt;
#pragma unroll
        for (int o = 1; o < 32; o <<= 1) { const int v = __shfl_up(incl, o, 32); if (e >= o) incl += v; }
        if (tidf() < 32) { tbl[e] = incl - nt; tbl[33 + e] = c; if (e == 31) tbl[32] = incl; }
    }
    __syncthreads();
    return tbl[32];
}
DEV int moe_find(const int* tbl, int mtile) { int e = 0;
#pragma unroll 1
    for (int k = 16; k >= 1; k >>= 1) if (e + k < 32 && tbl[e + k] <= mtile) e += k;
    return e; }

DEV void phase9(const P& p, unsigned char* lds) {
    unsigned char* ws = p.ws;
    int* tbl = (int*)(lds + LDS_MAIN + 256);
    const int ntm = moe_table(p, tbl);
    const int tid = tidf(), lane = tid & 63, wid = tid >> 6, wr = wid >> 1, wc = wid & 1, fr = lane & 15, fq = lane >> 4;
    const int srow = tid >> 3, sc = stage_col(tid) * 2;
    const u64* sqb = (const u64*)(ws + CTL_SQ);
    const int* rlist = (const int*)(ws + WS_ROUTE + RT_LIST); const float* rgate = (const float*)(ws + WS_ROUTE + RT_GATE);
    const u8* x2f8 = (const u8*)(ws + WS_X2B);
    u8* act = (u8*)(ws + WS_ACT);
    auto desc = [&](int item) -> GT8 {
        const int mtile = item >> 3, nt = item & 7;
        const int e = moe_find(tbl, mtile), mi = mtile - tbl[e], cnt = tbl[33 + e];
        const int* le = rlist + (size_t)e * T;
        GT8 t;
#pragma unroll
        for (int i = 0; i < 4; ++i) { int li = mi * 128 + srow + 32 * i; li = li < cnt ? li : cnt - 1; t.a[i] = x2f8 + (size_t)(le[li] >> 1) * D + sc; }
        const u8* bp = (const u8*)(ws + WS_WGU) + ((size_t)e * 1024 + nt * 128) * D + sc;
#pragma unroll
        for (int i = 0; i < 4; ++i) t.b[i] = bp + (size_t)bperm(srow + 32 * i) * D;
        return t; };
    GemmPipe gp{0, false};
    const int nitems = ntm * 8;
    if ((int)blockIdx.x >= nitems) return;
    GT8 cur = desc(blockIdx.x);
    for (int item = blockIdx.x; item < nitems; item += gridDim.x) {
        const int mtile = item >> 3, nt = item & 7;
        const int e = moe_find(tbl, mtile), mi = mtile - tbl[e], cnt = tbl[33 + e];
        const int* le = rlist + (size_t)e * T;
        const bool hn = item + (int)gridDim.x < nitems;
        GT8 nx = cur; if (hn) nx = desc(item + gridDim.x);
        f32x4 acc[4][4]; acc_zero(acc);
        float rsj[4], gtj[4];
#pragma unroll
        for (int j = 0; j < 4; ++j) {
            int li = mi * 128 + wr * 64 + j * 16 + fr; li = li < cnt ? li : cnt - 1;
            const int ent = le[li];
            rsj[j] = sq_rs(sqb + SQ_X2 * T, ent >> 1, 1.0f / 2048.0f); gtj[j] = rgate[ent];
        }
        gemm_run8(acc, lds, cur, 16, gp, nx, hn);
#pragma unroll
        for (int j = 0; j < 4; ++j) {
            const int ml = wr * 64 + j * 16 + fr;
            const float rs = rsj[j] * (1.0f / W8_SCALE), gt = gtj[j] * ACT8_SCALE;
            u32x2 aw;
#pragma unroll
            for (int q = 0; q < 2; ++q) {
                const f32x4 a = acc[2 * q][j] * rs, u = acc[2 * q + 1][j] * rs;
                float o[4];
#pragma unroll
                for (int c = 0; c < 4; ++c) o[c] = a[c] / (1.0f + __expf(-a[c])) * u[c] * gt;
                aw[q] = pack_fp8x4_sat(o[0], o[1], o[2], o[3]);
            }
            *(u32x2*)(act + (size_t)(mtile * 128 + ml) * 512 + nt * 64 + wc * 32 + fq * 8) = aw;
        }
        cur = nx;
    }
}

DEV void phase10(const P& p, unsigned char* lds) {
    unsigned char* ws = p.ws;
    int* tbl = (int*)(lds + LDS_MAIN + 256);
    const int ntm = moe_table(p, tbl);
    const int tid = tidf(), lane = tid & 63, wid = tid >> 6, wr = wid >> 1, wc = wid & 1, fr = lane & 15, fq = lane >> 4;
    const int* rlist = (const int*)(ws + WS_ROUTE + RT_LIST);
    bf16_t* y = (bf16_t*)(ws + WS_Y);
    const int srow = tid >> 3, sc = stage_col(tid) * 2;
    auto desc = [&](int item) -> GT8 {
        const int mtile = item >> 4, nt = item & 15;
        const int e = moe_find(tbl, mtile);
        GT8 t;
        const u8* a = (const u8*)(ws + WS_ACT) + (size_t)(mtile * 128 + srow) * 512 + sc;
        const u8* b = (const u8*)(ws + WS_WD) + ((size_t)e * 2048 + nt * 128) * 512 + sc;
#pragma unroll
        for (int i = 0; i < 4; ++i) { t.a[i] = a + (size_t)(32 * i) * 512; t.b[i] = b + (size_t)bperm(srow + 32 * i) * 512; }
        return t; };
    GemmPipe gp{0, false};
    const int nitems = ntm * 16;
    if ((int)blockIdx.x >= nitems) return;
    GT8 cur = desc(blockIdx.x);
    for (int item = blockIdx.x; item < nitems; item += gridDim.x) {
        const int mtile = item >> 4, nt = item & 15;
        const int e = moe_find(tbl, mtile), mi = mtile - tbl[e], cnt = tbl[33 + e];
        const int* le = rlist + (size_t)e * T;
        const bool hn = item + (int)gridDim.x < nitems;
        GT8 nx = cur; if (hn) nx = desc(item + gridDim.x);
        f32x4 acc[4][4]; acc_zero(acc);
        int entj[4];
#pragma unroll
        for (int j = 0; j < 4; ++j) { const int li = mi * 128 + wr * 64 + j * 16 + fr; entj[j] = li < cnt ? le[li] : -1; }
        gemm_run8(acc, lds, cur, 4, gp, nx, hn);
#pragma unroll
        for (int j = 0; j < 4; ++j) {
            if (entj[j] >= 0) {
                const int ent = entj[j], tok = ent >> 1, k = ent & 1;
                const float ys = 1.0f / (W8_SCALE * ACT8_SCALE);
                st_bf16x16(y + ((size_t)k * T + tok) * D + nt * 128 + wc * 64 + fq * 16, acc[0][j] * ys, acc[1][j] * ys, acc[2][j] * ys, acc[3][j] * ys);
            }
        }
        cur = nx;
    }
}

DEV void phase11(const P& p, float probe_c) {
    const int lane = tidf() & 63, gw = blockIdx.x * 4 + (tidf() >> 6), NGW = gridDim.x * 4;
    const bf16_t* y = (const bf16_t*)(p.ws + WS_Y);
    for (int row = gw; row < T; row += NGW) {
        float* xr = p.out + (size_t)row * D;
        const bf16_t* y0 = y + (size_t)row * D; const bf16_t* y1 = y + ((size_t)T + row) * D;
        f32x4 v[8]; float s = 0.f;
#pragma unroll
        for (int i = 0; i < 8; ++i) {
            const int c = i * 256 + lane * 4;
            v[i] = *(const f32x4*)(xr + c);
            const u32x2 a = *(const u32x2*)(y0 + c), b = *(const u32x2*)(y1 + c);
            v[i][0] += __uint_as_float(a.x << 16) + __uint_as_float(b.x << 16);
            v[i][1] += __uint_as_float(a.x & 0xffff0000u) + __uint_as_float(b.x & 0xffff0000u);
            v[i][2] += __uint_as_float(a.y << 16) + __uint_as_float(b.y << 16);
            v[i][3] += __uint_as_float(a.y & 0xffff0000u) + __uint_as_float(b.y & 0xffff0000u);
            s += v[i][0] * v[i][0] + v[i][1] * v[i][1] + v[i][2] * v[i][2] + v[i][3] * v[i][3];
        }
        s = wave_sum(s);
        const float rs = __builtin_amdgcn_rsqf(s * (1.0f / 2048.0f) + EPS);
#pragma unroll
        for (int i = 0; i < 8; ++i) {
            const int c = i * 256 + lane * 4;
            const f32x4 g = *(const f32x4*)(p.norm_final + c);
#ifdef PROBE_CONST_OUT
            *(f32x4*)(xr + c) = (f32x4){probe_c, probe_c, probe_c, probe_c};
#else
            *(f32x4*)(xr + c) = v[i] * rs * g + probe_c;
#endif
        }
    }
}

DEV void phase11_dry(const P& p) {
    const int lane = tidf() & 63, gw = blockIdx.x * 4 + (tidf() >> 6), NGW = gridDim.x * 4;
    const bf16_t* y = (const bf16_t*)(p.ws + WS_Y);
    for (int row = gw; row < T; row += NGW) {
        float* xr = p.out + (size_t)row * D;
        const bf16_t* y0 = y + (size_t)row * D; const bf16_t* y1 = y + ((size_t)T + row) * D;
        f32x4 v[8]; float s = 0.f;
#pragma unroll
        for (int i = 0; i < 8; ++i) {
            const int c = i * 256 + lane * 4;
            v[i] = *(const f32x4*)(xr + c);
            const u32x2 a = *(const u32x2*)(y0 + c), b = *(const u32x2*)(y1 + c);
            v[i][0] += __uint_as_float(a.x << 16) + __uint_as_float(b.x << 16);
            v[i][1] += __uint_as_float(a.x & 0xffff0000u) + __uint_as_float(b.x & 0xffff0000u);
            v[i][2] += __uint_as_float(a.y << 16) + __uint_as_float(b.y << 16);
            v[i][3] += __uint_as_float(a.y & 0xffff0000u) + __uint_as_float(b.y & 0xffff0000u);
            s += v[i][0] * v[i][0] + v[i][1] * v[i][1] + v[i][2] * v[i][2] + v[i][3] * v[i][3];
        }
        s = wave_sum(s);
        const float rs = __builtin_amdgcn_rsqf(s * (1.0f / 2048.0f) + EPS);
#pragma unroll
        for (int i = 0; i < 8; ++i) {
            const int c = i * 256 + lane * 4;
            const f32x4 g = *(const f32x4*)(p.norm_final + c);
            { const f32x4 o = v[i] * rs * g; asm volatile("" :: "v"(o)); }
        }
    }
}

#ifndef USE_CG_SYNC
#define USE_CG_SYNC 0
#endif
__global__ void __launch_bounds__(NTHREADS, 2) hymba_fwd(P p) {
    extern __shared__ __attribute__((aligned(16))) unsigned char lds[];
#if USE_CG_SYNC
    cg::grid_group grid = cg::this_grid();
#endif
    volatile unsigned* st = (volatile unsigned*)(lds + LDS_MAIN);
    if (threadIdx.x < 16) st[threadIdx.x] = 0u;
    __syncthreads();
    XcdBarrier bar = xcd_barrier_post((unsigned*)(p.ws + CTL_BAR), st);
#if USE_CG_SYNC
#define GRID_BAR() grid.sync()
#else
#define GRID_BAR() xcd_barrier(bar)
#endif
#ifndef PROBE_REPEAT
#define PROBE_REPEAT 0
#endif
#define REP(n) ((PROBE_REPEAT >> (n)) & 1)
#ifndef PROBE_TIME
#define PROBE_TIME -1
#endif
#ifndef PROBE_SCALE
#define PROBE_SCALE 1e-7f
#endif
#ifndef PROBE_QUANT
#define PROBE_QUANT 1
#define PROBE_QOFF 0
#endif
    u64* tsw = (u64*)(p.ws + CTL_CNT + 12288);
#define STAMP(i) do { if (PROBE_TIME >= 0 && blockIdx.x == 0 && threadIdx.x == 0) tsw[i] = __builtin_amdgcn_s_memrealtime(); } while (0)
    STAMP(0);
    phase0(p);        GRID_BAR(); STAMP(1);
    if (REP(0)) { phase0(p); GRID_BAR(); }
    phase1(p, lds);   GRID_BAR(); STAMP(2);
#ifdef PROBE_DRY1
    STAMP(12); phase1_dry<PROBE_DRY1 - 1>(p, lds); GRID_BAR(); STAMP(13);
#endif
    if (REP(1)) { phase1(p, lds, true); GRID_BAR(); }
    phase2(p, lds);   GRID_BAR(); STAMP(3);
    if (REP(2)) { phase2(p, lds); GRID_BAR(); }
    phase3(p, lds);   GRID_BAR(); STAMP(4);
#ifdef PROBE_DRY3
    STAMP(12); phase3_dry<PROBE_DRY3 - 1>(p, lds); GRID_BAR(); STAMP(13);
#endif
    if (REP(3)) { phase3(p, lds, true); GRID_BAR(); }
    phase4(p, lds);   GRID_BAR(); STAMP(5);
    if (REP(4)) { phase4(p, lds, true); GRID_BAR(); }
    phase5(p, lds);   GRID_BAR(); STAMP(6);
    if (REP(5)) { phase5(p, lds); GRID_BAR(); }
    phase6(p, lds);   GRID_BAR(); STAMP(7);
    if (REP(6)) { phase6(p, lds); GRID_BAR(); }
    phase7(p, lds);   GRID_BAR(); STAMP(8);
    if (REP(7)) { phase7(p, lds, true); GRID_BAR(); }
    phase8(p, lds);   GRID_BAR(); STAMP(9);
    phase9(p, lds);   GRID_BAR(); STAMP(10);
    if (REP(9)) { phase9(p, lds); GRID_BAR(); }
    phase10(p, lds);  GRID_BAR(); STAMP(11);
#ifdef PROBE_DRY11
    STAMP(12); phase11_dry(p); GRID_BAR(); STAMP(13);
#endif
    if (REP(10)) { phase10(p, lds); GRID_BAR(); }
    float probe_c = 0.f;
    if (PROBE_TIME >= 0) { GRID_BAR(); const u64 dt = tsw[PROBE_TIME + 1] - tsw[PROBE_TIME]; probe_c = sqrtf((float)((dt + PROBE_QOFF) / PROBE_QUANT * PROBE_QUANT) * PROBE_SCALE); }
    phase11(p, probe_c);
#if USE_CG_SYNC
    grid.sync();
#endif
    (void)bar;
}

extern "C" void kernel_launch(void* const* d_in, const int* in_sizes, int n_in, void* d_out, int out_size, void* d_ws, size_t ws_size, hipStream_t stream) {
    static int grid = 0;
    if (grid == 0) {
        if (n_in != 26 || out_size != T * D || ws_size < WS_END) {
            fprintf(stderr, "kernel_launch: unexpected shapes: n_in %d out %d ws %zu (need %zu)\n", n_in, out_size, ws_size, (size_t)WS_END); grid = -1; return; }
        int dev = 0, cus = 0, per_cu = 0;
        hipGetDevice(&dev);
        hipDeviceGetAttribute(&cus, hipDeviceAttributeMultiprocessorCount, dev);
        if (hipFuncSetAttribute((const void*)hymba_fwd, hipFuncAttributeMaxDynamicSharedMemorySize, LDS_BYTES) != hipSuccess) { fprintf(stderr, "kernel_launch: hipFuncSetAttribute failed\n"); grid = -1; return; }
        if (hipOccupancyMaxActiveBlocksPerMultiprocessor(&per_cu, (const void*)hymba_fwd, NTHREADS, LDS_BYTES) != hipSuccess || per_cu < 1) { fprintf(stderr, "kernel_launch: occupancy query failed (%d)\n", per_cu); grid = -1; return; }
        if (per_cu > 2) per_cu = 2;
        grid = cus * per_cu;
        fprintf(stderr, "kernel_launch: %d CUs x %d blocks\n", cus, per_cu);
    }
    if (grid < 0) return;
    hipMemsetAsync(d_ws, 0, CTL_BYTES, stream);
    P p{};
    p.x = (const float*)d_in[0]; p.mem = (const float*)d_in[1]; p.pos = (const int*)d_in[2];
    p.norm_mix = (const float*)d_in[3]; p.w_in = (const float*)d_in[4]; p.norm_q_lat = (const float*)d_in[5]; p.w_q_b = (const float*)d_in[6];
    p.norm_kv_lat = (const float*)d_in[7]; p.w_kv_b = (const float*)d_in[8]; p.norm_mla_out = (const float*)d_in[9]; p.norm_sb_out = (const float*)d_in[10];
    p.w_out = (const float*)d_in[11]; p.norm_mem_x = (const float*)d_in[12]; p.norm_mem_src = (const float*)d_in[13]; p.w_mem_q = (const float*)d_in[14];
    p.w_mem_kv = (const float*)d_in[15]; p.w_mem_o = (const float*)d_in[16]; p.norm_ffn = (const float*)d_in[17]; p.w_group = (const float*)d_in[18];
    p.b_group = (const float*)d_in[19]; p.w_er = (const float*)d_in[20]; p.b_er = (const float*)d_in[21]; p.w_gate = (const float*)d_in[22];
    p.w_up = (const float*)d_in[23]; p.w_down = (const float*)d_in[24]; p.norm_final = (const float*)d_in[25];
    p.out = (float*)d_out; p.ws = (unsigned char*)d_ws;
    void* args[] = {&p};
    hipError_t e = hipLaunchCooperativeKernel((const void*)hymba_fwd, dim3(grid), dim3(NTHREADS), args, LDS_BYTES, stream);
    if (e != hipSuccess) fprintf(stderr, "kernel_launch: cooperative launch failed: %s (grid %d)\n", hipGetErrorString(e), grid);
}
```

```cpp
#include <hip/hip_runtime.h>
#include <hip/hip_cooperative_groups.h>
#include <cstdio>
#include <cstdint>
namespace cg = cooperative_groups;

typedef unsigned short bf16_t;
typedef short bf16x8 __attribute__((ext_vector_type(8)));
typedef float f32x4 __attribute__((ext_vector_type(4)));
typedef float f32x16 __attribute__((ext_vector_type(16)));
typedef unsigned u32x4 __attribute__((ext_vector_type(4)));
typedef unsigned u32x2 __attribute__((ext_vector_type(2)));
typedef unsigned long long u64;

#define DEV __device__ __forceinline__

constexpr int D = 2048, NB = 2, S = 4096, T = NB * S;
constexpr int MEML = 256, MT = NB * MEML;
constexpr int NIN = 3968;
constexpr float EPS = 1e-6f;
constexpr float LOG2E = 1.4426950408889634f;
constexpr int NTHREADS = 256;
constexpr int LDS_MAIN = 65536;
constexpr int LDS_BYTES = LDS_MAIN + 1024;

constexpr size_t MB = 1024 * 1024;
constexpr size_t WS_CTL = 0;
constexpr size_t CTL_BAR = 0;
constexpr size_t CTL_CNT = 16384;
constexpr size_t CTL_CU = 32768;
constexpr size_t CTL_BYTES = CTL_CU + 8192;
constexpr size_t CTL_SQ = CTL_BYTES;
constexpr size_t WS_WIN = 1 * MB;
constexpr size_t WS_WQB = WS_WIN + (size_t)NIN * D * 2;
constexpr size_t WS_WKVB = WS_WQB + 1536 * 512 * 2;
constexpr size_t WS_WOUT = WS_WKVB + 2048 * 256 * 2;
constexpr size_t WS_WMQ = WS_WOUT + (size_t)2048 * 2048 * 2;
constexpr size_t WS_WMKV = WS_WMQ + 512 * 2048 * 2;
constexpr size_t WS_WMO = WS_WMKV + 1024 * 2048 * 2;
constexpr size_t WS_WGU = WS_WMO + 2048 * 512 * 2;
constexpr size_t WS_WD = WS_WGU + (size_t)32 * 1024 * 2048 * 2;
constexpr size_t WS_WR = WS_WD + (size_t)32 * 2048 * 512 * 2;
constexpr size_t WS_H = WS_WR + 48 * 2048 * 4;
constexpr size_t WS_MEMN = WS_H + (size_t)T * D * 2;
constexpr size_t WS_ROPE = WS_MEMN + (size_t)MT * D * 2;
constexpr size_t WS_CQ = WS_ROPE + (size_t)T * 32 * 8;
constexpr size_t WS_CKV = WS_CQ + (size_t)T * 512 * 2;
constexpr size_t WS_QSB = WS_CKV + (size_t)T * 256 * 2;
constexpr size_t WS_KSB = WS_QSB + (size_t)T * 1024 * 2;
constexpr size_t WS_VSBT = WS_KSB + (size_t)T * 1024 * 2;
constexpr size_t WS_KPE = WS_VSBT + (size_t)T * 1024 * 2;
constexpr size_t WS_KMEM = WS_KPE + (size_t)T * 64 * 2;
constexpr size_t WS_VMEMT = WS_KMEM + (size_t)MT * 512 * 2;
constexpr size_t WS_QM = WS_VMEMT + (size_t)MT * 512 * 2;
constexpr size_t WS_KN = WS_QM + (size_t)T * 1536 * 2;
constexpr size_t WS_VMT = WS_KN + (size_t)T * 1024 * 2;
constexpr size_t WS_X1 = WS_VMT + (size_t)T * 1024 * 2;
constexpr size_t WS_ROUTE = WS_X1 + (size_t)T * D * 4;
constexpr size_t RT_SLOT = 0;
constexpr size_t RT_GATE = (size_t)T * 2 * 4;
constexpr size_t RT_EXP = RT_GATE + (size_t)T * 2 * 4;
constexpr size_t RT_POS = RT_EXP + (size_t)T * 2 * 4;
constexpr size_t RT_LIST = RT_POS + (size_t)T * 2 * 4;
constexpr size_t WS_END0 = WS_ROUTE + RT_LIST + (size_t)32 * T * 4;
constexpr int LDP = 2048 + 64;
constexpr size_t WS_H2 = WS_END0;
constexpr size_t WS_WIN2 = WS_H2 + (size_t)T * LDP * 2;
constexpr size_t WS_END = WS_WIN2 + (size_t)NIN * LDP * 2;
constexpr size_t WS_OMIX = WS_H, WS_X2B = WS_H, WS_X1B = WS_QSB, WS_QMEM = WS_CQ, WS_OMEM = WS_KN, WS_ACT = WS_QM, WS_Y = WS_X1;
constexpr size_t WS_X2HI = WS_X1B, WS_X2LO = WS_X1;
constexpr int ACT_ROWS_MAX = 2 * T + 32 * 128;

enum { SQ_CQ = 0, SQ_CKV, SQ_OMLA, SQ_OSB, SQ_X1, SQ_X2 };

struct P {
    const float* x; const float* mem; const int* pos;
    const float *norm_mix, *w_in, *norm_q_lat, *w_q_b, *norm_kv_lat, *w_kv_b, *norm_mla_out, *norm_sb_out, *w_out;
    const float *norm_mem_x, *norm_mem_src, *w_mem_q, *w_mem_kv, *w_mem_o, *norm_ffn, *w_group, *b_group, *w_er, *b_er;
    const float *w_gate, *w_up, *w_down, *norm_final;
    float* out; unsigned char* ws;
};

DEV int tidf() { int t = threadIdx.x; asm volatile("" : "+v"(t)); return t; }
DEV unsigned cvt_pk_bf16(float lo, float hi) { unsigned r; asm("v_cvt_pk_bf16_f32 %0, %1, %2" : "=v"(r) : "v"(lo), "v"(hi)); return r; }
#ifndef WT_STORES
#define WT_STORES 0
#endif
DEV void st8(void* p, u32x2 v) {
#if WT_STORES > 1
    asm volatile("global_store_dwordx2 %0, %1, off sc1" :: "v"(p), "v"(v) : "memory");
#else
    *(u32x2*)p = v;
#endif
}
DEV void st16f(void* p, f32x4 v) {
#if WT_STORES
    asm volatile("global_store_dwordx4 %0, %1, off sc1\n\ts_nop 1" :: "v"(p), "v"(v) : "memory");
#else
    *(f32x4*)p = v;
#endif
}
DEV void st16u(void* p, u32x4 v) {
#if WT_STORES
    asm volatile("global_store_dwordx4 %0, %1, off sc1\n\ts_nop 1" :: "v"(p), "v"(v) : "memory");
#else
    *(u32x4*)p = v;
#endif
}
DEV float bf16_to_f32(bf16_t v) { return __uint_as_float(((unsigned)v) << 16); }
DEV float fexp2(float x) { return __builtin_amdgcn_exp2f(x); }
DEV float flog2(float x) { return __builtin_amdgcn_logf(x); }
DEV float wave_sum(float v) {
#pragma unroll
    for (int o = 32; o >= 1; o >>= 1) v += __shfl_xor(v, o);
    return v;
}
DEV void sq_add(u64* sq, int row, float partial) { atomicAdd(sq + row, (u64)__float2ull_rn(partial * 4294967296.0f)); }
DEV float sq_rs(const u64* sq, int row, float inv_n) {
    const u64 v = __hip_atomic_load(sq + row, __ATOMIC_RELAXED, __HIP_MEMORY_SCOPE_AGENT);
    const float ms = (float)((double)v * (1.0 / 4294967296.0)) * inv_n;
    return __builtin_amdgcn_rsqf(ms + EPS);
}
DEV int vperm4(int s0) { const int g = (s0 >> 2) & 3; const int gp = ((g & 1) << 1) | (g >> 1); return (s0 & ~15) | (gp << 2); }

#define XB_TMO      128
#define XB_XCNT(j)  (256  + 64 * (j))
#define XB_XSUB(j)  (1280 + 64 * (j))
#define XB_XGEN(j)  (2304 + 64 * (j))
#define XB_TOP      3328
#define XB_TOPGEN   3392
#define XCD_BAR_WORDS 3456
#define XB_SPIN_CAP (1u << 22)
#define LAS __attribute__((address_space(3)))
DEV unsigned xb_ld(unsigned* p) { return __hip_atomic_load(p, __ATOMIC_RELAXED, __HIP_MEMORY_SCOPE_AGENT); }
DEV unsigned xb_add(unsigned* p, unsigned v) { return __hip_atomic_fetch_add(p, v, __ATOMIC_RELAXED, __HIP_MEMORY_SCOPE_AGENT); }
DEV unsigned xb_xcc_id() { return (unsigned)__builtin_amdgcn_s_getreg((3 << 11) | 20) & 0xFu; }
#define XB_SPIN(cond, bar) do { unsigned _sp = 0; while (cond) { __builtin_amdgcn_s_sleep(1); \
    if ((++_sp & 255u) == 0u) { if (xb_ld(&(bar)[XB_TMO])) break; if (_sp > XB_SPIN_CAP) { atomicAdd(&(bar)[XB_TMO], 1u); break; } } } } while (0)
struct XcdBarrier { unsigned* bar; unsigned x; volatile unsigned* st; };
DEV XcdBarrier xcd_barrier_post(unsigned* bar, volatile unsigned* st) {
    XcdBarrier b; b.bar = bar; b.x = xb_xcc_id(); b.st = st;
    if (threadIdx.x == 0) (void)xb_add(&bar[XB_XCNT(b.x)], 1u);
    return b;
}
DEV void xcd_barrier_complete(unsigned* bar, unsigned x, unsigned& nloc, unsigned& nx) {
    const unsigned G = gridDim.x;
    unsigned sum, cnt, mine, sp = 0u;
    for (;;) {
        sum = 0u; cnt = 0u; mine = 0u;
#pragma unroll
        for (unsigned j = 0; j < 16; ++j) { const unsigned c = xb_ld(&bar[XB_XCNT(j)]); sum += c; cnt += (c > 0u) ? 1u : 0u; mine = (j == x) ? c : mine; }
        if (sum == G) break;
        __builtin_amdgcn_s_sleep(1);
        if ((++sp & 255u) == 0u) { if (xb_ld(&bar[XB_TMO])) break; if (sp > XB_SPIN_CAP) { atomicAdd(&bar[XB_TMO], 1u); break; } }
    }
    nloc = mine > 0u ? mine : 1u; nx = cnt > 0u ? cnt : 1u;
}
DEV void xcd_barrier(const XcdBarrier& b) {
    asm volatile("s_waitcnt vmcnt(0)" ::: "memory");
    __syncthreads();
    if (threadIdx.x == 0) {
        unsigned* bar = b.bar;
        __builtin_amdgcn_s_waitcnt(0);
        unsigned nloc = b.st[0], nx = b.st[1];
        if (nloc == 0u) { xcd_barrier_complete(bar, b.x, nloc, nx); b.st[0] = nloc; b.st[1] = nx; }
        const unsigned old = xb_add(&bar[XB_XSUB(b.x)], 1u);
        const unsigned gen = old / nloc;
        if (old + 1u == (gen + 1u) * nloc) {
            __builtin_amdgcn_fence(__ATOMIC_RELEASE, "agent");
            asm volatile("s_waitcnt vmcnt(0)" ::: "memory");
            const unsigned og = xb_add(&bar[XB_TOP], 1u);
            const unsigned tg = og / nx;
            if (og + 1u == (tg + 1u) * nx) xb_add(&bar[XB_TOPGEN], 1u);
            else XB_SPIN(xb_ld(&bar[XB_TOPGEN]) == tg, bar);
            __builtin_amdgcn_fence(__ATOMIC_ACQUIRE, "agent");
            xb_add(&bar[XB_XGEN(b.x)], 1u);
            asm volatile("s_waitcnt vmcnt(0)" ::: "memory");
        } else {
            XB_SPIN(xb_ld(&bar[XB_XGEN(b.x)]) == gen, bar);
            __builtin_amdgcn_fence(__ATOMIC_ACQUIRE, "agent");
            asm volatile("s_waitcnt vmcnt(0)" ::: "memory");
        }
    }
    __syncthreads();
}

struct XcdIter { int x, j, per; };
DEV XcdIter xcd_iter() { XcdIter r; const int G = gridDim.x; if ((G & 7) == 0) { r.x = blockIdx.x & 7; r.j = blockIdx.x >> 3; r.per = G >> 3; } else { r.x = -1; r.j = blockIdx.x; r.per = G; } return r; }

#define GLDS16(g, l) __builtin_amdgcn_global_load_lds((const unsigned*)(g), (LAS unsigned*)(l), 16, 0, 0)
#define GLDS16X(g, l, aux) __builtin_amdgcn_global_load_lds((const unsigned*)(g), (LAS unsigned*)(l), 16, 0, aux)
typedef short s16x4 __attribute__((ext_vector_type(4)));
DEV int stage_col(int tid) { return (((tid & 7) ^ ((tid >> 3) & 7)) << 3); }
#ifndef PF_DIST
#define PF_DIST 3
#endif
template <bool BF32, int ABL = 0>
DEV void gemm_acc(f32x4 (&acc)[4][4], unsigned char* lds, const bf16_t* a0, const bf16_t* a1, const bf16_t* a2, const bf16_t* a3,
                  const bf16_t* b0, const bf16_t* b1, const bf16_t* b2, const bf16_t* b3, const float* bf, int ldn, int nkt, bool swap, const float* pf = nullptr) {
    const int tid = tidf();
    const int lane = tid & 63, wid = tid >> 6, wr = wid >> 1, wc = wid & 1, fr = lane & 15, fq = lane >> 4;
    const int xbase = swap ? (16384 + wc * 8192) : (wr * 8192);
    const int ybase = swap ? (wr * 8192) : (16384 + wc * 8192);
    unsigned char* ldw = lds + wid * 1024;
    const int n4 = tid & 31, kr = tid >> 5;
    const int wofs = 16384 + kr * 256 + (n4 & 3) * 8, sl0 = ((n4 >> 2) ^ (kr & 3)) << 5, sl1 = ((n4 >> 2) ^ ((kr & 3) | 4)) << 5;
    const int tq = (lane >> 2) & 3, gq = tq | ((fq & 1) << 2);
    const int wrd = 16384 + (8 * fq + tq) * 256 + 8 * (lane & 3);
    f32x4 rb[8];
    auto stage_a = [&](int buf, int ko) { GLDS16(a0 + ko, ldw + buf); GLDS16(a1 + ko, ldw + buf + 4096); GLDS16(a2 + ko, ldw + buf + 8192); GLDS16(a3 + ko, ldw + buf + 12288); };
    auto stage_b = [&](int buf, int ko) { GLDS16(b0 + ko, ldw + buf + 16384); GLDS16(b1 + ko, ldw + buf + 16384 + 4096); GLDS16(b2 + ko, ldw + buf + 16384 + 8192); GLDS16(b3 + ko, ldw + buf + 16384 + 12288); };
    auto load_bf = [&](int kt) {
#pragma unroll
        for (int i = 0; i < 8; ++i) rb[i] = *(const f32x4*)(bf + (size_t)(kt * 64 + 8 * i) * ldn);
    };
    auto write_bf = [&](int buf) {
#pragma unroll
        for (int i = 0; i < 8; ++i) {
            u32x2 w; w.x = cvt_pk_bf16(rb[i][0], rb[i][1]); w.y = cvt_pk_bf16(rb[i][2], rb[i][3]);
            *(u32x2*)(lds + buf + wofs + i * 2048 + ((i & 1) ? sl1 : sl0)) = w;
        }
    };
    stage_a(0, 0);
    if (BF32) { load_bf(0); write_bf(0); } else stage_b(0, 0);
    asm volatile("s_waitcnt vmcnt(0)" ::: "memory");
    __syncthreads();
    float pf_old = 0.f;
    for (int kt = 0; kt < nkt; ++kt) {
        const int cur = (kt & 1) * 32768, nxt = 32768 - cur;
        const bool more = (kt + 1 < nkt);
#ifndef GEMM_INTERLEAVE
#define GEMM_INTERLEAVE 0
#endif
        constexpr bool ILV = GEMM_INTERLEAVE && !BF32 && ABL == 0;
        if (more && !ILV && !(ABL == 2 && !BF32)) { stage_a(nxt, (kt + 1) * 64); if (BF32) load_bf(kt + 1); else stage_b(nxt, (kt + 1) * 64); }
        float pf_new = 0.f; const bool pfi = BF32 && pf && (kt + PF_DIST < nkt);
        if (pfi) pf_new = *(pf + (size_t)(kt + PF_DIST) * 64 * ldn);
        __builtin_amdgcn_sched_barrier(0);
#pragma unroll
        for (int ks = 0; ks < 2; ++ks) {
            bf16x8 xf[4], yf[4];
            const int coff = (((ks * 4 + fq) ^ (fr & 7)) << 4) + fr * 128;
            if (BF32) {
#pragma unroll
                for (int i = 0; i < 4; ++i) {
                    const int o = cur + wrd + ks * 8192 + (((wc * 4 + i) ^ gq) << 5);
                    const s16x4 lo = __builtin_amdgcn_ds_read_tr16_b64_v4i16((LAS s16x4*)(lds + o));
                    const s16x4 hi = __builtin_amdgcn_ds_read_tr16_b64_v4i16((LAS s16x4*)(lds + o + 1024));
                    xf[i] = __builtin_shufflevector(lo, hi, 0, 1, 2, 3, 4, 5, 6, 7);
                    yf[i] = *(const bf16x8*)(lds + cur + wr * 8192 + i * 2048 + coff);
                }
            } else if (ABL == 3) {
#pragma unroll
                for (int i = 0; i < 4; ++i) { xf[i] = (bf16x8){(short)(0x3f80 + i), 0x3f80, 0x3f81, 0x3f82, 0x3f83, 0x3f84, 0x3f85, (short)(0x3f86 + ks)}; yf[i] = xf[i]; asm volatile("" : "+v"(xf[i]), "+v"(yf[i])); }
            } else {
#pragma unroll
                for (int i = 0; i < 4; ++i) { xf[i] = *(const bf16x8*)(lds + cur + xbase + i * 2048 + coff); yf[i] = *(const bf16x8*)(lds + cur + ybase + i * 2048 + coff); }
            }
            if (ABL == 1 && !BF32) {
#pragma unroll
                for (int i = 0; i < 4; ++i) asm volatile("" :: "v"(xf[i]), "v"(yf[i]));
            } else if (ILV) {
                const int ko = (kt + 1) * 64;
#pragma unroll
                for (int i = 0; i < 4; ++i) {
                    __builtin_amdgcn_s_setprio(1);
#pragma unroll
                    for (int j = 0; j < 4; ++j) acc[i][j] = __builtin_amdgcn_mfma_f32_16x16x32_bf16(xf[i], yf[j], acc[i][j], 0, 0, 0);
                    __builtin_amdgcn_s_setprio(0);
                    if (more) {
                        const bf16_t* g = (ks == 0) ? (i == 0 ? a0 : i == 1 ? a1 : i == 2 ? a2 : a3) : (i == 0 ? b0 : i == 1 ? b1 : i == 2 ? b2 : b3);
                        GLDS16(g + ko, ldw + nxt + ks * 16384 + i * 4096);
                    }
                    __builtin_amdgcn_sched_barrier(0);
                }
            } else {
            __builtin_amdgcn_s_setprio(1);
#pragma unroll
            for (int i = 0; i < 4; ++i)
#pragma unroll
                for (int j = 0; j < 4; ++j) acc[i][j] = __builtin_amdgcn_mfma_f32_16x16x32_bf16(xf[i], yf[j], acc[i][j], 0, 0, 0);
            __builtin_amdgcn_s_setprio(0);
            }
        }
        if (BF32 && more) write_bf(nxt);
        if (BF32) {
            if (pfi) asm volatile("s_waitcnt vmcnt(1) lgkmcnt(0)" ::: "memory"); else asm volatile("s_waitcnt vmcnt(0) lgkmcnt(0)" ::: "memory");
            asm volatile("" :: "v"(pf_old));
            pf_old = pf_new;
            __builtin_amdgcn_s_barrier();
            asm volatile("" ::: "memory");
        } else {
            asm volatile("s_waitcnt vmcnt(0)" ::: "memory");
            __syncthreads();
        }
    }
    if (BF32) asm volatile("" :: "v"(pf_old));
}

#define ACC_TIE(a) "+v"(a[0][0]), "+v"(a[0][1]), "+v"(a[0][2]), "+v"(a[0][3]), "+v"(a[1][0]), "+v"(a[1][1]), "+v"(a[1][2]), "+v"(a[1][3]), \
                   "+v"(a[2][0]), "+v"(a[2][1]), "+v"(a[2][2]), "+v"(a[2][3]), "+v"(a[3][0]), "+v"(a[3][1]), "+v"(a[3][2]), "+v"(a[3][3])
struct GT { const bf16_t* a[4]; const bf16_t* b[4]; };
struct GemmPipe { int sb; bool pre; };
DEV int bperm(int r) { const int a = r & 15; return (r & 64) | ((a >> 2) << 4) | (((r >> 4) & 3) << 2) | (a & 3); }
DEV GT gt_dense(const bf16_t* A, int lda, int m0, const bf16_t* Bt, int ldb, int n0, int k0, bool perm = true) {
    const int tid = tidf(), srow = tid >> 3, sc = stage_col(tid);
    GT t;
    const bf16_t* b = Bt + (size_t)n0 * ldb + k0 + sc;
#pragma unroll
    for (int i = 0; i < 4; ++i) { const int r = srow + 32 * i; t.a[i] = A + (size_t)(m0 + (perm ? r : bperm(r))) * lda + k0 + sc; t.b[i] = b + (size_t)(perm ? bperm(r) : r) * ldb; }
    return t;
}
DEV void gemm_run(f32x4 (&acc)[4][4], unsigned char* lds, const GT& t, int nkt, bool swap, GemmPipe& gp, const GT& next, bool has_next) {
    const int tid = tidf();
    const int lane = tid & 63, wid = tid >> 6, wr = wid >> 1, wc = wid & 1, fr = lane & 15, fq = lane >> 4;
    const int xbase = swap ? (16384 + wc * 8192) : (wr * 8192);
    const int ybase = swap ? (wr * 8192) : (16384 + wc * 8192);
    unsigned char* ldw = lds + wid * 1024;
    auto stage = [&](const GT& g, int buf, int ko) {
#pragma unroll
        for (int i = 0; i < 4; ++i) GLDS16(g.a[i] + ko, ldw + buf + i * 4096);
#pragma unroll
        for (int i = 0; i < 4; ++i) GLDS16(g.b[i] + ko, ldw + buf + 16384 + i * 4096);
    };
    if (!gp.pre) { gp.sb = 0; stage(t, 0, 0); stage(t, 32768, 64);
        asm volatile("s_waitcnt vmcnt(8)" ::: "memory");
        __builtin_amdgcn_s_barrier();
        asm volatile("" ::: "memory"); }
#pragma unroll 2
    for (int kt = 0; kt < nkt; ++kt) {
        const int cur = ((kt + gp.sb) & 1) * 32768;
        bf16x8 xf[2][4], yf[2][4];
#pragma unroll
        for (int ks = 0; ks < 2; ++ks) {
            const int coff = (((ks * 4 + fq) ^ (fr & 7)) << 4) + fr * 128;
#pragma unroll
            for (int i = 0; i < 4; ++i) { xf[ks][i] = *(const bf16x8*)(lds + cur + xbase + i * 2048 + coff); yf[ks][i] = *(const bf16x8*)(lds + cur + ybase + i * 2048 + coff); }
        }
        asm volatile("s_waitcnt lgkmcnt(0)" ::: "memory");
        __builtin_amdgcn_s_barrier();
        asm volatile("" ::: "memory");
        const bool in_tile = kt + 2 < nkt, issued = in_tile || has_next;
        const GT& sg = in_tile ? t : next;
        const int sko = in_tile ? (kt + 2) * 64 : (kt + 2 - nkt) * 64;
        __builtin_amdgcn_s_setprio(1);
#pragma unroll
        for (int ks = 0; ks < 2; ++ks)
#pragma unroll
            for (int i = 0; i < 4; ++i) {
                const int pc = ks * 4 + i;
                if (issued) { if (pc < 4) GLDS16(sg.a[pc] + sko, ldw + cur + pc * 4096); else GLDS16(sg.b[pc - 4] + sko, ldw + cur + 16384 + (pc - 4) * 4096); }
#pragma unroll
                for (int j = 0; j < 4; ++j) acc[i][j] = __builtin_amdgcn_mfma_f32_16x16x32_bf16(xf[ks][i], yf[ks][j], acc[i][j], 0, 0, 0);
                __builtin_amdgcn_sched_barrier(0);
            }
        __builtin_amdgcn_s_setprio(0);
        asm volatile("s_waitcnt lgkmcnt(0)" : ACC_TIE(acc) :: "memory");
        if (kt + 1 < nkt || has_next) {
            if (issued) asm volatile("s_waitcnt vmcnt(8)" ::: "memory"); else asm volatile("s_waitcnt vmcnt(0)" ::: "memory");
        }
        __builtin_amdgcn_s_barrier();
        asm volatile("" ::: "memory");
    }
    gp.pre = has_next; gp.sb = (nkt + gp.sb) & 1;
}

constexpr float W8_SCALE = 64.0f, ACT8_SCALE = 8.0f;
typedef int v8i __attribute__((ext_vector_type(8)));
typedef unsigned char u8;
DEV float sat8(float v) { return __builtin_amdgcn_fmed3f(v, -448.0f, 448.0f); }
DEV unsigned pack_fp8x4_sat(float a, float b, float c, float d) { int w = 0; w = __builtin_amdgcn_cvt_pk_fp8_f32(sat8(a), sat8(b), w, false); w = __builtin_amdgcn_cvt_pk_fp8_f32(sat8(c), sat8(d), w, true); return (unsigned)w; }
DEV unsigned pack_fp8x4(float a, float b, float c, float d) { int w = 0; w = __builtin_amdgcn_cvt_pk_fp8_f32(a, b, w, false); w = __builtin_amdgcn_cvt_pk_fp8_f32(c, d, w, true); return (unsigned)w; }
struct GT8 { const u8* a[4]; const u8* b[4]; };
template <int AUXA = 0>
DEV void gemm_run8(f32x4 (&acc)[4][4], unsigned char* lds, const GT8& t, int nks  , GemmPipe& gp, const GT8& next, bool has_next) {
    const int tid = tidf();
    const int lane = tid & 63, wid = tid >> 6, wr = wid >> 1, wc = wid & 1, fr = lane & 15, fq = lane >> 4;
    const int xbase = 16384 + wc * 8192, ybase = wr * 8192;
    unsigned char* ldw = lds + wid * 1024;
    const int off0 = fr * 128 + (((2 * fq) ^ (fr & 7)) << 4), off1 = fr * 128 + (((2 * fq + 1) ^ (fr & 7)) << 4);
    auto stage = [&](const GT8& g, int buf, int ko) {
#pragma unroll
        for (int i = 0; i < 4; ++i) GLDS16X(g.a[i] + ko, ldw + buf + i * 4096, AUXA);
#pragma unroll
        for (int i = 0; i < 4; ++i) GLDS16(g.b[i] + ko, ldw + buf + 16384 + i * 4096);
    };
    if (!gp.pre) { gp.sb = 0; stage(t, 0, 0); stage(t, 32768, 128);
        asm volatile("s_waitcnt vmcnt(8)" ::: "memory");
        __builtin_amdgcn_s_barrier();
        asm volatile("" ::: "memory"); }
#pragma unroll 2
    for (int ks = 0; ks < nks; ++ks) {
        const int cur = ((ks + gp.sb) & 1) * 32768;
        v8i xf[4], yf[4];
#pragma unroll
        for (int i = 0; i < 4; ++i) {
            const u32x4 xl = *(const u32x4*)(lds + cur + xbase + i * 2048 + off0), xh = *(const u32x4*)(lds + cur + xbase + i * 2048 + off1);
            const u32x4 yl = *(const u32x4*)(lds + cur + ybase + i * 2048 + off0), yh = *(const u32x4*)(lds + cur + ybase + i * 2048 + off1);
            xf[i] = (v8i){(int)xl.x, (int)xl.y, (int)xl.z, (int)xl.w, (int)xh.x, (int)xh.y, (int)xh.z, (int)xh.w};
            yf[i] = (v8i){(int)yl.x, (int)yl.y, (int)yl.z, (int)yl.w, (int)yh.x, (int)yh.y, (int)yh.z, (int)yh.w};
        }
        asm volatile("s_waitcnt lgkmcnt(0)" ::: "memory");
        __builtin_amdgcn_s_barrier();
        asm volatile("" ::: "memory");
        const bool in_tile = ks + 2 < nks, issued = in_tile || has_next;
        const GT8& sg = in_tile ? t : next;
        const int sko = in_tile ? (ks + 2) * 128 : (ks + 2 - nks) * 128;
        __builtin_amdgcn_s_setprio(1);
#pragma unroll
        for (int i = 0; i < 4; ++i)
#pragma unroll
            for (int jj = 0; jj < 2; ++jj) {
                const int pc = i * 2 + jj;
                if (issued) { if (pc < 4) GLDS16X(sg.a[pc] + sko, ldw + cur + pc * 4096, AUXA); else GLDS16(sg.b[pc - 4] + sko, ldw + cur + 16384 + (pc - 4) * 4096); }
#pragma unroll
                for (int j = jj * 2; j < jj * 2 + 2; ++j) acc[i][j] = __builtin_amdgcn_mfma_scale_f32_16x16x128_f8f6f4(xf[i], yf[j], acc[i][j], 0, 0, 0, 0x7F7F7F7F, 0, 0x7F7F7F7F);
                __builtin_amdgcn_sched_barrier(0);
            }
        __builtin_amdgcn_s_setprio(0);
        __builtin_amdgcn_sched_barrier(0);
        asm volatile("s_waitcnt lgkmcnt(0)" : ACC_TIE(acc) :: "memory");
        if (ks + 1 < nks || has_next) {
            if (issued) asm volatile("s_waitcnt vmcnt(8)" ::: "memory"); else asm volatile("s_waitcnt vmcnt(0)" ::: "memory");
        }
        __builtin_amdgcn_s_barrier();
        asm volatile("" ::: "memory");
    }
    gp.pre = has_next; gp.sb = (nks + gp.sb) & 1;
}
DEV void acc_zero(f32x4 (&acc)[4][4]) {
#pragma unroll
    for (int i = 0; i < 4; ++i)
#pragma unroll
        for (int j = 0; j < 4; ++j) acc[i][j] = (f32x4){0.f, 0.f, 0.f, 0.f};
}
template <int ABL = 0>
DEV void gemm_dense(f32x4 (&acc)[4][4], unsigned char* lds, const bf16_t* A, int lda, int m0, const bf16_t* Bt, int ldb, int n0, int k0, int nkt, bool swap) {
    if (ABL == 0) {
        GemmPipe gp{0, false};
        const GT t = gt_dense(A, lda, m0, Bt, ldb, n0, k0, swap);
        gemm_run(acc, lds, t, nkt, swap, gp, t, false);
        return;
    }
    const int tid = tidf();
    const int srow = tid >> 3, sc = stage_col(tid);
    const bf16_t* a = A + (size_t)m0 * lda + k0 + sc;
    const bf16_t* b = Bt + (size_t)n0 * ldb + k0 + sc;
    const int p0 = bperm(srow), p1 = bperm(srow + 32), p2 = bperm(srow + 64), p3 = bperm(srow + 96);
    const int r0 = swap ? p0 : srow, r1 = swap ? p1 : srow + 32, r2 = swap ? p2 : srow + 64, r3 = swap ? p3 : srow + 96;
    const int q0 = swap ? srow : p0, q1 = swap ? srow + 32 : p1, q2 = swap ? srow + 64 : p2, q3 = swap ? srow + 96 : p3;
    gemm_acc<false, ABL>(acc, lds, a + (size_t)q0 * lda, a + (size_t)q1 * lda, a + (size_t)q2 * lda, a + (size_t)q3 * lda, b + (size_t)r0 * ldb, b + (size_t)r1 * ldb, b + (size_t)r2 * ldb, b + (size_t)r3 * ldb, nullptr, 0, nkt, swap);
}
DEV void gemm_dense_bf32(f32x4 (&acc)[4][4], unsigned char* lds, const bf16_t* A, int lda, int m0, const float* Bsrc, int ldn, int nkt) {
    const int tid = tidf();
    const int srow = tid >> 3, sc = stage_col(tid);
    const bf16_t* a = A + (size_t)(m0 + srow) * lda + sc;
    const float* bf = Bsrc + (size_t)(tid >> 5) * ldn + (tid & 31) * 4;
    const float* pf = Bsrc + (size_t)(tid >> 2) * ldn + (tid & 3) * 32;
    gemm_acc<true>(acc, lds, a, a + (size_t)32 * lda, a + (size_t)64 * lda, a + (size_t)96 * lda, nullptr, nullptr, nullptr, nullptr, bf, ldn, nkt, true, pf);
}

template <class GainF, class RowF>
DEV void transpose_item(const float* src, int N, bf16_t* dst, int ldd, int k0, int n0, int lane, GainF gain, RowF dstrow) {
    const int ln = lane & 7, lk = lane >> 3;
    const int k = k0 + lk * 8, n = n0 + ln * 4;
    f32x4 v[8];
#pragma unroll
    for (int kk = 0; kk < 8; ++kk) v[kk] = *(const f32x4*)(src + (size_t)(k + kk) * N + n);
    float g[8];
#pragma unroll
    for (int kk = 0; kk < 8; ++kk) g[kk] = gain(k + kk);
#pragma unroll
    for (int j = 0; j < 4; ++j) {
        u32x4 w;
        w.x = cvt_pk_bf16(v[0][j] * g[0], v[1][j] * g[1]); w.y = cvt_pk_bf16(v[2][j] * g[2], v[3][j] * g[3]);
        w.z = cvt_pk_bf16(v[4][j] * g[4], v[5][j] * g[5]); w.w = cvt_pk_bf16(v[6][j] * g[6], v[7][j] * g[7]);
        st16u(dst + (size_t)dstrow(n + j) * ldd + k, w);
    }
}
DEV int rope_perm64(int i) { return i < 32 ? 2 * i : 2 * (i - 32) + 1; }

DEV void rms_row_to_bf16(const float* src, const float* g, bf16_t* dst, int lane) {
    f32x4 v[8]; float s = 0.f;
#pragma unroll
    for (int i = 0; i < 8; ++i) { v[i] = *(const f32x4*)(src + i * 256 + lane * 4); s += v[i][0] * v[i][0] + v[i][1] * v[i][1] + v[i][2] * v[i][2] + v[i][3] * v[i][3]; }
    s = wave_sum(s);
    const float rs = __builtin_amdgcn_rsqf(s * (1.0f / 2048.0f) + EPS);
#pragma unroll
    for (int i = 0; i < 8; ++i) {
        const f32x4 gg = *(const f32x4*)(g + i * 256 + lane * 4);
        u32x2 w; w.x = cvt_pk_bf16(v[i][0] * rs * gg[0], v[i][1] * rs * gg[1]); w.y = cvt_pk_bf16(v[i][2] * rs * gg[2], v[i][3] * rs * gg[3]);
        st8(dst + i * 256 + lane * 4, w);
    }
}

DEV void phase0(const P& p) {
    const int lane = tidf() & 63, gw = blockIdx.x * 4 + (tidf() >> 6), NGW = gridDim.x * 4;
    unsigned char* ws = p.ws;
    constexpr int I_IN = 32 * 122, I_QB = 8 * 48, I_KVB = 4 * 64;
    constexpr int NITEMS = I_IN + I_QB + I_KVB;
    for (int it = gw; it < NITEMS; it += NGW) {
        int r = it;
        if (r < I_IN) { const int kt = r / 122, nt = r % 122;
            transpose_item(p.w_in, 3904, (bf16_t*)(ws + WS_WIN2), LDP, kt * 64, nt * 32, lane, [](int) { return 1.0f; },
                [](int n) { return n < 768 ? n : (n < 832 ? 3840 + rope_perm64(n - 768) : n - 64); }); continue; }
        r -= I_IN;
        if (r < I_QB) { const int kt = r / 48, nt = r % 48; const float* g = p.norm_q_lat;
            transpose_item(p.w_q_b, 1536, (bf16_t*)(ws + WS_WQB), 512, kt * 64, nt * 32, lane, [g](int k) { return g[k]; },
                [](int n) { const int h = n / 192, d = n % 192; return h * 192 + (d < 128 ? d : 128 + rope_perm64(d - 128)); }); continue; }
        r -= I_QB;
        { const int kt = r / 64, nt = r % 64; const float* g = p.norm_kv_lat;
            transpose_item(p.w_kv_b, 2048, (bf16_t*)(ws + WS_WKVB), 256, kt * 64, nt * 32, lane, [g](int k) { return g[k]; }, [](int n) { return n; }); }
    }
    {
        float* rt = (float*)(ws + WS_ROPE);
        for (int i = blockIdx.x * NTHREADS + tidf(); i < T * 32; i += gridDim.x * NTHREADS) {
            const int t = i >> 5, f = i & 31;
            const float inv_freq = exp2f(-(float)f * (13.287712379549449f / 32.0f));
            const float ang = (float)p.pos[t] * inv_freq;
            const double turns = (double)ang * 0.15915494309189535;
            const float fr = (float)(turns - floor(turns));
            rt[2 * i] = __builtin_amdgcn_cosf(fr); rt[2 * i + 1] = __builtin_amdgcn_sinf(fr);
        }
    }
    {
        u32x4* z = (u32x4*)(ws + CTL_SQ);
        for (int i = blockIdx.x * NTHREADS + tidf(); i < 6 * T * 8 / 16; i += gridDim.x * NTHREADS) z[i] = (u32x4){0u, 0u, 0u, 0u};
    }
    for (int row = gw; row < T; row += NGW) rms_row_to_bf16(p.x + (size_t)row * D, p.norm_mix, (bf16_t*)(ws + WS_H2) + (size_t)row * LDP, lane);
}
DEV void late_convert(const P& p, int gw, int ngw, int lane) {
    unsigned char* ws = p.ws;
    constexpr int I_OUT = 32 * 64, I_MQ = 32 * 16, I_MKV = 32 * 32, I_MO = 8 * 64, I_WR = 48 * 2048 / 256, I_MEM = MT;
    constexpr int NITEMS = I_OUT + I_MQ + I_MKV + I_MO + I_WR + I_MEM;
    for (int it = gw; it < NITEMS; it += ngw) {
        int r = it;
        if (r < I_OUT) { const int kt = r / 64, nt = r % 64; const float* g1 = p.norm_mla_out; const float* g2 = p.norm_sb_out;
            transpose_item(p.w_out, 2048, (bf16_t*)(ws + WS_WOUT), 2048, kt * 64, nt * 32, lane, [g1, g2](int k) { return k < 1024 ? g1[k] : g2[k - 1024]; }, [](int n) { return n; }); continue; }
        r -= I_OUT;
        if (r < I_MQ) { const int kt = r / 16, nt = r % 16; const float* g = p.norm_mem_x;
            transpose_item(p.w_mem_q, 512, (bf16_t*)(ws + WS_WMQ), 2048, kt * 64, nt * 32, lane, [g](int k) { return g[k]; }, [](int n) { return n; }); continue; }
        r -= I_MQ;
        if (r < I_MKV) { const int kt = r / 32, nt = r % 32;
            transpose_item(p.w_mem_kv, 1024, (bf16_t*)(ws + WS_WMKV), 2048, kt * 64, nt * 32, lane, [](int) { return 1.0f; }, [](int n) { return n; }); continue; }
        r -= I_MKV;
        if (r < I_MO) { const int kt = r / 64, nt = r % 64;
            transpose_item(p.w_mem_o, 2048, (bf16_t*)(ws + WS_WMO), 512, kt * 64, nt * 32, lane, [](int) { return 1.0f; }, [](int n) { return n; }); continue; }
        r -= I_MO;
        if (r < I_WR) {
            bf16_t* wf = (bf16_t*)(ws + WS_WR);
#pragma unroll
            for (int q = 0; q < 4; ++q) { const int i = r * 256 + q * 64 + lane, n = i >> 11, k = i & 2047;
                float v = 0.f;
                if (n < 4) v = p.w_group[k * 4 + n] * p.norm_ffn[k]; else if (n < 36) v = p.w_er[k * 32 + (n - 4)] * p.norm_ffn[k];
                const unsigned hi = cvt_pk_bf16(v, 0.f) & 0xffffu; const float lo = v - __uint_as_float(hi << 16);
                const int d = (((k >> 5) * 3 + (n >> 4)) * 2) * 512 + (((k >> 3) & 3) * 16 + (n & 15)) * 8 + (k & 7);
                wf[d] = (bf16_t)hi; wf[d + 512] = (bf16_t)(cvt_pk_bf16(lo, 0.f) & 0xffffu); }
            continue; }
        r -= I_WR;
        rms_row_to_bf16(p.mem + (size_t)r * D, p.norm_mem_src, (bf16_t*)(ws + WS_MEMN) + (size_t)r * D, lane);
    }
}


typedef __attribute__((address_space(1))) unsigned gu32;
typedef __attribute__((address_space(1))) unsigned long long gu64;
constexpr size_t CTL_READY = CTL_CNT + 8192;
constexpr size_t CTL_READY12 = CTL_READY + 1024;
constexpr size_t CTL_Q10 = CTL_READY12 + 1024;
DEV void st_bf16x16(bf16_t* dst, const f32x4& v0, const f32x4& v1, const f32x4& v2, const f32x4& v3) {
    u32x4 a, b;
    a.x = cvt_pk_bf16(v0[0], v0[1]); a.y = cvt_pk_bf16(v0[2], v0[3]); a.z = cvt_pk_bf16(v1[0], v1[1]); a.w = cvt_pk_bf16(v1[2], v1[3]);
    b.x = cvt_pk_bf16(v2[0], v2[1]); b.y = cvt_pk_bf16(v2[2], v2[3]); b.z = cvt_pk_bf16(v3[0], v3[1]); b.w = cvt_pk_bf16(v3[2], v3[3]);
    *(u32x4*)dst = a; *(u32x4*)(dst + 8) = b;
}
DEV void st_bf16x16_wt(bf16_t* dst, const f32x4& v0, const f32x4& v1, const f32x4& v2, const f32x4& v3) {
    gu64* d = (gu64*)dst;
    __hip_atomic_store(d + 0, (u64)cvt_pk_bf16(v0[0], v0[1]) | ((u64)cvt_pk_bf16(v0[2], v0[3]) << 32), __ATOMIC_RELAXED, __HIP_MEMORY_SCOPE_AGENT);
    __hip_atomic_store(d + 1, (u64)cvt_pk_bf16(v1[0], v1[1]) | ((u64)cvt_pk_bf16(v1[2], v1[3]) << 32), __ATOMIC_RELAXED, __HIP_MEMORY_SCOPE_AGENT);
    __hip_atomic_store(d + 2, (u64)cvt_pk_bf16(v2[0], v2[1]) | ((u64)cvt_pk_bf16(v2[2], v2[3]) << 32), __ATOMIC_RELAXED, __HIP_MEMORY_SCOPE_AGENT);
    __hip_atomic_store(d + 3, (u64)cvt_pk_bf16(v3[0], v3[1]) | ((u64)cvt_pk_bf16(v3[2], v3[3]) << 32), __ATOMIC_RELAXED, __HIP_MEMORY_SCOPE_AGENT);
}
template <bool WT = false>
DEV void store_rowmajor_sq(const f32x4 (&acc)[4][4], bf16_t* dst, int ldd, int m0, int ncol0, u64* sq, float scale) {
    const int lane = tidf() & 63, wid = tidf() >> 6, wr = wid >> 1, wc = wid & 1, fr = lane & 15, fq = lane >> 4;
#pragma unroll
    for (int j = 0; j < 4; ++j) {
        const int m = m0 + wr * 64 + j * 16 + fr; float ss = 0.f;
#pragma unroll
        for (int i = 0; i < 4; ++i) { const f32x4 v = acc[i][j]; ss += v[0] * v[0] + v[1] * v[1] + v[2] * v[2] + v[3] * v[3]; }
        if (WT) st_bf16x16_wt(dst + (size_t)m * ldd + ncol0 + wc * 64 + fq * 16, acc[0][j] * scale, acc[1][j] * scale, acc[2][j] * scale, acc[3][j] * scale);
        else st_bf16x16(dst + (size_t)m * ldd + ncol0 + wc * 64 + fq * 16, acc[0][j] * scale, acc[1][j] * scale, acc[2][j] * scale, acc[3][j] * scale);
        if (sq) { ss += __shfl_xor(ss, 16); ss += __shfl_xor(ss, 32); if (fq == 0) sq_add(sq, m, ss); }
    }
}
DEV void store_transposed(const f32x4 (&acc)[4][4], bf16_t* dst, int L, int s0, const u64* sq, int sqrow0, float inv_n) {
    const int lane = tidf() & 63, wid = tidf() >> 6, wr = wid >> 1, wc = wid & 1, fr = lane & 15, fq = lane >> 4;
    const int ml = wr * 64 + fq * 16;
    f32x4 sc[4];
#pragma unroll
    for (int i = 0; i < 4; ++i)
#pragma unroll
        for (int r = 0; r < 4; ++r) sc[i][r] = sq ? sq_rs(sq, sqrow0 + ml + 4 * i + r, inv_n) : 1.0f;
#pragma unroll
    for (int j = 0; j < 4; ++j) {
        const int n = wc * 64 + j * 16 + fr;
        st_bf16x16(dst + (size_t)n * L + s0 + ml, acc[0][j] * sc[0], acc[2][j] * sc[2], acc[1][j] * sc[1], acc[3][j] * sc[3]);
    }
}

DEV void phase1(const P& p, unsigned char* lds, bool dry = false) {
    unsigned char* ws = p.ws;
    const XcdIter xi = xcd_iter();
    const int lane = tidf() & 63, wid = tidf() >> 6, wr = wid >> 1, wc = wid & 1, fr = lane & 15, fq = lane >> 4;
    u64* sqb = (u64*)(ws + CTL_SQ);
    u64* sq_cq = dry ? nullptr : sqb + SQ_CQ * T; u64* sq_ckv = dry ? nullptr : sqb + SQ_CKV * T;
    const int per_x = 8 * 31, total = 64 * 31;
    auto tile_at = [&](int it, int& mt, int& nt) -> bool {
        if (xi.x >= 0) { const int i = it * xi.per + xi.j; if (i >= per_x) return false; mt = xi.x * 8 + (i & 7); nt = i >> 3; }
        else { const int i = it * xi.per + xi.j; if (i >= total) return false; mt = i & 63; nt = i >> 6; }
        return true; };
    GemmPipe gp{0, false};
    int mt, nt; bool have = tile_at(0, mt, nt);
    if (!have) return;
    GT cur = gt_dense((const bf16_t*)(ws + WS_H2), LDP, mt * 128, (const bf16_t*)(ws + WS_WIN2), LDP, nt * 128, 0, !(nt >= 22 && nt < 30));
    for (int it = 0; have; ++it) {
        int mtn, ntn; const bool hn = tile_at(it + 1, mtn, ntn);
        GT nx = cur; if (hn) nx = gt_dense((const bf16_t*)(ws + WS_H2), LDP, mtn * 128, (const bf16_t*)(ws + WS_WIN2), LDP, ntn * 128, 0, !(ntn >= 22 && ntn < 30));
        f32x4 acc[4][4]; acc_zero(acc);
        const bool isv = (nt >= 22 && nt < 30);
        gemm_run(acc, lds, cur, 32, !isv, gp, nx, hn);
        const int m0 = mt * 128, b = m0 >> 12, s0 = m0 & 4095;
        if (nt < 6) {
            if (nt < 4) store_rowmajor_sq<true>(acc, (bf16_t*)(ws + WS_CQ), 512, m0, nt * 128, sq_cq, 1.0f);
            else store_rowmajor_sq<true>(acc, (bf16_t*)(ws + WS_CKV), 256, m0, (nt - 4) * 128, sq_ckv, 1.0f);
            asm volatile("s_waitcnt vmcnt(0)" ::: "memory");
            __syncthreads();
            if (tidf() == 0 && !dry) __hip_atomic_fetch_add((gu32*)(ws + CTL_READY12) + mt, 1u, __ATOMIC_RELAXED, __HIP_MEMORY_SCOPE_AGENT);
        }
        else if (nt < 14) store_rowmajor_sq(acc, (bf16_t*)(ws + WS_QSB) + (size_t)((b * 8 + (nt - 6)) * S) * 128, 128, s0, 0, nullptr, 0.08838834764831845f * LOG2E);
        else if (nt < 22) store_rowmajor_sq(acc, (bf16_t*)(ws + WS_KSB) + (size_t)((b * 8 + (nt - 14)) * S) * 128, 128, s0, 0, nullptr, 1.0f);
        else if (nt < 30) store_transposed(acc, (bf16_t*)(ws + WS_VSBT) + (size_t)((b * 8 + (nt - 22)) * 128) * S, S, s0, nullptr, 0, 0.f);
        else if (wc == 0) {
            const float* rt = (const float*)(ws + WS_ROPE);
            bf16_t* kpe = (bf16_t*)(ws + WS_KPE);
#pragma unroll
            for (int j = 0; j < 4; ++j) {
                const int m = m0 + wr * 64 + j * 16 + fr;
#pragma unroll
                for (int i = 0; i < 4; ++i) {
                    const int n = fq * 16 + i * 4; const f32x4 v = acc[i][j];
                    const f32x4 cs = *(const f32x4*)(rt + ((size_t)m * 32 + (n >> 1)) * 2);
                    u32x2 w; w.x = cvt_pk_bf16(v[0] * cs[0] - v[1] * cs[1], v[1] * cs[0] + v[0] * cs[1]);
                    w.y = cvt_pk_bf16(v[2] * cs[2] - v[3] * cs[3], v[3] * cs[2] + v[2] * cs[3]);
                    st8(kpe + (size_t)m * 64 + n, w);
                }
            }
        }
        cur = nx; mt = mtn; nt = ntn; have = hn;
    }
}


template <int ABL>
DEV void phase1_dry(const P& p, unsigned char* lds) {
    unsigned char* ws = p.ws;
    const XcdIter xi = xcd_iter();
    const int per_x = 8 * 31, total = 64 * 31;
    for (int it = 0;; ++it) {
        int mt, nt;
        if (xi.x >= 0) { const int i = it * xi.per + xi.j; if (i >= per_x) break; mt = xi.x * 8 + (i & 7); nt = i >> 3; }
        else { const int i = it * xi.per + xi.j; if (i >= total) break; mt = i & 63; nt = i >> 6; }
        f32x4 acc[4][4]; acc_zero(acc);
        gemm_dense<ABL>(acc, lds, (const bf16_t*)(ws + WS_H), D, mt * 128, (const bf16_t*)(ws + WS_WIN), D, nt * 128, 0, 32, true);
#pragma unroll
        for (int i = 0; i < 4; ++i)
#pragma unroll
            for (int j = 0; j < 4; ++j) asm volatile("" :: "v"(acc[i][j]));
    }
}
DEV void phase2(const P& p, unsigned char* lds) {
    unsigned char* ws = p.ws;
    const XcdIter xi = xcd_iter();
    const int lane = tidf() & 63, wid = tidf() >> 6, wr = wid >> 1, wc = wid & 1, fr = lane & 15, fq = lane >> 4;
    const u64* sqb = (const u64*)(ws + CTL_SQ);
    const int per_x = 8 * 28, total = 64 * 28;
    auto tile_at = [&](int it, int& mt, int& nt) -> bool {
        if (xi.x >= 0) { const int i = it * xi.per + xi.j; if (i >= per_x) return false; mt = xi.x * 8 + (i & 7); nt = i >> 3; }
        else { const int i = it * xi.per + xi.j; if (i >= total) return false; mt = i & 63; nt = i >> 6; }
        return true; };
    auto desc = [&](int mt, int nt) -> GT {
        return nt < 12 ? gt_dense((const bf16_t*)(ws + WS_CQ), 512, mt * 128, (const bf16_t*)(ws + WS_WQB), 512, nt * 128, 0, true)
                       : gt_dense((const bf16_t*)(ws + WS_CKV), 256, mt * 128, (const bf16_t*)(ws + WS_WKVB), 256, (nt - 12) * 128, 0, ((nt - 12) & 1) == 0); };
    GemmPipe gp{0, false};
    int mt, nt; bool have = tile_at(0, mt, nt);
    if (!have) return;
    if (tidf() < 64) {
        unsigned* bar = (unsigned*)(ws + CTL_BAR);
        int mtw, ntw, last = -1;
        for (int it = 0; tile_at(it, mtw, ntw); ++it) {
            if (mtw == last) continue;
            last = mtw;
            gu32* rdy = (gu32*)(ws + CTL_READY12) + mtw;
            XB_SPIN((unsigned)__builtin_amdgcn_readfirstlane(__hip_atomic_load(rdy, __ATOMIC_RELAXED, __HIP_MEMORY_SCOPE_AGENT)) < 6u, bar);
        }
    }
    __syncthreads();
    GT cur = desc(mt, nt);
    for (int it = 0; have; ++it) {
        int mtn, ntn; const bool hn = tile_at(it + 1, mtn, ntn);
        GT nx = cur; if (hn) nx = desc(mtn, ntn);
        const int m0 = mt * 128, b = m0 >> 12, s0 = m0 & 4095;
        f32x4 acc[4][4]; acc_zero(acc);
        if (nt < 12) {
            gemm_run(acc, lds, cur, 8, true, gp, nx, hn);
            const float* rt = (const float*)(ws + WS_ROPE);
            bf16_t* qm = (bf16_t*)(ws + WS_QM);
            const float qs = 0.07216878364870322f * LOG2E;
#pragma unroll
            for (int j = 0; j < 4; ++j) {
                const int m = m0 + wr * 64 + j * 16 + fr, s = s0 + wr * 64 + j * 16 + fr;
                const float rs = sq_rs(sqb + SQ_CQ * T, m, 1.0f / 512.0f) * qs;
                const int n0 = nt * 128 + wc * 64 + fq * 16, h = n0 / 192, d0 = n0 - h * 192;
                f32x4 vq[4];
#pragma unroll
                for (int i = 0; i < 4; ++i) {
                    const int d = d0 + i * 4;
                    f32x4 v = acc[i][j] * rs;
                    if (d >= 128) {
                        const f32x4 cs = *(const f32x4*)(rt + ((size_t)m * 32 + ((d - 128) >> 1)) * 2);
                        v = (f32x4){v[0] * cs[0] - v[1] * cs[1], v[1] * cs[0] + v[0] * cs[1], v[2] * cs[2] - v[3] * cs[3], v[3] * cs[2] + v[2] * cs[3]};
                    }
                    vq[i] = v;
                }
                st_bf16x16(qm + ((size_t)(b * 8 + h) * S + s) * 192 + d0, vq[0], vq[1], vq[2], vq[3]);
            }
        } else {
            const int nk = nt - 12, h = nk >> 1; const bool isv = nk & 1;
            gemm_run(acc, lds, cur, 4, !isv, gp, nx, hn);
            if (!isv) {
                bf16_t* kn = (bf16_t*)(ws + WS_KN) + (size_t)((b * 8 + h) * S) * 128;
#pragma unroll
                for (int j = 0; j < 4; ++j) {
                    const int ml = wr * 64 + j * 16 + fr;
                    const float rs = sq_rs(sqb + SQ_CKV * T, m0 + ml, 1.0f / 256.0f);
                    st_bf16x16(kn + (size_t)(s0 + ml) * 128 + wc * 64 + fq * 16, acc[0][j] * rs, acc[1][j] * rs, acc[2][j] * rs, acc[3][j] * rs);
                }
            } else {
                store_transposed(acc, (bf16_t*)(ws + WS_VMT) + (size_t)((b * 8 + h) * 128) * S, S, s0, sqb + SQ_CKV * T, m0, 1.0f / 256.0f);
            }
        }
        cur = nx; mt = mtn; nt = ntn; have = hn;
    }
}

template <int DQK> struct KStage {
    static constexpr int NIG = DQK / 64;
    u32x4 r[2][NIG];
    const bf16_t* gm; const bf16_t* gp; int l0, l1;
    DEV void init(const bf16_t* Kmain, const bf16_t* Kpe, int t) {
        const int row = t >> 3, c = t & 7;
        gm = Kmain + (size_t)row * 128 + c * 8; gp = (DQK == 192) ? Kpe + (size_t)row * 64 + c * 8 : nullptr;
        if (DQK == 128) { const int lo = row * 256 + ((c ^ (row & 7)) << 4), b3 = (row >> 3) & 1; l0 = lo + (b3 ? 128 : 0); l1 = lo + (b3 ? 0 : 128); }
        else { l0 = row * 384 + ((c ^ ((row >> 1) & 7)) << 4); l1 = l0 + 128; }
    }
    DEV void load(int tile) {
#pragma unroll
        for (int ps = 0; ps < 2; ++ps) {
            const bf16_t* g = gm + ((size_t)tile * 64 + ps * 32) * 128;
            r[ps][0] = *(const u32x4*)g; r[ps][1] = *(const u32x4*)(g + 64);
            if (DQK == 192) r[ps][NIG - 1] = *(const u32x4*)(gp + ((size_t)tile * 64 + ps * 32) * 64);
        }
    }
    DEV void load_piece(int tile, int pc) {
        const int ps = pc / NIG, q = pc % NIG;
        const bf16_t* g = gm + ((size_t)tile * 64 + ps * 32) * 128;
        if (q == 0) r[ps][0] = *(const u32x4*)g;
        else if (q == 1) r[ps][1] = *(const u32x4*)(g + 64);
        else r[ps][NIG - 1] = *(const u32x4*)(gp + ((size_t)tile * 64 + ps * 32) * 64);
    }
    DEV void write(unsigned char* ldsK) {
#pragma unroll
        for (int ps = 0; ps < 2; ++ps) {
            *(u32x4*)(ldsK + l0 + ps * 32 * DQK * 2) = r[ps][0]; *(u32x4*)(ldsK + l1 + ps * 32 * DQK * 2) = r[ps][1];
            if (DQK == 192) *(u32x4*)(ldsK + l0 + 256 + ps * 32 * DQK * 2) = r[ps][NIG - 1];
        }
    }
};
struct VStage {
    u32x4 r[4]; const bf16_t* g; int l; size_t rstride;
    DEV void init(const bf16_t* VT, int LV, int t) { const int row = t >> 3, c = t & 7; g = VT + (size_t)row * LV + c * 8; rstride = (size_t)32 * LV; l = row * 128 + ((c ^ ((row >> 1) & 7)) << 4); }
    DEV void load(int tile) {
#pragma unroll
        for (int i = 0; i < 4; ++i) r[i] = *(const u32x4*)(g + i * rstride + (size_t)tile * 64);
    }
    DEV void load_piece(int tile, int i) { r[i] = *(const u32x4*)(g + i * rstride + (size_t)tile * 64); }
    DEV void write(unsigned char* ldsV) {
#pragma unroll
        for (int i = 0; i < 4; ++i) *(u32x4*)(ldsV + l + i * 4096) = r[i];
    }
};
template <int DQK> DEV int kfrag_off(int krow, int ks, int hh) {
    const int c = 2 * ks + hh;
    if (DQK == 128) return krow * 256 + ((c ^ (krow & 15)) << 4);
    else return krow * 384 + ((((c & ~7) | ((c & 7) ^ ((krow >> 1) & 7)))) << 4);
}
DEV int vfrag_off(int r, int c) { return r * 128 + ((c ^ ((r >> 1) & 7)) << 4); }

constexpr int PFD = 0;
constexpr int OT_OFF = 40960, OT_STRIDE = 272;
template <int DQK, bool CAUSAL, int ABL = 0>
DEV void attn_unit(unsigned char* lds, const bf16_t* Q, const bf16_t* Kmain, const bf16_t* Kpe, const bf16_t* VT, int LV, int q0, int ntiles,
                   bf16_t* O, int ldo, u64* sq  , int orow0) {
    constexpr int NKS = DQK / 16, KTILE_BYTES = 64 * DQK * 2;
    const int tid = tidf();
    const int lane = tid & 63, wid = tid >> 6, pr = wid >> 1, kh = wid & 1, l31 = lane & 31, hh = lane >> 5;
    unsigned char* ldsK = lds; unsigned char* ldsV = lds + KTILE_BYTES;
    bf16x8 qf[NKS];
    { const bf16_t* qp = Q + (size_t)(q0 + pr * 32 + l31) * DQK + hh * 8;
#pragma unroll
      for (int ks = 0; ks < NKS; ++ks) qf[ks] = *(const bf16x8*)(qp + ks * 16); }
    f32x16 oacc[4];
#pragma unroll
    for (int i = 0; i < 4; ++i)
#pragma unroll
        for (int r = 0; r < 16; ++r) oacc[i][r] = 0.f;
    float mrun = -1e30f, lrun = 0.f;
    int pfv0 = 0, pfv1 = 0;
    KStage<DQK> ksg; VStage vsg;
    ksg.init(Kmain, Kpe, tid); vsg.init(VT, LV, tid);
    const int krow = kh * 32 + l31;
    int ka[DQK == 128 ? 8 : 4];
#pragma unroll
    for (int i = 0; i < (DQK == 128 ? 8 : 4); ++i) ka[i] = kfrag_off<DQK>(krow, i, hh);
    const int va0 = vfrag_off(l31, kh * 4 + hh), va1 = vfrag_off(l31, kh * 4 + 2 + hh);
    __builtin_amdgcn_s_setprio(1);
    if (ABL != 1) { ksg.load(0); vsg.load(0); ksg.write(ldsK); vsg.write(ldsV); } __syncthreads();
    const int qpos = q0 + pr * 32 + l31;
    for (int t = 0; t < ntiles; ++t) {
        const bool more = t + 1 < ntiles;
        if (more && ABL != 1) { if (ABL != 5) ksg.load(t + 1); if (ABL != 4) vsg.load(t + 1); }
        __builtin_amdgcn_sched_barrier(0);
        const bool diag = CAUSAL && (t == ntiles - 1);
        if (!(diag && pr == 0 && kh == 1)) {
            bf16x8 vf0[4];
#pragma unroll
            for (int dvb = 0; dvb < 4; ++dvb) vf0[dvb] = *(const bf16x8*)(ldsV + va0 + dvb * 4096);
            __builtin_amdgcn_sched_barrier(0);
            f32x16 sacc;
#pragma unroll
            for (int r = 0; r < 16; ++r) sacc[r] = 0.f;
            __builtin_amdgcn_s_setprio(2);
            {
                auto koff = [&](int ks) { return (DQK == 128) ? ka[ks] : (ka[ks & 3] + 128 * (ks >> 2)); };
                bf16x8 kf[NKS];
#pragma unroll
                for (int ks = 0; ks < 4; ++ks) kf[ks] = *(const bf16x8*)(ldsK + koff(ks));
                __builtin_amdgcn_sched_barrier(0);
#pragma unroll
                for (int ks = 0; ks < NKS; ++ks) {
                    if (ABL == 2) { asm volatile("" :: "v"(kf[ks])); sacc[ks & 15] += 1.0f; } else sacc = __builtin_amdgcn_mfma_f32_32x32x16_bf16(kf[ks], qf[ks], sacc, 0, 0, 0);
                    if (ks + 4 < NKS) kf[ks + 4] = *(const bf16x8*)(ldsK + koff(ks + 4));
                    __builtin_amdgcn_sched_barrier(0);
                }
            }
            __builtin_amdgcn_s_setprio(1);
            if (diag) {
                const int kbase = t * 64 + kh * 32 + 4 * hh;
#pragma unroll
                for (int r = 0; r < 16; ++r) { const int kp = kbase + (r & 3) + 8 * (r >> 2); if (kp > qpos) sacc[r] = -1e30f; }
            }
            float mnew = mrun;
            bool resc = false;
            if (ABL != 3) {
                float mx = sacc[0];
#pragma unroll
                for (int r = 1; r < 16; ++r) mx = fmaxf(mx, sacc[r]);
                mx = fmaxf(mx, __shfl_xor(mx, 32));
                resc = __any(mx > mrun + 8.0f);
                if (resc) {
                    mnew = fmaxf(mrun, mx);
                    const float alpha = fexp2(mrun - mnew);
                    mrun = mnew; lrun *= alpha;
#pragma unroll
                    for (int i = 0; i < 4; ++i)
#pragma unroll
                        for (int r = 0; r < 16; ++r) oacc[i][r] *= alpha;
                }
            }
            float ps = 0.f;
            if (ABL != 3) {
#pragma unroll
                for (int r = 0; r < 8; ++r) { sacc[r] = fexp2(sacc[r] - mnew); ps += sacc[r]; }
            }
            bf16x8 pf0;
            { u32x4 pw; pw.x = cvt_pk_bf16(sacc[0], sacc[1]); pw.y = cvt_pk_bf16(sacc[2], sacc[3]); pw.z = cvt_pk_bf16(sacc[4], sacc[5]); pw.w = cvt_pk_bf16(sacc[6], sacc[7]);
              __builtin_memcpy(&pf0, &pw, 16); }
            __builtin_amdgcn_s_setprio(2);
            bf16x8 vf1[4];
#pragma unroll
            for (int dvb = 0; dvb < 4; ++dvb) {
                __builtin_amdgcn_sched_barrier(0);
                if (ABL == 2) { asm volatile("" :: "v"(vf0[dvb]), "v"(pf0)); oacc[dvb][0] += 1.0f; } else oacc[dvb] = __builtin_amdgcn_mfma_f32_32x32x16_bf16(vf0[dvb], pf0, oacc[dvb], 0, 0, 0);
                vf1[dvb] = *(const bf16x8*)(ldsV + va1 + dvb * 4096);
            }
            __builtin_amdgcn_sched_barrier(0);
            if (ABL != 3) {
#pragma unroll
                for (int r = 8; r < 16; ++r) { sacc[r] = fexp2(sacc[r] - mnew); ps += sacc[r]; }
                lrun += ps;
            }
            bf16x8 pf1;
            { u32x4 pw; pw.x = cvt_pk_bf16(sacc[8], sacc[9]); pw.y = cvt_pk_bf16(sacc[10], sacc[11]); pw.z = cvt_pk_bf16(sacc[12], sacc[13]); pw.w = cvt_pk_bf16(sacc[14], sacc[15]);
              __builtin_memcpy(&pf1, &pw, 16); }
#pragma unroll
            for (int dvb = 0; dvb < 4; ++dvb) {
                if (ABL == 2) { asm volatile("" :: "v"(vf1[dvb]), "v"(pf1)); oacc[dvb][1] += 1.0f; } else oacc[dvb] = __builtin_amdgcn_mfma_f32_32x32x16_bf16(vf1[dvb], pf1, oacc[dvb], 0, 0, 0);
            }
            __builtin_amdgcn_s_setprio(1);
        }
        __syncthreads();
        if (more && ABL != 1) { if (ABL != 5) ksg.write(ldsK); if (ABL != 4) vsg.write(ldsV); }
        if (PFD > 0 && CAUSAL && ABL != 1) {
            asm volatile("" :: "v"(pfv0), "v"(pfv1));
            const int tt = min(t + PFD, ntiles - 1);
            const bf16_t* pp = (tid < 128) ? Kmain + ((size_t)tt * 64 + (tid >> 1)) * 128 + (tid & 1) * 64 : VT + (size_t)(tid - 128) * LV + (size_t)tt * 64;
            pfv0 = *(const int*)pp;
            if (DQK == 192) pfv1 = *(const int*)(Kpe + ((size_t)tt * 64 + (tid & 63)) * 64);
            __builtin_amdgcn_sched_barrier(0);
        }
        __syncthreads();
    }
    asm volatile("" :: "v"(pfv0), "v"(pfv1));
    __builtin_amdgcn_s_setprio(0);
    float lw = lrun + __shfl_xor(lrun, 32);
    float* xo = (float*)(lds + pr * 20480);
    if (kh == 1) {
#pragma unroll
        for (int i = 0; i < 4; ++i)
#pragma unroll
            for (int r = 0; r < 16; ++r) xo[(i * 16 + r) * 64 + lane] = oacc[i][r];
        xo[4096 + lane] = mrun; xo[4096 + 64 + lane] = lw;
    }
    __syncthreads();
    if (kh == 0 && O != nullptr) {
        const float m1 = xo[4096 + lane], l1 = xo[4096 + 64 + lane];
        const float m = fmaxf(mrun, m1), f0 = fexp2(mrun - m), f1 = fexp2(m1 - m);
        const float inv = 1.0f / (lw * f0 + l1 * f1);
        const float c0 = f0 * inv, c1 = f1 * inv;
        float ss = 0.f;
        unsigned char* ot = lds + OT_OFF + (pr * 32 + l31) * OT_STRIDE;
#pragma unroll
        for (int i = 0; i < 4; ++i)
#pragma unroll
            for (int rq = 0; rq < 4; ++rq) {
                float v[4];
#pragma unroll
                for (int e = 0; e < 4; ++e) { const int r = rq * 4 + e; v[e] = oacc[i][r] * c0 + xo[(i * 16 + r) * 64 + lane] * c1; ss += v[e] * v[e]; }
                u32x2 w; w.x = cvt_pk_bf16(v[0], v[1]); w.y = cvt_pk_bf16(v[2], v[3]);
                *(u32x2*)(ot + (i * 32 + 8 * rq + 4 * hh) * 2) = w;
            }
        if (sq) { ss += __shfl_xor(ss, 32); if (hh == 0) sq_add(sq, orow0 + pr * 32 + l31, ss); }
    }
    if (O == nullptr) { _Pragma("unroll") for (int i = 0; i < 4; ++i) asm volatile("" :: "v"(oacc[i])); asm volatile("" :: "v"(lrun), "v"(mrun)); }
    __syncthreads();
    if (O != nullptr) {
#pragma unroll
        for (int i = 0; i < 4; ++i) {
            const int c = tid + i * NTHREADS, row = c >> 4, ch = c & 15;
            const u32x4 w = *(const u32x4*)(lds + OT_OFF + row * OT_STRIDE + ch * 16);
            *(u32x4*)(O + (size_t)(orow0 + row) * ldo + ch * 8) = w;
        }
    }
    __syncthreads();
}

DEV void mla_unit(unsigned char* lds, const bf16_t* Q, const bf16_t* Kmain, const bf16_t* Kpe, const bf16_t* VT, int q0, int ntiles,
                  bf16_t* O, int ldo, u64* sq, int orow0) {
    constexpr int DQK = 192, NKS = 12, KTILE_BYTES = 64 * DQK * 2;
    const int tid = tidf();
    const int lane = tid & 63, wid = tid >> 6, pr = wid >> 1, kh = wid & 1, l31 = lane & 31, hh = lane >> 5;
    unsigned char* ldsK = lds; unsigned char* ldsV = lds + KTILE_BYTES;
    bf16x8 qf[NKS];
    { const bf16_t* qp = Q + (size_t)(q0 + pr * 32 + l31) * DQK + hh * 8;
#pragma unroll
      for (int ks = 0; ks < NKS; ++ks) qf[ks] = *(const bf16x8*)(qp + ks * 16); }
    f32x16 oacc[4];
#pragma unroll
    for (int i = 0; i < 4; ++i)
#pragma unroll
        for (int r = 0; r < 16; ++r) oacc[i][r] = 0.f;
    float mrun = -1e30f, lrun = 0.f;
    KStage<DQK> ksg; VStage vsg;
    ksg.init(Kmain, Kpe, tid); vsg.init(VT, S, tid);
    const int krow = kh * 32 + l31;
    int ka[4];
#pragma unroll
    for (int i = 0; i < 4; ++i) ka[i] = kfrag_off<DQK>(krow, i, hh);
    const int va0 = vfrag_off(l31, kh * 4 + hh), va1 = vfrag_off(l31, kh * 4 + 2 + hh);
    const int qpos = q0 + pr * 32 + l31;
    auto rdK = [&](int ks) { return *(const bf16x8*)(ldsK + ka[ks & 3] + 128 * (ks >> 2)); };
    __builtin_amdgcn_s_setprio(1);
    ksg.load(0); vsg.load(0); ksg.write(ldsK); vsg.write(ldsV); __syncthreads();
    ksg.load(ntiles > 1 ? 1 : 0);
    __builtin_amdgcn_sched_barrier(0);
    f32x16 sacc;
#pragma unroll
    for (int r = 0; r < 16; ++r) sacc[r] = 0.f;
#pragma unroll
    for (int ks = 0; ks < NKS; ++ks) sacc = __builtin_amdgcn_mfma_f32_32x32x16_bf16(rdK(ks), qf[ks], sacc, 0, 0, 0);
    __syncthreads();
    ksg.write(ldsK);
    __syncthreads();
    for (int t = 0; t + 1 < ntiles; ++t) {
        const int tk = min(t + 2, ntiles - 1), tv = t + 1;
        f32x16 sn;
#pragma unroll
        for (int r = 0; r < 16; ++r) sn[r] = 0.f;
        bf16x8 kf[NKS];
        kf[0] = rdK(0); kf[1] = rdK(1); kf[2] = rdK(2);
        __builtin_amdgcn_sched_barrier(0);
        __builtin_amdgcn_s_setprio(2);
        float mx = fmaxf(fmaxf(sacc[0], sacc[1]), fmaxf(sacc[2], sacc[3]));
        sn = __builtin_amdgcn_mfma_f32_32x32x16_bf16(kf[0], qf[0], sn, 0, 0, 0); kf[3] = rdK(3); ksg.load_piece(tk, 0);
        mx = fmaxf(mx, fmaxf(fmaxf(sacc[4], sacc[5]), fmaxf(sacc[6], sacc[7])));
        mx = fmaxf(mx, fmaxf(fmaxf(sacc[8], sacc[9]), fmaxf(sacc[10], sacc[11])));
        __builtin_amdgcn_sched_barrier(0);
        sn = __builtin_amdgcn_mfma_f32_32x32x16_bf16(kf[1], qf[1], sn, 0, 0, 0); kf[4] = rdK(4); ksg.load_piece(tk, 1);
        mx = fmaxf(mx, fmaxf(fmaxf(sacc[12], sacc[13]), fmaxf(sacc[14], sacc[15])));
        const float mxo = __shfl_xor(mx, 32);
        __builtin_amdgcn_sched_barrier(0);
        sn = __builtin_amdgcn_mfma_f32_32x32x16_bf16(kf[2], qf[2], sn, 0, 0, 0); kf[5] = rdK(5); ksg.load_piece(tk, 2);
        __builtin_amdgcn_sched_barrier(0);
        sn = __builtin_amdgcn_mfma_f32_32x32x16_bf16(kf[3], qf[3], sn, 0, 0, 0); kf[6] = rdK(6); ksg.load_piece(tk, 3);
        __builtin_amdgcn_sched_barrier(0);
        mx = fmaxf(mx, mxo);
        if (__any(mx > mrun + 8.0f)) {
            const float mnew = fmaxf(mrun, mx), alpha = fexp2(mrun - mnew);
            mrun = mnew; lrun *= alpha;
#pragma unroll
            for (int i = 0; i < 4; ++i)
#pragma unroll
                for (int r = 0; r < 16; ++r) oacc[i][r] *= alpha;
        }
        float ps = 0.f;
        bf16x8 vf0[4];
#pragma unroll
        for (int ks = 4; ks < NKS; ++ks) {
            sn = __builtin_amdgcn_mfma_f32_32x32x16_bf16(kf[ks], qf[ks], sn, 0, 0, 0);
            if (ks < 6) ksg.load_piece(tk, ks); else if (ks < 10) vsg.load_piece(tv, ks - 6);
            if (ks + 3 < NKS) kf[ks + 3] = rdK(ks + 3);
            else if (ks >= 9) { vf0[ks - 9] = *(const bf16x8*)(ldsV + va0 + (ks - 9) * 4096); if (ks == 11) vf0[3] = *(const bf16x8*)(ldsV + va0 + 3 * 4096); }
            sacc[ks - 4] = fexp2(sacc[ks - 4] - mrun); ps += sacc[ks - 4];
            __builtin_amdgcn_sched_barrier(0);
        }
        bf16x8 pf0;
        { u32x4 pw; pw.x = cvt_pk_bf16(sacc[0], sacc[1]); pw.y = cvt_pk_bf16(sacc[2], sacc[3]); pw.z = cvt_pk_bf16(sacc[4], sacc[5]); pw.w = cvt_pk_bf16(sacc[6], sacc[7]);
          __builtin_memcpy(&pf0, &pw, 16); }
        bf16x8 vf1[4];
#pragma unroll
        for (int dvb = 0; dvb < 4; ++dvb) {
            __builtin_amdgcn_sched_barrier(0);
            oacc[dvb] = __builtin_amdgcn_mfma_f32_32x32x16_bf16(vf0[dvb], pf0, oacc[dvb], 0, 0, 0);
            vf1[dvb] = *(const bf16x8*)(ldsV + va1 + dvb * 4096);
            sacc[8 + 2 * dvb] = fexp2(sacc[8 + 2 * dvb] - mrun); sacc[9 + 2 * dvb] = fexp2(sacc[9 + 2 * dvb] - mrun);
            ps += sacc[8 + 2 * dvb] + sacc[9 + 2 * dvb];
        }
        __builtin_amdgcn_sched_barrier(0);
        lrun += ps;
        bf16x8 pf1;
        { u32x4 pw; pw.x = cvt_pk_bf16(sacc[8], sacc[9]); pw.y = cvt_pk_bf16(sacc[10], sacc[11]); pw.z = cvt_pk_bf16(sacc[12], sacc[13]); pw.w = cvt_pk_bf16(sacc[14], sacc[15]);
          __builtin_memcpy(&pf1, &pw, 16); }
#pragma unroll
        for (int dvb = 0; dvb < 4; ++dvb) oacc[dvb] = __builtin_amdgcn_mfma_f32_32x32x16_bf16(vf1[dvb], pf1, oacc[dvb], 0, 0, 0);
        __builtin_amdgcn_s_setprio(1);
        sacc = sn;
        __syncthreads();
        ksg.write(ldsK); vsg.write(ldsV);
        __syncthreads();
    }
    if (!(pr == 0 && kh == 1)) {
        const int kbase = (ntiles - 1) * 64 + kh * 32 + 4 * hh;
#pragma unroll
        for (int r = 0; r < 16; ++r) { const int kp = kbase + (r & 3) + 8 * (r >> 2); if (kp > qpos) sacc[r] = -1e30f; }
        float mx = sacc[0];
#pragma unroll
        for (int r = 1; r < 16; ++r) mx = fmaxf(mx, sacc[r]);
        mx = fmaxf(mx, __shfl_xor(mx, 32));
        if (__any(mx > mrun + 8.0f)) {
            const float mnew = fmaxf(mrun, mx), alpha = fexp2(mrun - mnew);
            mrun = mnew; lrun *= alpha;
#pragma unroll
            for (int i = 0; i < 4; ++i)
#pragma unroll
                for (int r = 0; r < 16; ++r) oacc[i][r] *= alpha;
        }
        float ps = 0.f;
#pragma unroll
        for (int r = 0; r < 16; ++r) { sacc[r] = fexp2(sacc[r] - mrun); ps += sacc[r]; }
        lrun += ps;
        __builtin_amdgcn_s_setprio(2);
#pragma unroll
        for (int s2 = 0; s2 < 2; ++s2) {
            u32x4 pw; pw.x = cvt_pk_bf16(sacc[8 * s2 + 0], sacc[8 * s2 + 1]); pw.y = cvt_pk_bf16(sacc[8 * s2 + 2], sacc[8 * s2 + 3]);
            pw.z = cvt_pk_bf16(sacc[8 * s2 + 4], sacc[8 * s2 + 5]); pw.w = cvt_pk_bf16(sacc[8 * s2 + 6], sacc[8 * s2 + 7]);
            bf16x8 pf; __builtin_memcpy(&pf, &pw, 16);
#pragma unroll
            for (int dvb = 0; dvb < 4; ++dvb) {
                const bf16x8 vf = *(const bf16x8*)(ldsV + (s2 ? va1 : va0) + dvb * 4096);
                oacc[dvb] = __builtin_amdgcn_mfma_f32_32x32x16_bf16(vf, pf, oacc[dvb], 0, 0, 0);
            }
        }
    }
    __syncthreads();
    __builtin_amdgcn_s_setprio(0);
    float lw = lrun + __shfl_xor(lrun, 32);
    float* xo = (float*)(lds + pr * 20480);
    if (kh == 1) {
#pragma unroll
        for (int i = 0; i < 4; ++i)
#pragma unroll
            for (int r = 0; r < 16; ++r) xo[(i * 16 + r) * 64 + lane] = oacc[i][r];
        xo[4096 + lane] = mrun; xo[4096 + 64 + lane] = lw;
    }
    __syncthreads();
    if (kh == 0) {
        const float m1 = xo[4096 + lane], l1 = xo[4096 + 64 + lane];
        const float m = fmaxf(mrun, m1), f0 = fexp2(mrun - m), f1 = fexp2(m1 - m);
        const float inv = 1.0f / (lw * f0 + l1 * f1);
        const float c0 = f0 * inv, c1 = f1 * inv;
        float ss = 0.f;
        unsigned char* ot = lds + OT_OFF + (pr * 32 + l31) * OT_STRIDE;
#pragma unroll
        for (int i = 0; i < 4; ++i)
#pragma unroll
            for (int rq = 0; rq < 4; ++rq) {
                float v[4];
#pragma unroll
                for (int e = 0; e < 4; ++e) { const int r = rq * 4 + e; v[e] = oacc[i][r] * c0 + xo[(i * 16 + r) * 64 + lane] * c1; ss += v[e] * v[e]; }
                u32x2 w; w.x = cvt_pk_bf16(v[0], v[1]); w.y = cvt_pk_bf16(v[2], v[3]);
                *(u32x2*)(ot + (i * 32 + 8 * rq + 4 * hh) * 2) = w;
            }
        if (sq) { ss += __shfl_xor(ss, 32); if (hh == 0) sq_add(sq, orow0 + pr * 32 + l31, ss); }
    }
    __syncthreads();
#pragma unroll
    for (int i = 0; i < 4; ++i) {
        const int c = tid + i * NTHREADS, row = c >> 4, ch = c & 15;
        const u32x4 w = *(const u32x4*)(lds + OT_OFF + row * OT_STRIDE + ch * 16);
        *(u32x4*)(O + (size_t)(orow0 + row) * ldo + ch * 8) = w;
    }
    __syncthreads();
}

DEV void sb_unit(unsigned char* lds, const bf16_t* Q, const bf16_t* K, const bf16_t* VT, int U, bf16_t* O  , u64* sq, int tok0) {
    constexpr int KTILE_BYTES = 64 * 128 * 2;
    const int tid = tidf();
    const int lane = tid & 63, wid = tid >> 6, l31 = lane & 31, hh = lane >> 5;
    unsigned char* ldsK = lds; unsigned char* ldsV = lds + KTILE_BYTES;
    volatile int* flags = (volatile int*)(lds + LDS_MAIN + 64);
    const int q0 = U * 128 + wid * 32, qpos = q0 + l31;
    bf16x8 qf[8];
    { const bf16_t* qp = Q + (size_t)qpos * 128 + hh * 8;
#pragma unroll
      for (int ks = 0; ks < 8; ++ks) qf[ks] = *(const bf16x8*)(qp + ks * 16); }
    f32x16 oacc[4];
#pragma unroll
    for (int i = 0; i < 4; ++i)
#pragma unroll
        for (int r = 0; r < 16; ++r) oacc[i][r] = 0.f;
    float R = 0.f;
    KStage<128> ksg; VStage vsg;
    ksg.init(K, nullptr, tid); vsg.init(VT, S, tid);
    int ka[8];
#pragma unroll
    for (int i = 0; i < 8; ++i) ka[i] = kfrag_off<128>(l31, i, hh);
    const int va[4] = {vfrag_off(l31, hh), vfrag_off(l31, 2 + hh), vfrag_off(l31, 4 + hh), vfrag_off(l31, 6 + hh)};
    int t = 2 * U + 1;
    __builtin_amdgcn_s_setprio(1);
    ksg.load(t); vsg.load(t); ksg.write(ldsK); vsg.write(ldsV); __syncthreads();
    for (; t >= 0; --t) {
        const bool more = t > 0;
        if (more) { ksg.load(t - 1); vsg.load(t - 1); }
        __builtin_amdgcn_sched_barrier(0);
        const int kt0 = t * 64;
        if (kt0 < q0 + 31) {
            const bool need_mask = (kt0 + 63 >= q0);
#pragma unroll
            for (int kb = 1; kb >= 0; --kb) {
                f32x16 z;
#pragma unroll
                for (int r = 0; r < 16; ++r) z[r] = 0.f;
                __builtin_amdgcn_s_setprio(2);
#pragma unroll
                for (int ks = 0; ks < 8; ++ks) {
                    const bf16x8 kf = *(const bf16x8*)(ldsK + ka[ks] + kb * 8192);
                    z = __builtin_amdgcn_mfma_f32_32x32x16_bf16(kf, qf[ks], z, 0, 0, 0);
                }
                __builtin_amdgcn_s_setprio(1);
                float l1m[16];
#pragma unroll
                for (int r = 0; r < 16; ++r) {
                    const float zz = z[r];
                    const float sp = fmaxf(zz, 0.f) + flog2(1.0f + fexp2(-fabsf(zz)));
                    const int kp = kt0 + kb * 32 + (r & 3) + 8 * (r >> 2) + 4 * hh;
                    const bool ok = !need_mask || (kp < qpos);
                    l1m[r] = ok ? -sp : 0.f;
                    z[r] = ok ? zz : -1e30f;
                }
                float gs[4], pgs[4];
#pragma unroll
                for (int g = 0; g < 4; ++g) { gs[g] = (l1m[4 * g] + l1m[4 * g + 1]) + (l1m[4 * g + 2] + l1m[4 * g + 3]); pgs[g] = __shfl_xor(gs[g], 32); }
                float tail = 0.f;
#pragma unroll
                for (int g = 3; g >= 0; --g) {
                    const float sg = R + tail + (hh == 0 ? pgs[g] : 0.f);
                    const float e2 = l1m[4 * g + 3], e1 = e2 + l1m[4 * g + 2], e0 = e1 + l1m[4 * g + 1];
                    z[4 * g + 3] = fexp2(z[4 * g + 3] + l1m[4 * g + 3] + sg);
                    z[4 * g + 2] = fexp2(z[4 * g + 2] + l1m[4 * g + 2] + sg + e2);
                    z[4 * g + 1] = fexp2(z[4 * g + 1] + l1m[4 * g + 1] + sg + e1);
                    z[4 * g + 0] = fexp2(z[4 * g + 0] + l1m[4 * g + 0] + sg + e0);
                    tail += gs[g] + pgs[g];
                }
                R += tail;
                __builtin_amdgcn_s_setprio(2);
#pragma unroll
                for (int s2 = 0; s2 < 2; ++s2) {
                    u32x4 pw; pw.x = cvt_pk_bf16(z[8 * s2 + 0], z[8 * s2 + 1]); pw.y = cvt_pk_bf16(z[8 * s2 + 2], z[8 * s2 + 3]);
                    pw.z = cvt_pk_bf16(z[8 * s2 + 4], z[8 * s2 + 5]); pw.w = cvt_pk_bf16(z[8 * s2 + 6], z[8 * s2 + 7]);
                    bf16x8 pf; __builtin_memcpy(&pf, &pw, 16);
#pragma unroll
                    for (int dvb = 0; dvb < 4; ++dvb) {
                        const bf16x8 vf = *(const bf16x8*)(ldsV + va[kb * 2 + s2] + dvb * 4096);
                        oacc[dvb] = __builtin_amdgcn_mfma_f32_32x32x16_bf16(vf, pf, oacc[dvb], 0, 0, 0);
                    }
                }
                __builtin_amdgcn_s_setprio(1);
            }
        }
        const bool wdone = __all(R < -160.0f);
        if (lane == 0) flags[wid] = wdone ? 1 : 0;
        __syncthreads();
        const bool alldone = (flags[0] & flags[1] & flags[2] & flags[3]) != 0;
        if (alldone || !more) break;
        ksg.write(ldsK); vsg.write(ldsV);
        __syncthreads();
    }
    __syncthreads();
    __builtin_amdgcn_s_setprio(0);
    float ss = 0.f;
    unsigned char* ot = lds + (wid * 32 + l31) * OT_STRIDE;
#pragma unroll
    for (int i = 0; i < 4; ++i)
#pragma unroll
        for (int rq = 0; rq < 4; ++rq) {
            const float v0 = oacc[i][rq * 4], v1 = oacc[i][rq * 4 + 1], v2 = oacc[i][rq * 4 + 2], v3 = oacc[i][rq * 4 + 3];
            ss += v0 * v0 + v1 * v1 + v2 * v2 + v3 * v3;
            u32x2 w; w.x = cvt_pk_bf16(v0, v1); w.y = cvt_pk_bf16(v2, v3);
            *(u32x2*)(ot + (i * 32 + 8 * rq + 4 * hh) * 2) = w;
        }
    ss += __shfl_xor(ss, 32); if (sq && hh == 0) sq_add(sq, tok0 + qpos, ss);
    __syncthreads();
#pragma unroll
    for (int i = 0; i < 8; ++i) {
        const int c = tid + i * NTHREADS, row = c >> 4, ch = c & 15;
        const u32x4 w = *(const u32x4*)(lds + row * OT_STRIDE + ch * 16);
        *(u32x4*)(O + (size_t)(U * 128 + row) * 2048 + ch * 8) = w;
    }
    __syncthreads();
}


template <class RowF>
DEV void transpose_item8(const float* src, int N, u8* dst, int ldd, int k0, int n0, int lane, RowF dstrow) {
    const int ln = lane & 7, lk = lane >> 3, k = k0 + lk * 16, n = n0 + ln * 4;
    f32x4 v[16];
#pragma unroll
    for (int kk = 0; kk < 16; ++kk) v[kk] = __builtin_nontemporal_load((const f32x4*)(src + (size_t)(k + kk) * N + n)) * W8_SCALE;
#pragma unroll
    for (int j = 0; j < 4; ++j) {
        u32x4 w; w.x = pack_fp8x4(v[0][j], v[1][j], v[2][j], v[3][j]); w.y = pack_fp8x4(v[4][j], v[5][j], v[6][j], v[7][j]);
        w.z = pack_fp8x4(v[8][j], v[9][j], v[10][j], v[11][j]); w.w = pack_fp8x4(v[12][j], v[13][j], v[14][j], v[15][j]);
        __builtin_nontemporal_store(w, (u32x4*)(dst + (size_t)dstrow(n + j) * ldd + k));
    }
}
DEV void moe_convert(const P& p, int gw, int ngw, int lane) {
    unsigned char* ws = p.ws;
    constexpr int I_G = 16 * 16, I_E = 2 * I_G, NITEMS = 32 * I_E;
    for (int it = gw; it < NITEMS; it += ngw) {
        const int e = it / I_E; int r = it - e * I_E;
        u8* gu = (u8*)(ws + WS_WGU) + (size_t)e * 1024 * 2048;
        const int up = r >= I_G; if (up) r -= I_G; const int kt = r / 16, nt = r % 16;
        const float* src = (up ? p.w_up : p.w_gate) + (size_t)e * 2048 * 512;
        transpose_item8(src, 512, gu, 2048, kt * 128, nt * 32, lane,
            [up](int c) { const int t = c >> 6, rr = c & 63, wc = rr >> 5, r32 = rr & 31, fq = r32 >> 3, q = (r32 >> 2) & 1, rg = r32 & 3; return t * 128 + wc * 64 + fq * 16 + (2 * q + up) * 4 + rg; });
    }
}
DEV void moe_convert_down(const P& p, int gw, int ngw, int lane, int e_lo, int e_hi) {
    unsigned char* ws = p.ws;
    constexpr int I_D = 4 * 64;
    const int NITEMS = e_hi * I_D;
    for (int it = e_lo * I_D + gw; it < NITEMS; it += ngw) {
        const int e = it / I_D, r = it - e * I_D, kt = r / 64, nt = r % 64;
        transpose_item8(p.w_down + (size_t)e * 512 * 2048, 2048, (u8*)(ws + WS_WD) + (size_t)e * 2048 * 512, 512, kt * 128, nt * 32, lane, [](int n) { return n; });
    }
}
DEV void phase3(const P& p, unsigned char* lds, bool dry = false) {
    unsigned char* ws = p.ws;
    u64* sqb = (u64*)(ws + CTL_SQ);
    bf16_t* omix = (bf16_t*)(ws + WS_OMIX);
    const int G = gridDim.x;
    volatile int* rolew = (volatile int*)(lds + LDS_MAIN + 128);
    if (threadIdx.x == 0) {
        const unsigned hw = (unsigned)__builtin_amdgcn_s_getreg(((8 - 1) << 11) | (8 << 6) | 4);
        const unsigned slot = atomicAdd((unsigned*)(ws + CTL_CU) + (xb_xcc_id() & 7u) * 256u + (hw & 255u), 1u);
        rolew[0] = (int)(slot & 1u);
    }
    __syncthreads();
    const bool conv_first = rolew[0] != 0;
    const int cgw = (int)blockIdx.x * 4 + (tidf() >> 6), cngw = G * 4;
    if (!dry) late_convert(p, cgw, cngw, tidf() & 63);
    if (conv_first && !dry) moe_convert(p, cgw, cngw, tidf() & 63);
    for (int w0 = blockIdx.x; w0 < 512; w0 += G) {
        const int w = ((G & 7) == 0 && G >= 64) ? ((((w0 & 7) * 2 + ((w0 >> 3) >> 5)) & 15) * 32 + ((w0 >> 3) & 31)) : w0;
        const int bh = w >> 5, uu = w & 31, b = bh >> 3, h = bh & 7;
#pragma unroll 1
        for (int half = 0; half < 2; ++half) {
            const int u = half ? (63 - uu) : uu;
            mla_unit(lds, (const bf16_t*)(ws + WS_QM) + (size_t)bh * S * 192, (const bf16_t*)(ws + WS_KN) + (size_t)bh * S * 128,
                     (const bf16_t*)(ws + WS_KPE) + (size_t)b * S * 64, (const bf16_t*)(ws + WS_VMT) + (size_t)bh * 128 * S, u * 64, u + 1,
                     omix + (size_t)b * S * 2048 + h * 128, 2048, dry ? nullptr : sqb + SQ_OMLA * T + b * S, u * 64);
        }
    }
    for (int w0 = blockIdx.x; w0 < 512; w0 += G) {
        const int w = ((G & 7) == 0 && G >= 64) ? ((((w0 & 7) * 2 + ((w0 >> 3) >> 5)) & 15) * 32 + ((w0 >> 3) & 31)) : w0;
        const int bh = w >> 5, U = w & 31, b = bh >> 3, h = bh & 7;
        sb_unit(lds, (const bf16_t*)(ws + WS_QSB) + (size_t)bh * S * 128, (const bf16_t*)(ws + WS_KSB) + (size_t)bh * S * 128,
                (const bf16_t*)(ws + WS_VSBT) + (size_t)bh * 128 * S, U, omix + (size_t)b * S * 2048 + 1024 + h * 128, dry ? nullptr : sqb + SQ_OSB * T, b * S);
    }
    if (!conv_first && !dry) moe_convert(p, cgw, cngw, tidf() & 63);
}


template <int ABL>
DEV void phase3_dry(const P& p, unsigned char* lds) {
    unsigned char* ws = p.ws;
    const int G = gridDim.x;
    for (int w0 = blockIdx.x; w0 < 512; w0 += G) {
        const int w = ((G & 7) == 0 && G >= 64) ? ((((w0 & 7) * 2 + ((w0 >> 3) >> 5)) & 15) * 32 + ((w0 >> 3) & 31)) : w0;
        const int bh = w >> 5, uu = w & 31, b = bh >> 3;
#pragma unroll 1
        for (int half = 0; half < 2; ++half) {
            const int u = half ? (63 - uu) : uu;
            attn_unit<192, true, ABL>(lds, (const bf16_t*)(ws + WS_QM) + (size_t)bh * S * 192, (const bf16_t*)(ws + WS_KN) + (size_t)bh * S * 128,
                                 (const bf16_t*)(ws + WS_KPE) + (size_t)b * S * 64, (const bf16_t*)(ws + WS_VMT) + (size_t)bh * 128 * S, S, u * 64, u + 1,
                                 nullptr, 2048, nullptr, u * 64);
        }
    }
}
DEV void phase4(const P& p, unsigned char* lds, bool dry = false) {
    unsigned char* ws = p.ws;
    const XcdIter xi = xcd_iter();
    const int lane = tidf() & 63, wid = tidf() >> 6, wr = wid >> 1, wc = wid & 1, fr = lane & 15, fq = lane >> 4;
    u64* sqb = (u64*)(ws + CTL_SQ);
    bf16_t* x1b = (bf16_t*)(ws + WS_X1B);
    const int per_x = 8 * 16, total = 64 * 16;
    auto tile_at = [&](int it, int& mt, int& nt) -> bool {
        if (xi.x >= 0) { const int i = it * xi.per + xi.j; if (i >= per_x) return false; mt = xi.x * 8 + (i & 7); nt = i >> 3; }
        else { const int i = it * xi.per + xi.j; if (i >= total) return false; mt = i & 63; nt = i >> 6; }
        return true; };
    GemmPipe gp{0, false};
    int mt, nt; bool have = tile_at(0, mt, nt);
    if (!have) return;
    GT cur = gt_dense((const bf16_t*)(ws + WS_OMIX), D, mt * 128, (const bf16_t*)(ws + WS_WOUT), D, nt * 128, 0);
    for (int it = 0; have; ++it) {
        int mtn, ntn; const bool hn = tile_at(it + 1, mtn, ntn);
        const int m0 = mt * 128;
        const GT cur2 = gt_dense((const bf16_t*)(ws + WS_OMIX), D, m0, (const bf16_t*)(ws + WS_WOUT), D, nt * 128, 1024);
        GT nx = cur; if (hn) nx = gt_dense((const bf16_t*)(ws + WS_OMIX), D, mtn * 128, (const bf16_t*)(ws + WS_WOUT), D, ntn * 128, 0);
        f32x4 acc[4][4]; acc_zero(acc);
        gemm_run(acc, lds, cur, 16, true, gp, cur2, true);
        float rsb[4];
#pragma unroll
        for (int j = 0; j < 4; ++j) {
            const int m = m0 + wr * 64 + j * 16 + fr;
            const float ra = sq_rs(sqb + SQ_OMLA * T, m, 1.0f / 1024.0f); rsb[j] = sq_rs(sqb + SQ_OSB * T, m, 1.0f / 1024.0f);
            const float ratio = ra / rsb[j];
#pragma unroll
            for (int i = 0; i < 4; ++i) acc[i][j] *= ratio;
        }
        gemm_run(acc, lds, cur2, 16, true, gp, nx, hn);
#pragma unroll
        for (int j = 0; j < 4; ++j) {
            const int m = m0 + wr * 64 + j * 16 + fr; float ss = 0.f;
            const int n0 = nt * 128 + wc * 64 + fq * 16;
            f32x4 vv[4];
#pragma unroll
            for (int i = 0; i < 4; ++i) {
                const f32x4 xv = *(const f32x4*)(p.x + (size_t)m * D + n0 + i * 4);
                const f32x4 v = xv + acc[i][j] * rsb[j];
                ss += v[0] * v[0] + v[1] * v[1] + v[2] * v[2] + v[3] * v[3];
                vv[i] = v;
            }
            st_bf16x16(x1b + (size_t)m * D + n0, vv[0], vv[1], vv[2], vv[3]);
            ss += __shfl_xor(ss, 16); ss += __shfl_xor(ss, 32); if (fq == 0 && !dry) sq_add(sqb + SQ_X1 * T, m, ss);
        }
        cur = nx; mt = mtn; nt = ntn; have = hn;
    }
}

DEV void phase5(const P& p, unsigned char* lds) {
    unsigned char* ws = p.ws;
    const XcdIter xi = xcd_iter();
    const int lane = tidf() & 63, wid = tidf() >> 6, wr = wid >> 1, wc = wid & 1, fr = lane & 15, fq = lane >> 4;
    const u64* sqb = (const u64*)(ws + CTL_SQ);
    const int per_x = 8 * 4 + 4, total = 64 * 4 + 32;
    {
        const int my = xi.j, nbusy = ((xi.x >= 0 ? per_x : total) + xi.per - 1) / xi.per > 1 ? xi.per : (xi.x >= 0 ? per_x : total);
        const int lists = xi.x >= 0 ? 8 : 1, nidle = (xi.per - nbusy) * lists;
        if (nidle > 0) { if (my >= nbusy) moe_convert_down(p, ((my - nbusy) * lists + (xi.x >= 0 ? xi.x : 0)) * 4 + (tidf() >> 6), nidle * 4, tidf() & 63, 0, 24); }
        else moe_convert_down(p, (int)blockIdx.x * 4 + (tidf() >> 6), (int)gridDim.x * 4, tidf() & 63, 0, 24);
    }
    for (int it = 0;; ++it) {
        int mt, nt; bool memkv = false;
        if (xi.x >= 0) { const int i = it * xi.per + xi.j; if (i >= per_x) break;
            if (i < 32) { mt = xi.x * 8 + (i & 7); nt = i >> 3; } else { memkv = true; const int q = xi.x * 4 + (i - 32); mt = q & 3; nt = q >> 2; } }
        else { const int i = it * xi.per + xi.j; if (i >= total) break;
            if (i < 256) { mt = i & 63; nt = i >> 6; } else { memkv = true; const int q = i - 256; mt = q & 3; nt = q >> 2; } }
        const int m0 = mt * 128, b = m0 >> 12, s0 = m0 & 4095;
        f32x4 acc[4][4]; acc_zero(acc);
        if (memkv) {
            const bool isv = nt >= 4;
            gemm_dense(acc, lds, (const bf16_t*)(ws + WS_MEMN), D, mt * 128, (const bf16_t*)(ws + WS_WMKV), D, nt * 128, 0, 32, !isv);
            const int bb = mt >> 1, mm0 = (mt & 1) * 128;
            if (!isv) store_rowmajor_sq(acc, (bf16_t*)(ws + WS_KMEM) + (size_t)((bb * 4 + nt) * 256) * 128, 128, mm0, 0, nullptr, 1.0f);
            else store_transposed(acc, (bf16_t*)(ws + WS_VMEMT) + (size_t)((bb * 4 + (nt - 4)) * 128) * 256, 256, mm0, nullptr, 0, 0.f);
            continue;
        }
        gemm_dense(acc, lds, (const bf16_t*)(ws + WS_X1B), D, m0, (const bf16_t*)(ws + WS_WMQ), D, nt * 128, 0, 32, true);
        bf16_t* qm = (bf16_t*)(ws + WS_QMEM) + (size_t)((b * 4 + nt) * S) * 128;
#pragma unroll
        for (int j = 0; j < 4; ++j) {
            const int ml = wr * 64 + j * 16 + fr;
            const float rs = sq_rs(sqb + SQ_X1 * T, m0 + ml, 1.0f / 2048.0f) * (0.08838834764831845f * LOG2E);
            st_bf16x16(qm + (size_t)(s0 + ml) * 128 + wc * 64 + fq * 16, acc[0][j] * rs, acc[1][j] * rs, acc[2][j] * rs, acc[3][j] * rs);
        }
    }
}

DEV void phase6(const P& p, unsigned char* lds) {
    unsigned char* ws = p.ws;
    for (int w = blockIdx.x; w < 512; w += gridDim.x) {
        const int bh = w >> 6, u = w & 63, b = bh >> 2, h = bh & 3;
        attn_unit<128, false>(lds, (const bf16_t*)(ws + WS_QMEM) + (size_t)bh * S * 128, (const bf16_t*)(ws + WS_KMEM) + (size_t)bh * 256 * 128, nullptr,
                              (const bf16_t*)(ws + WS_VMEMT) + (size_t)bh * 128 * 256, 256, u * 64, 4,
                              (bf16_t*)(ws + WS_OMEM) + (size_t)b * S * 512 + h * 128, 512, nullptr, u * 64);
    }
}

DEV void phase7(const P& p, unsigned char* lds, bool dry = false) {
    unsigned char* ws = p.ws;
    const XcdIter xi = xcd_iter();
    const int lane = tidf() & 63, wid = tidf() >> 6, wr = wid >> 1, wc = wid & 1, fr = lane & 15, fq = lane >> 4;
    u64* sqb = (u64*)(ws + CTL_SQ);
    bf16_t* x1b = (bf16_t*)(ws + WS_X1B); u8* x2f8 = (u8*)(ws + WS_X2B);
    bf16_t* x2lo = (bf16_t*)(ws + WS_X2LO);
    const int per_x = 8 * 16, total = 64 * 16;
    auto tile_at = [&](int it, int& mt, int& nt) -> bool {
        if (xi.x >= 0) { const int i = it * xi.per + xi.j; if (i >= per_x) return false; mt = xi.x * 8 + (i & 7); nt = i >> 3; }
        else { const int i = it * xi.per + xi.j; if (i >= total) return false; mt = i & 63; nt = i >> 6; }
        return true; };
    GemmPipe gp{0, false};
    int mt, nt; bool have = tile_at(0, mt, nt);
    if (!have) return;
    GT cur = gt_dense((const bf16_t*)(ws + WS_OMEM), 512, mt * 128, (const bf16_t*)(ws + WS_WMO), 512, nt * 128, 0);
    for (int it = 0; have; ++it) {
        int mtn, ntn; const bool hn = tile_at(it + 1, mtn, ntn);
        GT nx = cur; if (hn) nx = gt_dense((const bf16_t*)(ws + WS_OMEM), 512, mtn * 128, (const bf16_t*)(ws + WS_WMO), 512, ntn * 128, 0);
        const int m0 = mt * 128;
        f32x4 acc[4][4]; acc_zero(acc);
        gemm_run(acc, lds, cur, 8, true, gp, nx, hn);
#pragma unroll
        for (int j = 0; j < 4; ++j) {
            const int m = m0 + wr * 64 + j * 16 + fr; float ss = 0.f;
            const int n0 = nt * 128 + wc * 64 + fq * 16;
            const u32x4 xb0 = *(const u32x4*)(x1b + (size_t)m * D + n0), xb1 = *(const u32x4*)(x1b + (size_t)m * D + n0 + 8);
            const unsigned xw[8] = {xb0.x, xb0.y, xb0.z, xb0.w, xb1.x, xb1.y, xb1.z, xb1.w};
            u32x4 f8;
            unsigned hw[8], lw[8];
#pragma unroll
            for (int i = 0; i < 4; ++i) {
                const int n = n0 + i * 4;
                const f32x4 v = (f32x4){__uint_as_float(xw[2 * i] << 16), __uint_as_float(xw[2 * i] & 0xffff0000u), __uint_as_float(xw[2 * i + 1] << 16), __uint_as_float(xw[2 * i + 1] & 0xffff0000u)} + acc[i][j];
                ss += v[0] * v[0] + v[1] * v[1] + v[2] * v[2] + v[3] * v[3];
                hw[2 * i] = cvt_pk_bf16(v[0], v[1]); hw[2 * i + 1] = cvt_pk_bf16(v[2], v[3]);
                lw[2 * i] = cvt_pk_bf16(v[0] - __uint_as_float(hw[2 * i] << 16), v[1] - __uint_as_float(hw[2 * i] & 0xffff0000u));
                lw[2 * i + 1] = cvt_pk_bf16(v[2] - __uint_as_float(hw[2 * i + 1] << 16), v[3] - __uint_as_float(hw[2 * i + 1] & 0xffff0000u));
                const f32x4 gf = *(const f32x4*)(p.norm_ffn + n);
                f8[i] = pack_fp8x4_sat(v[0] * gf[0], v[1] * gf[1], v[2] * gf[2], v[3] * gf[3]);
            }
            *(u32x4*)(x1b + (size_t)m * D + n0) = (u32x4){hw[0], hw[1], hw[2], hw[3]}; *(u32x4*)(x1b + (size_t)m * D + n0 + 8) = (u32x4){hw[4], hw[5], hw[6], hw[7]};
            {
                bf16_t* lf = x2lo + ((size_t)((m >> 4) * 64 + (n0 >> 5)) * 64 + ((n0 >> 3) & 3) * 16 + (m & 15)) * 8;
                *(u32x4*)lf = (u32x4){lw[0], lw[1], lw[2], lw[3]}; *(u32x4*)(lf + 128) = (u32x4){lw[4], lw[5], lw[6], lw[7]}; }
            *(u32x4*)(x2f8 + (size_t)m * D + n0) = f8;
            ss += __shfl_xor(ss, 16); ss += __shfl_xor(ss, 32); if (fq == 0 && !dry) sq_add(sqb + SQ_X2 * T, m, ss);
        }
        cur = nx; mt = mtn; nt = ntn; have = hn;
    }
}

DEV void phase8(const P& p, unsigned char* lds) {
    unsigned char* ws = p.ws;
    const int tid = tidf(), lane = tid & 63, wid = tid >> 6, r16 = lane & 15, kq = lane >> 4;
    const u64* sqb = (const u64*)(ws + CTL_SQ);
    unsigned* cnt = (unsigned*)(ws + CTL_CNT);
    unsigned char* rt = ws + WS_ROUTE;
    float* red = (float*)lds;
    bool conv_done = false;
    for (int tb = blockIdx.x; tb < T / 16; tb += gridDim.x) {
        const int t0 = tb * 16;
        f32x4 acc[3];
#pragma unroll
        for (int c = 0; c < 3; ++c) acc[c] = (f32x4){0.f, 0.f, 0.f, 0.f};
        const size_t xo = (size_t)(t0 + r16) * D + wid * 512 + kq * 8;
        const bf16_t* xhp = (const bf16_t*)(ws + WS_X2HI) + xo;
        const bf16_t* xlp = (const bf16_t*)(ws + WS_X2LO) + ((size_t)(tb * 64 + wid * 16) * 64 + lane) * 8;
        const bf16_t* wf = (const bf16_t*)(ws + WS_WR) + (size_t)(wid * 16) * 3 * 2 * 512 + lane * 8;
#pragma unroll 4
        for (int k = 0; k < 512; k += 32) {
            const bf16x8 xh = *(const bf16x8*)(xhp + k), xl = *(const bf16x8*)(xlp + (k >> 5) * 512);
#pragma unroll
            for (int c = 0; c < 3; ++c) {
                const bf16x8 bh = *(const bf16x8*)(wf + (((k >> 5) * 3 + c) * 2) * 512), bl = *(const bf16x8*)(wf + (((k >> 5) * 3 + c) * 2 + 1) * 512);
                acc[c] = __builtin_amdgcn_mfma_f32_16x16x32_bf16(xh, bh, acc[c], 0, 0, 0);
                acc[c] = __builtin_amdgcn_mfma_f32_16x16x32_bf16(xh, bl, acc[c], 0, 0, 0);
                acc[c] = __builtin_amdgcn_mfma_f32_16x16x32_bf16(xl, bh, acc[c], 0, 0, 0);
            }
        }
#pragma unroll
        for (int c = 0; c < 3; ++c)
#pragma unroll
            for (int e = 0; e < 4; ++e) red[(wid * 16 + kq * 4 + e) * 48 + c * 16 + r16] = acc[c][e];
        __syncthreads();
        if (tid < 16) {
            const int tok = t0 + tid;
            const float rs = sq_rs(sqb + SQ_X2 * T, tok, 1.0f / 2048.0f);
            auto logit = [&](int n) { return ((red[(0 * 16 + tid) * 48 + n] + red[(1 * 16 + tid) * 48 + n]) + (red[(2 * 16 + tid) * 48 + n] + red[(3 * 16 + tid) * 48 + n])) * rs; };
            float lg0 = logit(0) + p.b_group[0], lg1 = logit(1) + p.b_group[1], lg2 = logit(2) + p.b_group[2], lg3 = logit(3) + p.b_group[3];
            int g = 0; float gm = lg0;
            if (lg1 > gm) { gm = lg1; g = 1; }
            if (lg2 > gm) { gm = lg2; g = 2; }
            if (lg3 > gm) { gm = lg3; g = 3; }
            const float gden = __expf(lg0 - gm) + __expf(lg1 - gm) + __expf(lg2 - gm) + __expf(lg3 - gm);
            const float pg = 1.0f / gden;
            float el[8];
#pragma unroll
            for (int e = 0; e < 8; ++e) el[e] = logit(4 + g * 8 + e) + p.b_er[g * 8 + e];
            int e1 = 0; float m1 = el[0];
#pragma unroll
            for (int e = 1; e < 8; ++e) if (el[e] > m1) { m1 = el[e]; e1 = e; }
            int e2 = -1; float m2 = -3.0e38f;
#pragma unroll
            for (int e = 0; e < 8; ++e) if (e != e1 && el[e] > m2) { m2 = el[e]; e2 = e; }
            const float x2e = __expf(m2 - m1);
            const float p1 = 1.0f / (1.0f + x2e), p2 = x2e / (1.0f + x2e);
            const int ex1 = g * 8 + e1, ex2 = g * 8 + e2;
            const unsigned pos1 = atomicAdd(cnt + ex1 * 64, 1u), pos2 = atomicAdd(cnt + ex2 * 64, 1u);
            int* rexp = (int*)(rt + RT_EXP); int* rpos = (int*)(rt + RT_POS); float* rgate = (float*)(rt + RT_GATE); int* rlist = (int*)(rt + RT_LIST);
            rexp[tok * 2] = ex1; rexp[tok * 2 + 1] = ex2; rpos[tok * 2] = (int)pos1; rpos[tok * 2 + 1] = (int)pos2;
            rgate[tok * 2] = pg * p1; rgate[tok * 2 + 1] = pg * p2;
            rlist[ex1 * T + pos1] = tok * 2; rlist[ex2 * T + pos2] = tok * 2 + 1;
        }
        if (!conv_done) { moe_convert_down(p, (int)blockIdx.x * 4 + (tidf() >> 6), (int)gridDim.x * 4, tidf() & 63, 24, 32); conv_done = true; }
        __syncthreads();
    }
    if (!conv_done) moe_convert_down(p, (int)blockIdx.x * 4 + (tidf() >> 6), (int)gridDim.x * 4, tidf() & 63, 24, 32);
}

DEV int moe_table(const P& p, int* tbl  ) {
    const unsigned* cnt = (const unsigned*)(p.ws + CTL_CNT);
    if (tidf() < 64) {
        const int e = tidf() & 31;
        const int c = (int)__hip_atomic_load(cnt + e * 64, __ATOMIC_RELAXED, __HIP_MEMORY_SCOPE_AGENT);
        const int nt = (c + 127) >> 7;
        int incl = nt;
#pragma unroll
        for (int o = 1; o < 32; o <<= 1) { const int v = __shfl_up(incl, o, 32); if (e >= o) incl += v; }
        if (tidf() < 32) { tbl[e] = incl - nt; tbl[33 + e] = c; if (e == 31) tbl[32] = incl; }
    }
    __syncthreads();
    return tbl[32];
}
DEV int moe_find(const int* tbl, int mtile) { int e = 0;
#pragma unroll 1
    for (int k = 16; k >= 1; k >>= 1) if (e + k < 32 && tbl[e + k] <= mtile) e += k;
    return e; }

struct MoeLoc { int e, mi, mtile; };
DEV int moe_chunk_lo(const int* tbl, const XcdIter& xi) { return xi.x < 0 ? 0 : (xi.x * tbl[32]) >> 3; }
DEV int moe_local_tiles(const int* tbl, const XcdIter& xi) {
    if (xi.x < 0) return tbl[32];
    return (((xi.x + 1) * tbl[32]) >> 3) - ((xi.x * tbl[32]) >> 3);
}
DEV MoeLoc moe_locate(const int* tbl, const XcdIter& xi, int lm) {
    MoeLoc r;
    r.mtile = moe_chunk_lo(tbl, xi) + lm; r.e = moe_find(tbl, r.mtile); r.mi = r.mtile - tbl[r.e];
    return r;
}

DEV void moe_wait_tile(unsigned char* ws, int mtile) {
    if (tidf() < 64) {
        gu32* rdy = (gu32*)(ws + CTL_READY) + mtile;
        unsigned* bar = (unsigned*)(ws + CTL_BAR);
        XB_SPIN((unsigned)__builtin_amdgcn_readfirstlane(__hip_atomic_load(rdy, __ATOMIC_RELAXED, __HIP_MEMORY_SCOPE_AGENT)) < 8u, bar);
    }
    __syncthreads();
}

DEV void phase9(const P& p, unsigned char* lds) {
    unsigned char* ws = p.ws;
    int* tbl = (int*)(lds + LDS_MAIN + 256);
    const int ntm = moe_table(p, tbl);
    const int tid = tidf(), lane = tid & 63, wid = tid >> 6, wr = wid >> 1, wc = wid & 1, fr = lane & 15, fq = lane >> 4;
    const int srow = tid >> 3, sc = stage_col(tid) * 2;
    const u64* sqb = (const u64*)(ws + CTL_SQ);
    const int* rlist = (const int*)(ws + WS_ROUTE + RT_LIST); const float* rgate = (const float*)(ws + WS_ROUTE + RT_GATE);
    const u8* x2f8 = (const u8*)(ws + WS_X2B);
    u8* act = (u8*)(ws + WS_ACT);
    const XcdIter xi = xcd_iter();
    auto desc = [&](int item) -> GT8 {
        const int nt = item & 7;
        const MoeLoc lc = moe_locate(tbl, xi, item >> 3);
        const int e = lc.e, mi = lc.mi, cnt = tbl[33 + e];
        const int* le = rlist + (size_t)e * T;
        GT8 t;
#pragma unroll
        for (int i = 0; i < 4; ++i) { int li = mi * 128 + srow + 32 * i; li = li < cnt ? li : cnt - 1; t.a[i] = x2f8 + (size_t)(le[li] >> 1) * D + sc; }
        const u8* bp = (const u8*)(ws + WS_WGU) + ((size_t)e * 1024 + nt * 128) * D + sc;
#pragma unroll
        for (int i = 0; i < 4; ++i) t.b[i] = bp + (size_t)bperm(srow + 32 * i) * D;
        return t; };
    GemmPipe gp{0, false};
    (void)ntm;
    const int nitems = moe_local_tiles(tbl, xi) * 8;
    if (xi.j >= nitems) return;
    GT8 cur = desc(xi.j);
    for (int item = xi.j; item < nitems; item += xi.per) {
        const int nt = item & 7;
        const MoeLoc lc = moe_locate(tbl, xi, item >> 3);
        const int e = lc.e, mi = lc.mi, mtile = lc.mtile, cnt = tbl[33 + e];
        const int* le = rlist + (size_t)e * T;
        const bool hn = item + xi.per < nitems;
        GT8 nx = cur; if (hn) nx = desc(item + xi.per);
        f32x4 acc[4][4]; acc_zero(acc);
        float rsj[4], gtj[4];
#pragma unroll
        for (int j = 0; j < 4; ++j) {
            int li = mi * 128 + wr * 64 + j * 16 + fr; li = li < cnt ? li : cnt - 1;
            const int ent = le[li];
            rsj[j] = sq_rs(sqb + SQ_X2 * T, ent >> 1, 1.0f / 2048.0f); gtj[j] = rgate[ent];
        }
        gemm_run8(acc, lds, cur, 16, gp, nx, hn);
#pragma unroll
        for (int j = 0; j < 4; ++j) {
            const int ml = wr * 64 + j * 16 + fr;
            const float rs = rsj[j] * (1.0f / W8_SCALE), gt = gtj[j] * ACT8_SCALE;
            u32x2 aw;
#pragma unroll
            for (int q = 0; q < 2; ++q) {
                const f32x4 a = acc[2 * q][j] * rs, u = acc[2 * q + 1][j] * rs;
                float o[4];
#pragma unroll
                for (int c = 0; c < 4; ++c) o[c] = a[c] / (1.0f + __expf(-a[c])) * u[c] * gt;
                aw[q] = pack_fp8x4_sat(o[0], o[1], o[2], o[3]);
            }
            __hip_atomic_store((gu64*)(act + (size_t)(mtile * 128 + ml) * 512 + nt * 64 + wc * 32 + fq * 8), (unsigned long long)aw.x | ((unsigned long long)aw.y << 32),
                               __ATOMIC_RELAXED, __HIP_MEMORY_SCOPE_AGENT);
        }
        asm volatile("s_waitcnt vmcnt(0)" ::: "memory");
        __syncthreads();
        if (tid == 0) __hip_atomic_fetch_add((gu32*)(ws + CTL_READY) + mtile, 1u, __ATOMIC_RELAXED, __HIP_MEMORY_SCOPE_AGENT);
        cur = nx;
    }
}

DEV void phase10(const P& p, unsigned char* lds) {
    unsigned char* ws = p.ws;
    int* tbl = (int*)(lds + LDS_MAIN + 256);
    const int ntm = moe_table(p, tbl);
    const int tid = tidf(), lane = tid & 63, wid = tid >> 6, wr = wid >> 1, wc = wid & 1, fr = lane & 15, fq = lane >> 4;
    const int* rlist = (const int*)(ws + WS_ROUTE + RT_LIST);
    bf16_t* y = (bf16_t*)(ws + WS_Y);
    const int srow = tid >> 3, sc = stage_col(tid) * 2;
    const XcdIter xi = xcd_iter();
    auto desc = [&](int item) -> GT8 {
        const int nt = item & 15;
        const MoeLoc lc = moe_locate(tbl, xi, item >> 4);
        const int e = lc.e, mtile = lc.mtile;
        GT8 t;
        const u8* a = (const u8*)(ws + WS_ACT) + (size_t)(mtile * 128 + srow) * 512 + sc;
        const u8* b = (const u8*)(ws + WS_WD) + ((size_t)e * 2048 + nt * 128) * 512 + sc;
#pragma unroll
        for (int i = 0; i < 4; ++i) { t.a[i] = a + (size_t)(32 * i) * 512; t.b[i] = b + (size_t)bperm(srow + 32 * i) * 512; }
        return t; };
    GemmPipe gp{0, false};
    (void)ntm;
    const int nitems = moe_local_tiles(tbl, xi) * 16;
    gu32* qctr = (gu32*)(ws + CTL_Q10) + (xi.x >= 0 ? xi.x : 0) * 64;
    volatile int* qs = (volatile int*)(lds + LDS_MAIN + 192);
    if (tid < 64) {
        const int nl = moe_local_tiles(tbl, xi); bool done = true;
        if (lane < nl) done = __hip_atomic_load((gu32*)(ws + CTL_READY) + moe_locate(tbl, xi, lane).mtile, __ATOMIC_RELAXED, __HIP_MEMORY_SCOPE_AGENT) >= 8u;
        const unsigned long long m = __ballot(done);
        if (lane == 0) { qs[2] = (int)(unsigned)m; qs[3] = (int)(unsigned)(m >> 32);
                         qs[0] = (int)__hip_atomic_fetch_add(qctr, 2u, __ATOMIC_RELAXED, __HIP_MEMORY_SCOPE_AGENT); }
    }
    __syncthreads();
    const unsigned long long ready_mask = (unsigned long long)(unsigned)qs[2] | ((unsigned long long)(unsigned)qs[3] << 32);
    int item = qs[0], nitem = item + 1;
    __syncthreads();
    if (item >= nitems) return;
    auto wait_item = [&](int it) { const int lm = it >> 4; if (lm >= 64 || !((ready_mask >> lm) & 1ull)) moe_wait_tile(ws, moe_locate(tbl, xi, lm).mtile); };
    GT8 cur = desc(item);
    wait_item(item);
    for (;;) {
        const int nt = item & 15;
        const MoeLoc lc = moe_locate(tbl, xi, item >> 4);
        const int e = lc.e, mi = lc.mi, cnt = tbl[33 + e];
        const int* le = rlist + (size_t)e * T;
        const bool hn = nitem < nitems;
        GT8 nx = cur;
        if (hn) { nx = desc(nitem); wait_item(nitem); }
        f32x4 acc[4][4]; acc_zero(acc);
        int entj[4];
#pragma unroll
        for (int j = 0; j < 4; ++j) { const int li = mi * 128 + wr * 64 + j * 16 + fr; entj[j] = li < cnt ? le[li] : -1; }
        gemm_run8<0>(acc, lds, cur, 4, gp, nx, hn);
        int drawn = 0;
        if (tid == 0 && hn) drawn = (int)__hip_atomic_fetch_add(qctr, 1u, __ATOMIC_RELAXED, __HIP_MEMORY_SCOPE_AGENT);
#pragma unroll
        for (int j = 0; j < 4; ++j) {
            if (entj[j] >= 0) {
                const int ent = entj[j], tok = ent >> 1, k = ent & 1;
                const float ys = 1.0f / (W8_SCALE * ACT8_SCALE);
                st_bf16x16(y + ((size_t)k * T + tok) * D + nt * 128 + wc * 64 + fq * 16, acc[0][j] * ys, acc[1][j] * ys, acc[2][j] * ys, acc[3][j] * ys);
            }
        }
        if (!hn) break;
        if (tid == 0) qs[0] = drawn;
        __syncthreads();
        const int nn = qs[0];
        __syncthreads();
        cur = nx; item = nitem; nitem = nn;
    }
}

DEV void phase11(const P& p, float probe_c) {
    const int lane = tidf() & 63, gw = blockIdx.x * 4 + (tidf() >> 6), NGW = gridDim.x * 4;
    const bf16_t* y = (const bf16_t*)(p.ws + WS_Y);
    for (int row = gw; row < T; row += NGW) {
        float* xr = p.out + (size_t)row * D;
        const bf16_t* x2h = (const bf16_t*)(p.ws + WS_X2HI) + (size_t)row * D;
        const bf16_t* y0 = y + (size_t)row * D; const bf16_t* y1 = y + ((size_t)T + row) * D;
        f32x4 v[8]; float s = 0.f;
#pragma unroll
        for (int i = 0; i < 8; ++i) {
            const int c = i * 256 + lane * 4;
            const u32x2 xx = *(const u32x2*)(x2h + c);
            v[i] = (f32x4){__uint_as_float(xx.x << 16), __uint_as_float(xx.x & 0xffff0000u), __uint_as_float(xx.y << 16), __uint_as_float(xx.y & 0xffff0000u)};
            const u32x2 a = *(const u32x2*)(y0 + c), b = *(const u32x2*)(y1 + c);
            v[i][0] += __uint_as_float(a.x << 16) + __uint_as_float(b.x << 16);
            v[i][1] += __uint_as_float(a.x & 0xffff0000u) + __uint_as_float(b.x & 0xffff0000u);
            v[i][2] += __uint_as_float(a.y << 16) + __uint_as_float(b.y << 16);
            v[i][3] += __uint_as_float(a.y & 0xffff0000u) + __uint_as_float(b.y & 0xffff0000u);
            s += v[i][0] * v[i][0] + v[i][1] * v[i][1] + v[i][2] * v[i][2] + v[i][3] * v[i][3];
        }
        s = wave_sum(s);
        const float rs = __builtin_amdgcn_rsqf(s * (1.0f / 2048.0f) + EPS);
#pragma unroll
        for (int i = 0; i < 8; ++i) {
            const int c = i * 256 + lane * 4;
            const f32x4 g = *(const f32x4*)(p.norm_final + c);
#ifdef PROBE_CONST_OUT
            *(f32x4*)(xr + c) = (f32x4){probe_c, probe_c, probe_c, probe_c};
#else
            *(f32x4*)(xr + c) = v[i] * rs * g + probe_c;
#endif
        }
    }
}

DEV void phase11_dry(const P& p) {
    const int lane = tidf() & 63, gw = blockIdx.x * 4 + (tidf() >> 6), NGW = gridDim.x * 4;
    const bf16_t* y = (const bf16_t*)(p.ws + WS_Y);
    for (int row = gw; row < T; row += NGW) {
        float* xr = p.out + (size_t)row * D;
        const bf16_t* x2h = (const bf16_t*)(p.ws + WS_X2HI) + (size_t)row * D;
        const bf16_t* y0 = y + (size_t)row * D; const bf16_t* y1 = y + ((size_t)T + row) * D;
        f32x4 v[8]; float s = 0.f;
#pragma unroll
        for (int i = 0; i < 8; ++i) {
            const int c = i * 256 + lane * 4;
            const u32x2 xx = *(const u32x2*)(x2h + c);
            v[i] = (f32x4){__uint_as_float(xx.x << 16), __uint_as_float(xx.x & 0xffff0000u), __uint_as_float(xx.y << 16), __uint_as_float(xx.y & 0xffff0000u)};
            const u32x2 a = *(const u32x2*)(y0 + c), b = *(const u32x2*)(y1 + c);
            v[i][0] += __uint_as_float(a.x << 16) + __uint_as_float(b.x << 16);
            v[i][1] += __uint_as_float(a.x & 0xffff0000u) + __uint_as_float(b.x & 0xffff0000u);
            v[i][2] += __uint_as_float(a.y << 16) + __uint_as_float(b.y << 16);
            v[i][3] += __uint_as_float(a.y & 0xffff0000u) + __uint_as_float(b.y & 0xffff0000u);
            s += v[i][0] * v[i][0] + v[i][1] * v[i][1] + v[i][2] * v[i][2] + v[i][3] * v[i][3];
        }
        s = wave_sum(s);
        const float rs = __builtin_amdgcn_rsqf(s * (1.0f / 2048.0f) + EPS);
#pragma unroll
        for (int i = 0; i < 8; ++i) {
            const int c = i * 256 + lane * 4;
            const f32x4 g = *(const f32x4*)(p.norm_final + c);
            { const f32x4 o = v[i] * rs * g; asm volatile("" :: "v"(o)); }
        }
    }
}

#ifndef USE_CG_SYNC
#define USE_CG_SYNC 0
#endif
__global__ void __launch_bounds__(NTHREADS, 2) hymba_fwd(P p) {
    extern __shared__ __attribute__((aligned(16))) unsigned char lds[];
#if USE_CG_SYNC
    cg::grid_group grid = cg::this_grid();
#endif
    volatile unsigned* st = (volatile unsigned*)(lds + LDS_MAIN);
    if (threadIdx.x < 16) st[threadIdx.x] = 0u;
    __syncthreads();
    XcdBarrier bar = xcd_barrier_post((unsigned*)(p.ws + CTL_BAR), st);
#if USE_CG_SYNC
#define GRID_BAR() grid.sync()
#else
#define GRID_BAR() xcd_barrier(bar)
#endif
#ifndef PROBE_REPEAT
#define PROBE_REPEAT 0
#endif
#define REP(n) ((PROBE_REPEAT >> (n)) & 1)
#ifndef PROBE_TIME
#define PROBE_TIME -1
#endif
#ifndef PROBE_SCALE
#define PROBE_SCALE 1e-7f
#endif
#ifndef PROBE_QUANT
#define PROBE_QUANT 1
#define PROBE_QOFF 0
#endif
    u64* tsw = (u64*)(p.ws + CTL_CNT + 12288);
#define STAMP(i) do { if (PROBE_TIME >= 0 && blockIdx.x == 0 && threadIdx.x == 0) tsw[i] = __builtin_amdgcn_s_memrealtime(); } while (0)
    STAMP(0);
    phase0(p);        GRID_BAR(); STAMP(1);
    if (REP(0)) { phase0(p); GRID_BAR(); }
    phase1(p, lds);   STAMP(2);
#ifdef PROBE_DRY1
    STAMP(12); phase1_dry<PROBE_DRY1 - 1>(p, lds); GRID_BAR(); STAMP(13);
#endif
    if (REP(1)) { phase1(p, lds, true); GRID_BAR(); }
    phase2(p, lds);   GRID_BAR(); STAMP(3);
    if (REP(2)) { phase2(p, lds); GRID_BAR(); }
    phase3(p, lds);   GRID_BAR(); STAMP(4);
#ifdef PROBE_DRY3
    STAMP(12); phase3_dry<PROBE_DRY3 - 1>(p, lds); GRID_BAR(); STAMP(13);
#endif
    if (REP(3)) { phase3(p, lds, true); GRID_BAR(); }
    phase4(p, lds);   GRID_BAR(); STAMP(5);
    if (REP(4)) { phase4(p, lds, true); GRID_BAR(); }
    phase5(p, lds);   GRID_BAR(); STAMP(6);
    if (REP(5)) { phase5(p, lds); GRID_BAR(); }
    phase6(p, lds);   GRID_BAR(); STAMP(7);
    if (REP(6)) { phase6(p, lds); GRID_BAR(); }
    phase7(p, lds);   GRID_BAR(); STAMP(8);
    if (REP(7)) { phase7(p, lds, true); GRID_BAR(); }
    phase8(p, lds);   GRID_BAR(); STAMP(9);
    phase9(p, lds);   STAMP(10);
    if (REP(9)) { phase9(p, lds); GRID_BAR(); }
    phase10(p, lds);  GRID_BAR(); STAMP(11);
#ifdef PROBE_DRY11
    STAMP(12); phase11_dry(p); GRID_BAR(); STAMP(13);
#endif
    if (REP(10)) { phase10(p, lds); GRID_BAR(); }
    float probe_c = 0.f;
    if (PROBE_TIME >= 0) { GRID_BAR(); const u64 dt = tsw[PROBE_TIME + 1] - tsw[PROBE_TIME]; probe_c = sqrtf((float)((dt + PROBE_QOFF) / PROBE_QUANT * PROBE_QUANT) * PROBE_SCALE); }
    phase11(p, probe_c);
#if USE_CG_SYNC
    grid.sync();
#endif
    (void)bar;
}

extern "C" void kernel_launch(void* const* d_in, const int* in_sizes, int n_in, void* d_out, int out_size, void* d_ws, size_t ws_size, hipStream_t stream) {
    static int grid = 0;
    if (grid == 0) {
        if (n_in != 26 || out_size != T * D || ws_size < WS_END) {
            fprintf(stderr, "kernel_launch: unexpected shapes: n_in %d out %d ws %zu (need %zu)\n", n_in, out_size, ws_size, (size_t)WS_END); grid = -1; return; }
        int dev = 0, cus = 0, per_cu = 0;
        hipGetDevice(&dev);
        hipDeviceGetAttribute(&cus, hipDeviceAttributeMultiprocessorCount, dev);
        if (hipFuncSetAttribute((const void*)hymba_fwd, hipFuncAttributeMaxDynamicSharedMemorySize, LDS_BYTES) != hipSuccess) { fprintf(stderr, "kernel_launch: hipFuncSetAttribute failed\n"); grid = -1; return; }
        if (hipOccupancyMaxActiveBlocksPerMultiprocessor(&per_cu, (const void*)hymba_fwd, NTHREADS, LDS_BYTES) != hipSuccess || per_cu < 1) { fprintf(stderr, "kernel_launch: occupancy query failed (%d)\n", per_cu); grid = -1; return; }
        if (per_cu > 2) per_cu = 2;
        grid = cus * per_cu;
        fprintf(stderr, "kernel_launch: %d CUs x %d blocks\n", cus, per_cu);
    }
    if (grid < 0) return;
    hipMemsetAsync(d_ws, 0, CTL_BYTES, stream);
    P p{};
    p.x = (const float*)d_in[0]; p.mem = (const float*)d_in[1]; p.pos = (const int*)d_in[2];
    p.norm_mix = (const float*)d_in[3]; p.w_in = (const float*)d_in[4]; p.norm_q_lat = (const float*)d_in[5]; p.w_q_b = (const float*)d_in[6];
    p.norm_kv_lat = (const float*)d_in[7]; p.w_kv_b = (const float*)d_in[8]; p.norm_mla_out = (const float*)d_in[9]; p.norm_sb_out = (const float*)d_in[10];
    p.w_out = (const float*)d_in[11]; p.norm_mem_x = (const float*)d_in[12]; p.norm_mem_src = (const float*)d_in[13]; p.w_mem_q = (const float*)d_in[14];
    p.w_mem_kv = (const float*)d_in[15]; p.w_mem_o = (const float*)d_in[16]; p.norm_ffn = (const float*)d_in[17]; p.w_group = (const float*)d_in[18];
    p.b_group = (const float*)d_in[19]; p.w_er = (const float*)d_in[20]; p.b_er = (const float*)d_in[21]; p.w_gate = (const float*)d_in[22];
    p.w_up = (const float*)d_in[23]; p.w_down = (const float*)d_in[24]; p.norm_final = (const float*)d_in[25];
    p.out = (float*)d_out; p.ws = (unsigned char*)d_ws;
    void* args[] = {&p};
    hipError_t e = hipLaunchCooperativeKernel((const void*)hymba_fwd, dim3(grid), dim3(NTHREADS), args, LDS_BYTES, stream);
    if (e != hipSuccess) fprintf(stderr, "kernel_launch: cooperative launch failed: %s (grid %d)\n", hipGetErrorString(e), grid);
}
```
